# Optimizing an MI355X kernel written in HIP

```python
import math
import jax
import jax.numpy as jnp
from jax import lax
import numpy as np

D_MODEL = 1024
BATCH = 8
SEQ = 2048
DEPTH = 4

CTX_LEN = 256
GRID_W = 64
NORM_EPS = 1e-6

MLA_HEADS = 8
MLA_NOPE = 64
MLA_ROPE = 32
MLA_QK = MLA_NOPE + MLA_ROPE
MLA_V = 64
MLA_Q_LORA = 256
MLA_KV_LORA = 128
MLA_WIDTH = MLA_HEADS * MLA_V
ROPE_BASE = 10000.0
BLOCK_Q = 128

RW_HEADS = 8
RW_HEAD = 64
RW_WIDTH = RW_HEADS * RW_HEAD
RW_LORA_W = 64
RW_LORA_A = 64
RW_SHIFT = 3 * RW_WIDTH + 2 * RW_LORA_W + 2 * RW_LORA_A
RW_GN_EPS = 64e-5

EV_MIX = MLA_WIDTH + RW_WIDTH
EV_DQ = MLA_Q_LORA
EV_DKV = MLA_KV_LORA + MLA_ROPE
EV_IN = EV_DQ + EV_DKV + RW_SHIFT + EV_MIX

HY_WIDTH = D_MODEL
HY_IN = 4 * HY_WIDTH
HY_ORDER = 64
HY_BANDS = 16
HY_EMB = 1 + 2 * HY_BANDS
HY_INNER = 2
HY_FAST_DECAY = 0.3
HY_SLOW_DECAY = 1.5
HY_TARGET = 1e-2

N_EVEN = (DEPTH + 1) // 2
N_ODD = DEPTH // 2

kernel_name = 'hybrid_mla_rwkv7_hyena_prefix_block'


def rms_norm(t, g):
    tf = t.astype(jnp.float32)
    tf = tf * lax.rsqrt(jnp.mean(tf * tf, axis=-1, keepdims=True) + NORM_EPS)
    return (tf * g).astype(t.dtype)


def axial_rope_tables(seq_len):
    rows = seq_len // GRID_W
    row = jnp.repeat(jnp.arange(rows, dtype=jnp.float32), GRID_W)
    col = jnp.tile(jnp.arange(GRID_W, dtype=jnp.float32), rows)
    n_freq = MLA_ROPE // 4
    inv = ROPE_BASE ** (-jnp.arange(n_freq, dtype=jnp.float32) / n_freq)
    ang = jnp.concatenate([row[:, None] * inv, col[:, None] * inv], axis=-1)
    return jnp.cos(ang), jnp.sin(ang)


def apply_rope(t, cos, sin):
    tf = t.astype(jnp.float32).reshape(t.shape[:-1] + (MLA_ROPE // 2, 2))
    a, b = tf[..., 0], tf[..., 1]
    cs, sn = cos[:, None, :], sin[:, None, :]
    out = jnp.stack([a * cs - b * sn, a * sn + b * cs], axis=-1).reshape(t.shape)
    return out.astype(t.dtype)


def rope_tail(t, rope):
    return jnp.concatenate([t[..., :MLA_NOPE], apply_rope(t[..., MLA_NOPE:], *rope)], axis=-1)


def mla_queries(p_dq, q_a_norm, w_uq, q_norm, rope):
    q = jnp.einsum('blr,rhd->blhd', rms_norm(p_dq, q_a_norm), w_uq)
    q = rms_norm(q, q_norm)
    return q if rope is None else rope_tail(q, rope)


def mla_keys_values(p_dkv, kv_a_norm, w_ukv, k_norm, rope):
    B, L, _ = p_dkv.shape
    kv = jnp.einsum('blr,rhd->blhd', rms_norm(p_dkv[..., :MLA_KV_LORA], kv_a_norm), w_ukv)
    k_nope, v = kv[..., :MLA_NOPE], kv[..., MLA_NOPE:]
    k_rope = jnp.broadcast_to(p_dkv[:, :, None, MLA_KV_LORA:], (B, L, MLA_HEADS, MLA_ROPE))
    k = rms_norm(jnp.concatenate([k_nope, k_rope], axis=-1), k_norm)
    return (k if rope is None else rope_tail(k, rope)), v


def attend(q, k, v):
    s = jnp.einsum('bqhd,bkhd->bhqk', q, k, preferred_element_type=jnp.float32) * (q.shape[-1] ** -0.5)
    p = jax.nn.softmax(s, axis=-1)
    return jnp.einsum('bhqk,bkhd->bqhd', p.astype(v.dtype), v)


def blocked_attention(q, k, v):
    B, L, H, Dq = q.shape
    nb = L // BLOCK_Q
    qb = q.reshape(B, nb, BLOCK_Q, H, Dq).transpose(1, 0, 2, 3, 4)
    ob = lax.map(lambda blk: attend(blk, k, v), qb)
    return ob.transpose(1, 0, 2, 3, 4).reshape(B, L, H, v.shape[-1])


def bidir_shift(p, mu_prev, mu_next):
    zero = jnp.zeros_like(p[:, :1])
    prev = jnp.concatenate([zero, p[:, :-1]], axis=1)
    nxt = jnp.concatenate([p[:, 1:], zero], axis=1)
    return p + (prev - p) * mu_prev + (nxt - p) * mu_next


def rwkv_streams(ps, w0, w_up, a0, a_up, k_k, k_a):
    B, L, _ = ps.shape
    ps = ps.astype(jnp.float32)
    cut = [RW_WIDTH, 2 * RW_WIDTH, 3 * RW_WIDTH, 3 * RW_WIDTH + 2 * RW_LORA_W]
    r, k, v, wd, ad = jnp.split(ps, cut, axis=-1)
    wd = jnp.tanh(wd.reshape(B, L, 2, RW_LORA_W))
    ad = ad.reshape(B, L, 2, RW_LORA_A)
    w_log = -jax.nn.softplus(-(w0 + jnp.einsum('bldr,drc->bldc', wd, w_up))) - 0.5
    decay = jnp.exp(-jnp.exp(w_log))
    a = jax.nn.sigmoid(a0 + jnp.einsum('bldr,drc->bldc', ad, a_up))
    kk = (k * k_k).reshape(B, L, RW_HEADS, RW_HEAD)
    kk = kk * lax.rsqrt(jnp.maximum(jnp.sum(kk * kk, axis=-1, keepdims=True), 1e-24))
    kd = k[:, :, None, :] * (1.0 + (a - 1.0) * k_a)
    hd = lambda t: t.reshape(t.shape[:-1] + (RW_HEADS, RW_HEAD))
    return hd(r), hd(v), kk, hd(decay), hd(a), hd(kd)


def rwkv_scan(r, w, k, v, kk, a, s0, reverse):
    def step(S, inp):
        r_t, w_t, k_t, v_t, kk_t, a_t = inp
        sa = jnp.einsum('bhvk,bhk->bhv', S, -kk_t)
        S = S * w_t[:, :, None, :] + sa[..., None] * (kk_t * a_t)[:, :, None, :] + v_t[..., None] * k_t[:, :, None, :]
        return S, jnp.einsum('bhvk,bhk->bhv', S, r_t)
    xs = tuple(jnp.moveaxis(t, 1, 0) for t in (r, w, k, v, kk, a))
    S, out = lax.scan(step, s0, xs, reverse=reverse)
    return S, jnp.moveaxis(out, 0, 1)


def rwkv_run(streams, s0s):
    r, v, kk, decay, a, kd = streams
    outs, finals = [], []
    for d in range(2):
        S, o = rwkv_scan(r, decay[:, :, d], kd[:, :, d], v, kk, a[:, :, d], s0s[d], reverse=(d == 1))
        outs.append(o)
        finals.append(S)
    return outs, finals


def rwkv_finish(streams, outs, r_k, ln_w, ln_b):
    r, v, kk, decay, a, kd = streams
    B, L = r.shape[:2]
    o = outs[0] + outs[1]
    mu = jnp.mean(o, axis=-1, keepdims=True)
    var = jnp.mean(jnp.square(o - mu), axis=-1, keepdims=True)
    o = ((o - mu) * lax.rsqrt(var + RW_GN_EPS)).reshape(B, L, RW_WIDTH) * ln_w + ln_b
    bonus = jnp.sum(jnp.sum(r[:, :, None] * kd * r_k, axis=-1, keepdims=True), axis=2) * v
    return o + bonus.reshape(B, L, RW_WIDTH)


def merge_heads(o_mla, o_rw, g, w_out):
    B, L = g.shape[:2]
    o = jnp.concatenate([o_mla.reshape(B, L, MLA_WIDTH).astype(g.dtype), o_rw.astype(g.dtype)], axis=-1)
    return (o * jax.nn.silu(g)) @ w_out


def even_mixer(h, hc, rope, ctx_out, w_in, w_out, mla_p, rw_p, rw_out_p):
    cut = [EV_DQ, EV_DQ + EV_DKV, EV_DQ + EV_DKV + RW_SHIFT]
    p_dq, p_dkv, p_rw, g = jnp.split(h @ w_in, cut, axis=-1)
    pc_dq, pc_dkv, pc_rw, gc = jnp.split(hc @ w_in, cut, axis=-1)
    q_a_norm, w_uq, kv_a_norm, w_ukv, q_norm, k_norm = mla_p
    mu_prev, mu_next = rw_p[0], rw_p[1]
    q = mla_queries(p_dq, q_a_norm, w_uq, q_norm, rope)
    k, v = mla_keys_values(p_dkv, kv_a_norm, w_ukv, k_norm, rope)
    kc, vc = mla_keys_values(pc_dkv, kv_a_norm, w_ukv, k_norm, None)
    o_mla = blocked_attention(q, jnp.concatenate([k, kc], axis=1), jnp.concatenate([v, vc], axis=1))
    st_c = rwkv_streams(bidir_shift(pc_rw, mu_prev, mu_next), *rw_p[2:])
    st = rwkv_streams(bidir_shift(p_rw, mu_prev, mu_next), *rw_p[2:])
    s0 = jnp.zeros((hc.shape[0], RW_HEADS, RW_HEAD, RW_HEAD), jnp.float32)
    outs_c, fin_c = rwkv_run(st_c, (s0, s0))
    outs, _ = rwkv_run(st, fin_c)
    o_rw = rwkv_finish(st, outs, *rw_out_p)
    y = merge_heads(o_mla, o_rw, g, w_out)
    if not ctx_out:
        return y, None
    qc = mla_queries(pc_dq, q_a_norm, w_uq, q_norm, None)
    oc_mla = attend(qc, kc, vc)
    oc_rw = rwkv_finish(st_c, outs_c, *rw_out_p)
    return y, merge_heads(oc_mla, oc_rw, gc, w_out)


def centred_conv3(u, w, b):
    up = jnp.pad(u, ((0, 0), (1, 1), (0, 0)))
    return up[:, :-2] * w[0] + up[:, 1:-1] * w[1] + up[:, 2:] * w[2] + b


def hyena_filters(L, f_w1, f_b1, f_w2, f_b2, f_wout, freq):
    f32 = jnp.float32
    pos = jnp.arange(L, dtype=f32)[:, None]
    t = pos / (L - 1)
    bands = jnp.linspace(1e-4, HY_BANDS - 1, HY_BANDS, dtype=f32)
    ang = pos * (2.0 * math.pi / L) * bands
    z = jnp.concatenate([t, jnp.cos(ang), -jnp.sin(ang)], axis=-1)
    hdn = jnp.sin(freq * (z @ f_w1 + f_b1))
    for j in range(HY_INNER):
        hdn = jnp.sin(freq * (hdn @ f_w2[j] + f_b2[j]))
    filt = (hdn @ f_wout).reshape(L, 2, HY_WIDTH)
    deltas = jnp.abs(jnp.linspace(math.log(HY_TARGET) / HY_FAST_DECAY, math.log(HY_TARGET) / HY_SLOW_DECAY, HY_WIDTH, dtype=f32))
    filt = filt * jnp.exp(-t[:, :, None] * deltas)
    full = jnp.concatenate([filt[:, 0], jnp.zeros((1, HY_WIDTH), f32), filt[:0:-1, 1]], axis=0)
    return full / jnp.sum(jnp.abs(full), axis=0, keepdims=True)


def hyena_mixer(h, w_in, w_out, conv_w, conv_b, bias_d, f_w1, f_b1, f_w2, f_b2, f_wout, freq):
    L = h.shape[1]
    p = h @ w_in
    u, g = p[..., :3 * HY_WIDTH], p[..., 3 * HY_WIDTH:]
    x0, x1, v = jnp.split(centred_conv3(u, conv_w, conv_b), 3, axis=-1)
    v = (v * x1).astype(jnp.float32)
    filt = hyena_filters(L, f_w1, f_b1, f_w2, f_b2, f_wout, freq)
    n = 2 * L
    y = jnp.fft.irfft(jnp.fft.rfft(v, n=n, axis=1) * jnp.fft.rfft(filt, n=n, axis=0)[None], n=n, axis=1)[:, :L]
    y = (y + v * bias_d).astype(h.dtype) * x0
    return (y * jax.nn.silu(g)) @ w_out


def setup_inputs(seed: int = 0) -> dict:
    key = jax.random.key(seed)
    ks = iter(jax.random.split(key, 48))
    f32 = jnp.float32
    D = D_MODEL

    def nrm(shape, scale=1.0):
        return scale * jax.random.normal(next(ks), shape, f32)

    def gain(shape):
        return 1.0 + nrm(shape, 0.02)

    def unif(shape, lo, hi):
        return jax.random.uniform(next(ks), shape, f32, lo, hi)

    return {
        'x': nrm((BATCH, SEQ, D)),
        'c': nrm((BATCH, D)),
        'ctx': nrm((BATCH, CTX_LEN, D)),
        'c_ctx': nrm((D,)),
        'mod_w': nrm((DEPTH, D, 3 * D), 0.5 * D ** -0.5),
        'mod_b': nrm((DEPTH, 3 * D), 0.02),
        'norm_g': gain((DEPTH, D)),
        'ev_w_in': nrm((N_EVEN, D, EV_IN), D ** -0.5),
        'ev_w_out': nrm((N_EVEN, EV_MIX, D), EV_MIX ** -0.5),
        'mla_q_a_norm': gain((N_EVEN, MLA_Q_LORA)),
        'mla_w_uq': nrm((N_EVEN, MLA_Q_LORA, MLA_HEADS, MLA_QK), MLA_Q_LORA ** -0.5),
        'mla_kv_a_norm': gain((N_EVEN, MLA_KV_LORA)),
        'mla_w_ukv': nrm((N_EVEN, MLA_KV_LORA, MLA_HEADS, MLA_NOPE + MLA_V), MLA_KV_LORA ** -0.5),
        'mla_q_norm': gain((N_EVEN, MLA_QK)),
        'mla_k_norm': gain((N_EVEN, MLA_QK)),
        'rwkv_mu_prev': unif((N_EVEN, RW_SHIFT), 0.0, 0.5),
        'rwkv_mu_next': unif((N_EVEN, RW_SHIFT), 0.0, 0.5),
        'rwkv_w0': unif((N_EVEN, 2, RW_WIDTH), -4.0, 1.0),
        'rwkv_w_up': nrm((N_EVEN, 2, RW_LORA_W, RW_WIDTH), 0.1),
        'rwkv_a0': nrm((N_EVEN, 2, RW_WIDTH), 0.1),
        'rwkv_a_up': nrm((N_EVEN, 2, RW_LORA_A, RW_WIDTH), 0.1),
        'rwkv_k_k': 0.85 + nrm((N_EVEN, RW_WIDTH), 0.02),
        'rwkv_k_a': gain((N_EVEN, RW_WIDTH)),
        'rwkv_r_k': nrm((N_EVEN, 2, RW_HEADS, RW_HEAD), 0.1),
        'rwkv_ln_w': gain((N_EVEN, RW_WIDTH)),
        'rwkv_ln_b': nrm((N_EVEN, RW_WIDTH), 0.02),
        'od_w_in': nrm((N_ODD, D, HY_IN), D ** -0.5),
        'od_w_out': nrm((N_ODD, HY_WIDTH, D), HY_WIDTH ** -0.5),
        'hy_conv_w': nrm((N_ODD, 3, 3 * HY_WIDTH), 3 ** -0.5),
        'hy_conv_b': nrm((N_ODD, 3 * HY_WIDTH), 0.02),
        'hy_bias_d': nrm((N_ODD, HY_WIDTH), 0.5),
        'hy_f_w1': nrm((N_ODD, HY_EMB, HY_ORDER), HY_EMB ** -0.5),
        'hy_f_b1': nrm((N_ODD, HY_ORDER), 0.1),
        'hy_f_w2': nrm((N_ODD, HY_INNER, HY_ORDER, HY_ORDER), HY_ORDER ** -0.5),
        'hy_f_b2': nrm((N_ODD, HY_INNER, HY_ORDER), 0.1),
        'hy_f_wout': nrm((N_ODD, HY_ORDER, 2 * HY_WIDTH), HY_ORDER ** -0.5),
        'hy_freq': gain((N_ODD, HY_ORDER)),
    }


def reference(x, c, ctx, c_ctx, mod_w, mod_b, norm_g,
              ev_w_in, ev_w_out, mla_q_a_norm, mla_w_uq, mla_kv_a_norm, mla_w_ukv, mla_q_norm, mla_k_norm,
              rwkv_mu_prev, rwkv_mu_next, rwkv_w0, rwkv_w_up, rwkv_a0, rwkv_a_up, rwkv_k_k, rwkv_k_a,
              rwkv_r_k, rwkv_ln_w, rwkv_ln_b,
              od_w_in, od_w_out, hy_conv_w, hy_conv_b, hy_bias_d, hy_f_w1, hy_f_b1, hy_f_w2, hy_f_b2,
              hy_f_wout, hy_freq):
    rope = axial_rope_tables(x.shape[1])
    silu_c = jax.nn.silu(c)
    silu_cc = jax.nn.silu(c_ctx)
    xc = ctx
    for i in range(DEPTH):
        ctx_needed_later = any(j > i and j % 2 == 0 for j in range(DEPTH))
        shift, scale, gate = jnp.split((silu_c @ mod_w[i] + mod_b[i])[:, None, :], 3, axis=-1)
        h = rms_norm(x, norm_g[i]) * (1 + scale) + shift
        if i % 2 == 0 or ctx_needed_later:
            shift_c, scale_c, gate_c = jnp.split(silu_cc @ mod_w[i] + mod_b[i], 3, axis=-1)
            hc = rms_norm(xc, norm_g[i]) * (1 + scale_c) + shift_c
        if i % 2 == 0:
            e = i // 2
            mla_p = (mla_q_a_norm[e], mla_w_uq[e], mla_kv_a_norm[e], mla_w_ukv[e], mla_q_norm[e], mla_k_norm[e])
            rw_p = (rwkv_mu_prev[e], rwkv_mu_next[e], rwkv_w0[e], rwkv_w_up[e], rwkv_a0[e], rwkv_a_up[e],
                    rwkv_k_k[e], rwkv_k_a[e])
            rw_out_p = (rwkv_r_k[e], rwkv_ln_w[e], rwkv_ln_b[e])
            y, yc = even_mixer(h, hc, rope, ctx_needed_later, ev_w_in[e], ev_w_out[e], mla_p, rw_p, rw_out_p)
        else:
            o = i // 2
            hy_p = (od_w_in[o], od_w_out[o], hy_conv_w[o], hy_conv_b[o], hy_bias_d[o], hy_f_w1[o], hy_f_b1[o],
                    hy_f_w2[o], hy_f_b2[o], hy_f_wout[o], hy_freq[o])
            y = hyena_mixer(h, *hy_p)
            yc = hyena_mixer(hc, *hy_p) if ctx_needed_later else None
        x = x + gate * y
        if ctx_needed_later:
            xc = xc + gate_c * yc
    return x
```

```cpp
#include <hip/hip_runtime.h>
#include <hip/hip_cooperative_groups.h>
#include <cstdio>
#include <cstdint>
namespace cg = cooperative_groups;

#define LAS __attribute__((address_space(3)))
#define GAS __attribute__((address_space(1)))
typedef unsigned short bf16_t;
typedef short bf16x8 __attribute__((ext_vector_type(8)));
typedef float f32x4 __attribute__((ext_vector_type(4)));
typedef unsigned u32x4 __attribute__((ext_vector_type(4)));
typedef unsigned u32x2 __attribute__((ext_vector_type(2)));

#ifndef EN_P0
#define EN_P0 1
#endif
#ifndef EN_NORM
#define EN_NORM 1
#endif
#ifndef EN_E2
#define EN_E2 1
#endif
#ifndef EN_E4
#define EN_E4 1
#endif
#ifndef EN_E5
#define EN_E5 1
#endif
#ifndef EN_SCAN
#define EN_SCAN 1
#endif
#ifndef EN_ATTN
#define EN_ATTN 1
#endif
#ifndef EN_E6
#define EN_E6 1
#endif
#ifndef EN_O2
#define EN_O2 1
#endif
#ifndef EN_O3
#define EN_O3 1
#endif
#ifndef EN_GR
#define EN_GR 1
#endif
#ifndef EN_GS
#define EN_GS 1
#endif
constexpr int NB = 8, SEQ = 2048, DM = 1024, CTXL = 256;
constexpr int NLAT = NB * SEQ;
constexpr int NCTX = NB * CTXL;
constexpr int MTOT = NLAT + NCTX;
constexpr int NTHREADS = 512, NWAVES = 8;
constexpr int LDS_BYTES = 147456;
constexpr float NORM_EPS = 1e-6f;

constexpr size_t UU = (size_t)MTOT * 1024 * 2;
constexpr size_t MiB = 1u << 20;
constexpr size_t OFF_MODS = 0;
constexpr size_t OFF_BONUS = MiB / 2;
constexpr size_t OFF_HDN = 2 * MiB;
constexpr size_t OFF_WTS = 4 * MiB;
constexpr size_t OFF_XC = 15 * MiB;
constexpr size_t OFF_BIG = 23 * MiB;
constexpr size_t EV_A = 0;
constexpr size_t EV_B = EV_A + UU * 7 / 4;
constexpr size_t EV_C = EV_B + UU;
constexpr size_t EV_D = EV_C + UU * 3 / 4;
constexpr size_t EV_F = EV_D + UU / 2;
constexpr size_t EV_E = EV_F + UU / 2;
constexpr size_t EV_G = EV_E + UU;
constexpr size_t EV_END = EV_G + UU * 3 / 4;
constexpr size_t OD_P = 0;
constexpr size_t OD_HV = 4 * UU;
constexpr size_t OD_FILT = 5 * UU;
constexpr size_t OD_END = OD_FILT + (size_t)2 * 2048 * 1024 * 4 + (size_t)2 * 256 * 1024 * 4;
static_assert(OFF_BIG + EV_END <= 268435456 && OFF_BIG + OD_END <= 268435456, "ws map");
constexpr size_t W_IN = 0;
constexpr size_t W_OUT = (size_t)4096 * 1024 * 2;
constexpr size_t W_UQ = W_OUT + (size_t)1024 * 1024 * 2;
constexpr size_t W_UKV = W_UQ + (size_t)768 * 256 * 2;
static_assert(W_UKV + (size_t)1024 * 256 * 2 <= 11 * MiB, "weights region");

__device__ __forceinline__ unsigned f2bf(float f) { unsigned u = __builtin_bit_cast(unsigned, f); return (u + 0x7fffu + ((u >> 16) & 1u)) >> 16; }
__device__ __forceinline__ unsigned pk2(float lo, float hi) { return f2bf(lo) | (f2bf(hi) << 16); }
__device__ __forceinline__ float bf2f(unsigned h) { return __builtin_bit_cast(float, (h & 0xffffu) << 16); }
__device__ __forceinline__ float bflo(unsigned w) { return __builtin_bit_cast(float, w << 16); }
__device__ __forceinline__ float bfhi(unsigned w) { return __builtin_bit_cast(float, w & 0xffff0000u); }
__device__ __forceinline__ float shx(float v, int m, int lane) { return __builtin_bit_cast(float, __builtin_amdgcn_ds_bpermute((lane ^ m) << 2, __builtin_bit_cast(int, v))); }
__device__ __forceinline__ float bcast(float v, int src) { return __builtin_bit_cast(float, __builtin_amdgcn_readlane(__builtin_bit_cast(int, v), src)); }
__device__ __forceinline__ float wave_sum(float v, int lane) {
#pragma unroll
    for (int o = 1; o < 64; o <<= 1) v += shx(v, o, lane);
    return v;
}
__device__ __forceinline__ float sum8(float v, int lane) { v += shx(v, 1, lane); v += shx(v, 2, lane); v += shx(v, 4, lane); return v; }
__device__ __forceinline__ float silu_f(float x) { return x / (1.0f + __expf(-x)); }
__device__ __forceinline__ float sigmoid_f(float x) { return 1.0f / (1.0f + __expf(-x)); }

namespace pg8 {
constexpr int BM = 256, BK = 64, HALF = 128, HTB = HALF * BK * 2, STAGE_BYTES = 8 * HTB, NXCD = 8, WGM = 8;
__host__ __device__ __forceinline__ int lds_byte(int r, int c) { const int st = (r >> 4) * 2 + (c >> 5), rr = r & 15, cc = c & 31, ob = rr * 64 + cc * 2; return st * 1024 + (ob ^ (((ob >> 9) & 1) << 5)); }
__host__ __device__ __forceinline__ void stage_rc(int b, int& R, int& C) { const int st = b / 1024, sb = b % 1024, swz = sb ^ (((sb >> 9) & 1) << 5); R = (st >> 1) * 16 + swz / 64; C = (st & 1) * 32 + (swz % 64) / 2; }
__host__ __device__ __forceinline__ int perm32(int rho) { const int n = rho >> 4, i = rho & 15; return 8 * (i >> 2) + 4 * n + (i & 3); }
struct Unit { int pm, pn; };
struct Gemm { const bf16_t* A; const bf16_t* Bt; int M, N, K; };
struct StaticOrder {
    int nM, nN, nwg, G, c;
    __host__ __device__ void init(int M, int N, int G_, int c_) { nM = M / BM; nN = N / BM; nwg = nM * nN; G = G_; c = c_; }
    __host__ __device__ bool next(int i, Unit& u) const {
        const long L = (long)i * G + c; if (L >= nwg) return false;
        int wgid = (int)L; { const int q = nwg / NXCD, r = nwg % NXCD, xcd = wgid % NXCD, off = wgid / NXCD; wgid = (xcd < r ? xcd * (q + 1) : r * (q + 1) + (xcd - r) * q) + off; }
        const int nig = WGM * nN, gid = wgid / nig, fm = gid * WGM, gsz = (nM - fm) < WGM ? (nM - fm) : WGM;
        u.pm = fm + ((wgid % nig) % gsz); u.pn = (wgid % nig) / gsz; return true;
    }
    __device__ __forceinline__ void a_ready(const Unit&) const {}
    __device__ __forceinline__ void done(const Unit&) const {}
};

struct EpiRoute {
    static constexpr bool PERM = true, AFTER_DRAIN = false;
    bf16_t* base[4]; int ld[4]; int t0, t1, t2;
    __device__ __forceinline__ void operator()(const f32x4 (&acc)[2][2][4][2], const Unit& u, int wr, int wc, int fr, int fq) const {
        const int row0 = u.pm * BM + wr * 64 + fr;
        bf16_t* b; int ldc, colt;
        if (u.pn < t0) { b = base[0]; ldc = ld[0]; colt = u.pn * BM; }
        else if (u.pn < t1) { b = base[1]; ldc = ld[1]; colt = (u.pn - t0) * BM; }
        else if (u.pn < t2) { b = base[2]; ldc = ld[2]; colt = (u.pn - t1) * BM; }
        else { b = base[3]; ldc = ld[3]; colt = (u.pn - t2) * BM; }
        const int col0 = colt + wc * 32 + 8 * fq;
#pragma unroll
        for (int ai = 0; ai < 2; ++ai)
#pragma unroll
            for (int m = 0; m < 4; ++m) {
                const int row = row0 + ai * HALF + m * 16;
                {
                    bf16_t* rowp = b + (size_t)row * ldc + col0;
#pragma unroll
                    for (int bj = 0; bj < 2; ++bj) {
                        const f32x4 v0 = acc[ai][bj][m][0], v1 = acc[ai][bj][m][1];
                        u32x4 w; w.x = pk2(v0[0], v0[1]); w.y = pk2(v0[2], v0[3]); w.z = pk2(v1[0], v1[1]); w.w = pk2(v1[2], v1[3]);
                        *(u32x4*)(rowp + bj * HALF) = w;
                    }
                }
            }
    }
};
struct EpiResid {
    static constexpr bool PERM = false, AFTER_DRAIN = false;
    const float* xsrc; float* xdst; const float* xcsrc; float* xcdst; const float* mods;
    __device__ __forceinline__ void operator()(const f32x4 (&acc)[2][2][4][2], const Unit& u, int wr, int wc, int fr, int fq) const {
        const int row0 = u.pm * BM + wr * 64 + fr, col0 = u.pn * BM + wc * 32 + 4 * fq;
#pragma unroll
        for (int ai = 0; ai < 2; ++ai)
#pragma unroll
            for (int m = 0; m < 4; ++m) {
                const int row = row0 + ai * HALF + m * 16;
                const float* src; float* dst; const float* gt;
                if (row < NLAT) { src = xsrc + (size_t)row * DM; dst = xdst + (size_t)row * DM; gt = mods + (row >> 11) * 3072 + 2048; }
                else { const int r2 = row - NLAT; src = xcsrc + (size_t)r2 * DM; dst = xcdst + (size_t)r2 * DM; gt = mods + 8 * 3072 + 2048; }
#pragma unroll
                for (int bj = 0; bj < 2; ++bj)
#pragma unroll
                    for (int n = 0; n < 2; ++n) {
                        const int col = col0 + bj * HALF + n * 16;
                        const f32x4 xs = *(const f32x4*)(src + col), g = *(const f32x4*)(gt + col);
                        *(f32x4*)(dst + col) = xs + g * acc[ai][bj][m][n];
                    }
            }
    }
};

template <class Epi, class Sched, bool ALIGN_EPI = false, bool SP2 = false>
__device__ __forceinline__ void gemm_phase(LAS unsigned char* lds, const Gemm g, const Sched& S, const Epi& E, const int tid) {
    const int wid = __builtin_amdgcn_readfirstlane(tid >> 6), lane = tid & 63, wr = wid >> 2, wc = wid & 3, fr = lane & 15, fq = lane >> 4;
    const int K = g.K, nt = K / BK;
    unsigned voffA[2], voffB[2];
#pragma unroll
    for (int i = 0; i < 2; ++i) { int R, C; stage_rc(tid * 16 + i * 8192, R, C); const int Rb = Epi::PERM ? ((R & ~31) + perm32(R & 31)) : R;
        voffA[i] = (unsigned)(R * K + C) * 2u; voffB[i] = (unsigned)(Rb * K + C) * 2u; }
    const size_t kstep = (size_t)(BK * 2);
    const size_t hstep = (size_t)HALF * K * 2;
    const size_t tstep = 2 * hstep;
    const unsigned ldsw = (unsigned)wid * 1024u;
    const int aoff = lds_byte(wr * 64 + fr, fq * 8), boff = lds_byte(wc * 32 + fr, fq * 8);
#define PG8_SA(b, h) (((b) * 2 + (h)) * HTB)
#define PG8_SB(b, h) ((4 + (b) * 2 + (h)) * HTB)
#define PG8_STAGE(bufoff, gbase, voff) do { _Pragma("unroll") for (int _i = 0; _i < 2; ++_i) \
        __builtin_amdgcn_global_load_lds((const unsigned*)((const char*)(gbase) + (voff)[_i]), (LAS unsigned*)(lds + (bufoff) + ldsw + _i * 8192), 16, 0, 0); } while (0)
#define PG8_LDA(dst, b, h) do { _Pragma("unroll") for (int m = 0; m < 4; ++m) _Pragma("unroll") for (int k = 0; k < 2; ++k) dst[m][k] = *(const LAS bf16x8*)(lds + PG8_SA(b, h) + aoff + m * 2048 + k * 1024); } while (0)
#define PG8_LDB(dst, b, h) do { _Pragma("unroll") for (int n = 0; n < 2; ++n) _Pragma("unroll") for (int k = 0; k < 2; ++k) dst[n][k] = *(const LAS bf16x8*)(lds + PG8_SB(b, h) + boff + n * 2048 + k * 1024); } while (0)
#define PG8_MMA(ai, bj, At, Bt) do { __builtin_amdgcn_s_setprio(1); _Pragma("unroll") for (int m = 0; m < 4; ++m) _Pragma("unroll") for (int n = 0; n < 2; ++n) _Pragma("unroll") for (int k = 0; k < 2; ++k) \
        acc[ai][bj][m][n] = __builtin_amdgcn_mfma_f32_16x16x32_bf16(Bt[n][k], At[m][k], acc[ai][bj][m][n], 0, 0, 0); __builtin_amdgcn_s_setprio(0); } while (0)
#define PG8_WAIT_V(n) asm volatile("s_waitcnt vmcnt(" #n ")" ::: "memory")
#define PG8_WAIT_L(n) asm volatile("s_waitcnt lgkmcnt(" #n ")" ::: "memory")
#define PG8_BAR __builtin_amdgcn_s_barrier()
#define PG8_SCHED __builtin_amdgcn_sched_barrier(0)
    Unit cur, nxt; int ui = 0;
    if (!S.next(0, cur)) return;
    f32x4 acc[2][2][4][2];
#pragma unroll
    for (int a = 0; a < 2; ++a)
#pragma unroll
        for (int b = 0; b < 2; ++b)
#pragma unroll
            for (int m = 0; m < 4; ++m)
#pragma unroll
                for (int n = 0; n < 2; ++n) acc[a][b][m][n] = (f32x4){0.f, 0.f, 0.f, 0.f};
    bf16x8 At[4][2], B0[2][2], B1[2][2];
    const char* cA = (const char*)g.A + (size_t)cur.pm * tstep; const char* cB = (const char*)g.Bt + (size_t)cur.pn * tstep;
    S.a_ready(cur);
    if constexpr (SP2) {
        PG8_STAGE(PG8_SB(0, 0), cB, voffB); PG8_STAGE(PG8_SB(0, 1), cB + hstep, voffB); PG8_STAGE(PG8_SA(0, 0), cA, voffA); PG8_STAGE(PG8_SA(0, 1), cA + hstep, voffA);
        if (wr == 1) PG8_BAR;
        PG8_WAIT_V(2); PG8_BAR;
        PG8_STAGE(PG8_SB(1, 0), cB + kstep, voffB); PG8_STAGE(PG8_SA(1, 0), cA + kstep, voffA); PG8_STAGE(PG8_SB(1, 1), cB + hstep + kstep, voffB);
        PG8_WAIT_V(6); PG8_BAR;
    } else {
        PG8_STAGE(PG8_SB(0, 0), cB, voffB); PG8_STAGE(PG8_SA(0, 0), cA, voffA); PG8_STAGE(PG8_SB(0, 1), cB + hstep, voffB); PG8_STAGE(PG8_SA(0, 1), cA + hstep, voffA);
        if (wr == 1) PG8_BAR;
        PG8_WAIT_V(4); PG8_BAR;
        PG8_STAGE(PG8_SB(1, 0), cB + kstep, voffB); PG8_STAGE(PG8_SA(1, 0), cA + kstep, voffA); PG8_STAGE(PG8_SB(1, 1), cB + hstep + kstep, voffB);
        PG8_WAIT_V(6); PG8_BAR;
    }
    for (;;) {
        const bool has_next = S.next(ui + 1, nxt);
        const char* nA = has_next ? (const char*)g.A + (size_t)nxt.pm * tstep : cA; const char* nB = has_next ? (const char*)g.Bt + (size_t)nxt.pn * tstep : cB;
        for (int t = 0; t < nt; t += 2) {
            const bool last = (t == nt - 2);
            const char* a1 = cA + (size_t)(t + 1) * kstep;
            const char* a2 = last ? nA : cA + (size_t)(t + 2) * kstep; const char* b2 = last ? nB : cB + (size_t)(t + 2) * kstep;
            const char* a3 = a2 + kstep; const char* b3 = b2 + kstep;
            if (last && has_next) S.a_ready(nxt);
            if constexpr (SP2) {
            PG8_LDB(B0, 0, 0); PG8_LDB(B1, 0, 1); PG8_SCHED; PG8_LDA(At, 0, 0); PG8_STAGE(PG8_SA(1, 1), a1 + hstep, voffA);
            PG8_WAIT_V(8); PG8_WAIT_L(0); PG8_BAR; PG8_MMA(0, 0, At, B0); PG8_MMA(0, 1, At, B1); PG8_BAR; PG8_SCHED;
            PG8_LDA(At, 0, 1); PG8_STAGE(PG8_SB(0, 0), b2, voffB); PG8_STAGE(PG8_SB(0, 1), b2 + hstep, voffB); PG8_STAGE(PG8_SA(0, 0), a2, voffA);
            PG8_WAIT_V(8); PG8_WAIT_L(0); PG8_BAR; PG8_MMA(1, 0, At, B0); PG8_MMA(1, 1, At, B1); PG8_BAR; PG8_SCHED;
            PG8_LDB(B0, 1, 0); PG8_LDB(B1, 1, 1); PG8_SCHED; PG8_LDA(At, 1, 0); PG8_STAGE(PG8_SA(0, 1), a2 + hstep, voffA);
            PG8_WAIT_V(8); PG8_WAIT_L(0); PG8_BAR; PG8_MMA(0, 0, At, B0); PG8_MMA(0, 1, At, B1); PG8_BAR; PG8_SCHED;
            PG8_LDA(At, 1, 1); PG8_STAGE(PG8_SB(1, 0), b3, voffB); PG8_STAGE(PG8_SB(1, 1), b3 + hstep, voffB); PG8_STAGE(PG8_SA(1, 0), a3, voffA);
            PG8_WAIT_V(8); PG8_WAIT_L(0); PG8_BAR; PG8_MMA(1, 0, At, B0); PG8_MMA(1, 1, At, B1); PG8_BAR; PG8_SCHED;
            } else {
            PG8_LDB(B0, 0, 0); PG8_SCHED; PG8_LDA(At, 0, 0); PG8_STAGE(PG8_SA(1, 1), a1 + hstep, voffA);
            PG8_WAIT_L(8); PG8_BAR; PG8_WAIT_L(0); PG8_MMA(0, 0, At, B0); PG8_BAR; PG8_SCHED;
            PG8_LDB(B1, 0, 1); PG8_STAGE(PG8_SB(0, 0), b2, voffB);
            PG8_BAR; PG8_WAIT_L(0); PG8_MMA(0, 1, At, B1); PG8_BAR;
            PG8_LDA(At, 0, 1); PG8_STAGE(PG8_SA(0, 0), a2, voffA);
            PG8_BAR; PG8_WAIT_L(0); PG8_MMA(1, 0, At, B0); PG8_BAR; PG8_SCHED;
            PG8_STAGE(PG8_SB(0, 1), b2 + hstep, voffB);
            PG8_WAIT_V(6); PG8_BAR; PG8_MMA(1, 1, At, B1); PG8_BAR;
            PG8_LDB(B0, 1, 0); PG8_SCHED; PG8_LDA(At, 1, 0); PG8_STAGE(PG8_SA(0, 1), a2 + hstep, voffA);
            PG8_WAIT_L(8); PG8_BAR; PG8_WAIT_L(0); PG8_MMA(0, 0, At, B0); PG8_BAR; PG8_SCHED;
            PG8_LDB(B1, 1, 1); PG8_STAGE(PG8_SB(1, 0), b3, voffB);
            PG8_BAR; PG8_WAIT_L(0); PG8_MMA(0, 1, At, B1); PG8_BAR;
            PG8_LDA(At, 1, 1); PG8_STAGE(PG8_SA(1, 0), a3, voffA);
            PG8_BAR; PG8_WAIT_L(0); PG8_MMA(1, 0, At, B0); PG8_BAR; PG8_SCHED;
            PG8_STAGE(PG8_SB(1, 1), b3 + hstep, voffB);
            PG8_WAIT_V(6); PG8_BAR; PG8_MMA(1, 1, At, B1); PG8_BAR;
            }
        }
        if constexpr (ALIGN_EPI) { if (wr == 0) PG8_BAR; }
        if constexpr (!Epi::AFTER_DRAIN) { E(acc, cur, wr, wc, fr, fq); S.done(cur); }
        if (!has_next) break;
#pragma unroll
        for (int a = 0; a < 2; ++a)
#pragma unroll
            for (int b = 0; b < 2; ++b)
#pragma unroll
                for (int m = 0; m < 4; ++m)
#pragma unroll
                    for (int n = 0; n < 2; ++n) acc[a][b][m][n] = (f32x4){0.f, 0.f, 0.f, 0.f};
        cur = nxt; cA = nA; cB = nB; ++ui;
        if constexpr (ALIGN_EPI) { if (wr == 1) PG8_BAR; }
    }
    PG8_WAIT_V(0);
    if constexpr (!ALIGN_EPI) { if (wr == 0) PG8_BAR; }
    PG8_BAR;
#undef PG8_SA
#undef PG8_SB
#undef PG8_STAGE
#undef PG8_LDA
#undef PG8_LDB
#undef PG8_MMA
#undef PG8_WAIT_V
#undef PG8_WAIT_L
#undef PG8_BAR
#undef PG8_SCHED
}
}

struct Args { const float* in[37]; float* out; unsigned char* ws; };

enum { I_X = 0, I_C, I_CTX, I_CCTX, I_MODW, I_MODB, I_NORMG, I_EVWIN, I_EVWOUT, I_QAN, I_WUQ, I_KVAN, I_WUKV, I_QN, I_KN,
       I_MUP, I_MUN, I_W0, I_WUP, I_A0, I_AUP, I_KK, I_KA, I_RK, I_LNW, I_LNB, I_ODWIN, I_ODWOUT, I_CONVW, I_CONVB, I_BIASD,
       I_FW1, I_FB1, I_FW2, I_FB2, I_FWOUT, I_FREQ };

#define INP(i) (a.in[(i) + opq0])
__device__ __forceinline__ void transpose_item(const float* W, int ldw, int src_col0, bool valid, bf16_t* WT, int Kd, int dst_row0, int k0, LAS float* scr, int lane) {
    if (valid) {
#pragma unroll 8
        for (int i = 0; i < 32; ++i) { const int kk = 2 * i + (lane >> 5); scr[kk * 33 + (lane & 31)] = W[(size_t)(k0 + kk) * ldw + src_col0 + (lane & 31)]; }
    } else {
#pragma unroll 8
        for (int i = 0; i < 32; ++i) { const int kk = 2 * i + (lane >> 5); scr[kk * 33 + (lane & 31)] = 0.f; }
    }
    asm volatile("s_waitcnt vmcnt(0) lgkmcnt(0)" ::: "memory");
    const int c = lane & 7;
#pragma unroll
    for (int j = 0; j < 4; ++j) { const int n = (lane >> 3) + 8 * j; const LAS float* s = scr + (8 * c) * 33 + n;
        u32x4 o; o.x = pk2(s[0 * 33], s[1 * 33]); o.y = pk2(s[2 * 33], s[3 * 33]); o.z = pk2(s[4 * 33], s[5 * 33]); o.w = pk2(s[6 * 33], s[7 * 33]);
        *(u32x4*)(WT + (size_t)(dst_row0 + n) * Kd + k0 + 8 * c) = o; }
    asm volatile("s_waitcnt lgkmcnt(0)" ::: "memory");
}

__device__ __forceinline__ void norm_row(const float* xrow, const float* g, const float* md, bf16_t* orow, int lane) {
    const f32x4* xr = (const f32x4*)xrow + lane;
    f32x4 v[4]; float s = 0.f;
#pragma unroll
    for (int j = 0; j < 4; ++j) { v[j] = xr[64 * j]; s += (v[j].x * v[j].x + v[j].y * v[j].y) + (v[j].z * v[j].z + v[j].w * v[j].w); }
    const float rstd = 1.0f / sqrtf(wave_sum(s, lane) * (1.f / DM) + NORM_EPS);
    u32x2* o8 = (u32x2*)orow + lane;
#pragma unroll
    for (int j = 0; j < 4; ++j) {
        const f32x4 gg = ((const f32x4*)g)[lane + 64 * j], sh = ((const f32x4*)md)[lane + 64 * j], sc = ((const f32x4*)(md + 1024))[lane + 64 * j];
        const f32x4 y = (v[j] * rstd) * gg * (sc + 1.0f) + sh;
        u32x2 w; w.x = pk2(y.x, y.y); w.y = pk2(y.z, y.w); o8[64 * j] = w;
    }
}

__global__ void __launch_bounds__(NTHREADS, 2) mega_fwd(Args a) {
    extern __shared__ __attribute__((aligned(16))) unsigned char lds_raw[];
    cg::grid_group grid = cg::this_grid();
    LAS unsigned char* lds = (LAS unsigned char*)lds_raw;
    const int G = gridDim.x, bid = blockIdx.x;
    const int NGW = G * NWAVES;
#define PHASE_LOCALS \
    int tid = threadIdx.x; asm volatile("" : "+v"(tid)); \
    const int lane = tid & 63, wave = __builtin_amdgcn_readfirstlane(tid >> 6); \
    const int gw = bid * NWAVES + wave; \
    int opq0 = 0; asm volatile("" : "+s"(opq0)); \
    unsigned char* ws = a.ws + opq0; \
    (void)lane; (void)wave; (void)gw; (void)ws; (void)opq0;
#define MODS ((float*)(ws + OFF_MODS))
#define BONUS ((float*)(ws + OFF_BONUS))
#define HDN ((float*)(ws + OFF_HDN))
#define XC ((float*)(ws + OFF_XC))
#define BIG (ws + OFF_BIG)
#define WIN ((bf16_t*)(ws + OFF_WTS + W_IN))
#define WOUT ((bf16_t*)(ws + OFF_WTS + W_OUT))
#define WUQ ((bf16_t*)(ws + OFF_WTS + W_UQ))
#define WUKV ((bf16_t*)(ws + OFF_WTS + W_UKV))

    if (EN_P0) {
        PHASE_LOCALS
        LAS float* sc = (LAS float*)lds;
        LAS float* red = (LAS float*)(lds + 9 * 1024 * 4);
        bool have_silu = false;
        for (int it = bid; it < 4 * 48; it += G) {
            if (!have_silu) {
                for (int i = tid; i < 9 * 1024; i += NTHREADS) { const float cv = (i < 8192) ? INP(I_C)[i] : INP(I_CCTX)[i - 8192]; sc[i] = silu_f(cv); }
                have_silu = true;
            }
            __syncthreads();
            const int layer = it / 48, cg0 = (it % 48) * 64, cl = tid & 63, kg = tid >> 6;
            const float* W = INP(I_MODW) + (size_t)layer * 1024 * 3072 + cg0 + cl;
            float acc[9];
#pragma unroll
            for (int r = 0; r < 9; ++r) acc[r] = 0.f;
            for (int k = kg * 128; k < kg * 128 + 128; ++k) {
                const float w = W[(size_t)k * 3072];
#pragma unroll
                for (int r = 0; r < 9; ++r) acc[r] += sc[r * 1024 + k] * w;
            }
#pragma unroll
            for (int r = 0; r < 9; ++r) red[(kg * 9 + r) * 64 + cl] = acc[r];
            __syncthreads();
            for (int idx = tid; idx < 9 * 64; idx += NTHREADS) {
                const int r = idx >> 6, c2 = idx & 63; float s = 0.f;
#pragma unroll
                for (int q = 0; q < 8; ++q) s += red[(q * 9 + r) * 64 + c2];
                MODS[((size_t)layer * 9 + r) * 3072 + cg0 + c2] = s + INP(I_MODB)[layer * 3072 + cg0 + c2];
            }
        }
        for (int it = gw; it < 2048 + 256 + 2048; it += NGW) {
            int o, Lf, pos; float* outp;
            if (it < 2048) { o = 0; Lf = 2048; pos = it; outp = HDN + (size_t)pos * 64; }
            else if (it < 2304) { o = 0; Lf = 256; pos = it - 2048; outp = HDN + (size_t)(2048 + pos) * 64; }
            else { o = 1; Lf = 2048; pos = it - 2304; outp = HDN + (size_t)(2304 + pos) * 64; }
            const float fpos = (float)pos, tt = fpos / (float)(Lf - 1);
            float z = 0.f;
            if (lane == 0) z = tt;
            else if (lane < 33) {
                const int bi = (lane - 1) & 15;
                const float band = 1e-4f + (float)bi * ((15.0f - 1e-4f) / 15.0f);
                const float ang = fpos * (6.283185307179586f / (float)Lf) * band;
                z = (lane < 17) ? cosf(ang) : -sinf(ang);
            }
            const float fr = INP(I_FREQ)[o * 64 + lane];
            float h = INP(I_FB1)[o * 64 + lane];
            const float* w1 = INP(I_FW1) + (size_t)o * 33 * 64;
            for (int i = 0; i < 33; ++i) h += bcast(z, i) * w1[i * 64 + lane];
            h = sinf(fr * h);
            for (int jj = 0; jj < 2; ++jj) {
                const float* w2 = INP(I_FW2) + ((size_t)o * 2 + jj) * 64 * 64;
                float h2 = INP(I_FB2)[(o * 2 + jj) * 64 + lane];
                for (int i = 0; i < 64; ++i) h2 += bcast(h, i) * w2[i * 64 + lane];
                h = sinf(fr * h2);
            }
            outp[lane] = h;
        }
    }
    grid.sync();

    for (int ph = 0; ph < 26; ++ph) {
        {
            PHASE_LOCALS
            int phs = ph; asm volatile("" : "+s"(phs));
            int layer, step;
            if (phs < 8) { layer = 0; step = phs; } else if (phs < 13) { layer = 1; step = phs - 8; } else if (phs < 21) { layer = 2; step = phs - 13; } else { layer = 3; step = phs - 21; }
            const bool even = !(layer & 1);
            const int e = layer >> 1;
            const bool ctx_out = (layer < 2);
            const bool ctx_in = (layer < 3);
            const int Mrows = ctx_in ? MTOT : NLAT;
            const int Mout = ctx_out ? MTOT : NLAT;
            const float* xsrc = (layer == 0) ? INP(I_X) : a.out;
            const float* xcsrc = (layer == 0) ? INP(I_CTX) : XC;
            const float* mods = MODS + (size_t)layer * 9 * 3072;
            int nroute = 0; bool resid = false;
            if (even) { if (step == 1) nroute = 1; else if (step == 3) nroute = 2; else if (step == 7) resid = true; }
            else { if (step == 1) nroute = 1; else if (step == 4) resid = true; }

            if (EN_NORM && step == 0) {
                bf16_t* H = (bf16_t*)(BIG + (even ? EV_E : OD_HV));
                const float* ng = INP(I_NORMG) + layer * 1024;
                for (int m = gw; m < Mrows; m += NGW) {
                    const float* xr; const float* md;
                    if (m < NLAT) { xr = xsrc + (size_t)m * DM; md = mods + (m >> 11) * 3072; }
                    else { xr = xcsrc + (size_t)(m - NLAT) * DM; md = mods + 8 * 3072; }
                    norm_row(xr, ng, md, H + (size_t)m * DM, lane);
                }
                LAS float* scr = (LAS float*)(lds + wave * 8448);
                if (even) {
                    const float* win = INP(I_EVWIN) + (size_t)e * 1024 * 3232;
                    const float* wout = INP(I_EVWOUT) + (size_t)e * 1024 * 1024;
                    const float* wuq = INP(I_WUQ) + (size_t)e * 256 * 768;
                    const float* wukv = INP(I_WUKV) + (size_t)e * 128 * 1024;
                    constexpr int N1 = 104 * 16, N2 = 32 * 16, N3 = 24 * 4, N4 = 32 * 4;
                    for (int it = gw; it < N1 + N2 + N3 + N4; it += NGW) {
                        int r = it;
                        if (r < N1) { const int nb = r / 16, kb = r % 16; const int d0 = nb * 32; int s0;
                            if (d0 < 1792) s0 = 416 + d0; else if (d0 < 2816) s0 = 2208 + (d0 - 1792); else if (d0 < 3072) s0 = d0 - 2816; else if (d0 < 3232) s0 = 256 + (d0 - 3072); else s0 = -1;
                            transpose_item(win, 3232, s0, s0 >= 0, WIN, 1024, d0, kb * 64, scr, lane); continue; }
                        r -= N1;
                        if (r < N2) { const int nb = r / 16, kb = r % 16; transpose_item(wout, 1024, nb * 32, true, WOUT, 1024, nb * 32, kb * 64, scr, lane); continue; }
                        r -= N2;
                        if (r < N3) { const int nb = r / 4, kb = r % 4; transpose_item(wuq, 768, nb * 32, true, WUQ, 256, nb * 32, kb * 64, scr, lane); continue; }
                        r -= N3;
                        { const int nb = r / 4, kb = r % 4; const int d0 = nb * 32; const int hh = (d0 & 511) >> 6, dd = d0 & 63; const int s0 = hh * 128 + dd + ((d0 >= 512) ? 64 : 0);
                          transpose_item(wukv, 1024, s0, kb < 2, WUKV, 256, d0, kb * 64, scr, lane); }
                    }
                } else {
                    const float* win = INP(I_ODWIN) + (size_t)e * 1024 * 4096;
                    const float* wout = INP(I_ODWOUT) + (size_t)e * 1024 * 1024;
                    constexpr int N1 = 128 * 16, N2 = 32 * 16;
                    for (int it = gw; it < N1 + N2; it += NGW) {
                        int r = it;
                        if (r < N1) { const int nb = r / 16, kb = r % 16; transpose_item(win, 4096, nb * 32, true, WIN, 1024, nb * 32, kb * 64, scr, lane); continue; }
                        r -= N1;
                        { const int nb = r / 16, kb = r % 16; transpose_item(wout, 1024, nb * 32, true, WOUT, 1024, nb * 32, kb * 64, scr, lane); }
                    }
                    __syncthreads();
                    float* FILT = (float*)(BIG + OD_FILT);
                    float* FILTC = FILT + (size_t)2 * 2048 * 1024;
                    LAS float* fred = (LAS float*)(lds + 8 * 8448);
                    const int nsel = (layer == 1) ? 2 : 1;
                    for (int it = bid; it < nsel * 128; it += G) {
                        const int sel = it >> 7, dir = (it >> 6) & 1, cg0 = (it & 63) * 16;
                        const int Lf = sel ? 256 : 2048;
                        const float* hd = HDN + (size_t)(e == 0 ? (sel ? 2048 : 0) : 2304) * 64;
                        float* fo = (sel ? FILTC : FILT);
                        const int ch = tid & 15, lg = tid >> 4, c = cg0 + ch;
                        const float* wo = INP(I_FWOUT) + (size_t)e * 64 * 2048 + dir * 1024 + c;
                        const float dstart = -15.350567286626973f, dstop = -3.0701134573253946f;
                        const float delta = fabsf(dstart + (float)c * ((dstop - dstart) / 1023.0f));
                        float asum = 0.f;
                        for (int l = lg; l < Lf; l += 32) {
                            float f = 0.f;
                            for (int j = 0; j < 64; ++j) f += hd[(size_t)l * 64 + j] * wo[(size_t)j * 2048];
                            const float tt = (float)l / (float)(Lf - 1);
                            f *= expf(-tt * delta);
                            if (dir == 1 && l == 0) { fo[c] = 0.f; }
                            else { fo[(size_t)(dir ? (Lf - l) : (Lf + l)) * 1024 + c] = f; asum += fabsf(f); }
                        }
                        fred[lg * 16 + ch] = asum;
                        __syncthreads();
                        if (tid < 16) { float s = 0.f; for (int q = 0; q < 32; ++q) s += fred[q * 16 + tid];
                            float* NS = HDN + (size_t)(2048 + 256 + 2048) * 64;
                            NS[((size_t)sel * 2 + dir) * 1024 + cg0 + tid] = s; }
                        __syncthreads();
                    }
                }
            } else if (EN_E2 && even && step == 2) {
                const bf16_t* PDQ = (const bf16_t*)(BIG + EV_F);
                bf16_t* QLAT = (bf16_t*)(BIG + EV_E); bf16_t* KVLAT = (bf16_t*)(BIG + EV_E + UU / 4);
                const float* qan = INP(I_QAN) + e * 256; const float* kvan = INP(I_KVAN) + e * 128;
                for (int m = gw; m < MTOT; m += NGW) {
                    const bf16_t* pr = PDQ + (size_t)m * 512;
                    const u32x2 wq = *(const u32x2*)(pr + 4 * lane);
                    const float q0 = bflo(wq.x), q1 = bfhi(wq.x), q2 = bflo(wq.y), q3 = bfhi(wq.y);
                    const float rq = 1.0f / sqrtf(wave_sum(q0 * q0 + q1 * q1 + q2 * q2 + q3 * q3, lane) * (1.f / 256.f) + NORM_EPS);
                    const f32x4 gq = *(const f32x4*)(qan + 4 * lane);
                    u32x2 oq; oq.x = pk2(q0 * rq * gq.x, q1 * rq * gq.y); oq.y = pk2(q2 * rq * gq.z, q3 * rq * gq.w);
                    *(u32x2*)(QLAT + (size_t)m * 256 + 4 * lane) = oq;
                    const unsigned wk = *(const unsigned*)(pr + 256 + 2 * lane);
                    const float k0 = bflo(wk), k1 = bfhi(wk);
                    const float rk = 1.0f / sqrtf(wave_sum(k0 * k0 + k1 * k1, lane) * (1.f / 128.f) + NORM_EPS);
                    *(unsigned*)(KVLAT + (size_t)m * 256 + 2 * lane) = pk2(k0 * rk * kvan[2 * lane], k1 * rk * kvan[2 * lane + 1]);
                    *(unsigned*)(KVLAT + (size_t)m * 256 + 128 + 2 * lane) = 0u;
                }
            } else if (EN_E4 && even && step == 4) {
                bf16_t* Q = (bf16_t*)(BIG + EV_C); bf16_t* K = (bf16_t*)(BIG + EV_G);
                const bf16_t* KNOPE = (const bf16_t*)(BIG + EV_E + UU / 2); const bf16_t* PDQ = (const bf16_t*)(BIG + EV_F);
                const float* qn = INP(I_QN) + e * 96; const float* kn = INP(I_KN) + e * 96;
                const int hh = lane >> 3, d0 = (lane & 7) * 12;
                for (int m = gw; m < MTOT; m += NGW) {
                    const bool lat = m < NLAT; const int t = m & 2047;
                    const float frow = (float)(t >> 6), fcol = (float)(t & 63);
#pragma unroll
                    for (int which = 0; which < 2; ++which) {
                        float v[12];
                        if (which == 0) {
                            const bf16_t* src = Q + (size_t)m * 768 + lane * 12;
#pragma unroll
                            for (int j = 0; j < 6; ++j) { const unsigned w = *(const unsigned*)(src + 2 * j); v[2 * j] = bflo(w); v[2 * j + 1] = bfhi(w); }
                        } else {
#pragma unroll
                            for (int j = 0; j < 12; ++j) { const int d = d0 + j;
                                v[j] = (d < 64) ? bf2f(KNOPE[(size_t)m * 512 + hh * 64 + d]) : bf2f(PDQ[(size_t)m * 512 + 384 + (d - 64)]); }
                        }
                        float ss = 0.f;
#pragma unroll
                        for (int j = 0; j < 12; ++j) ss += v[j] * v[j];
                        const float rs = 1.0f / sqrtf(sum8(ss, lane) * (1.f / 96.f) + NORM_EPS);
                        const float* gn = which ? kn : qn;
#pragma unroll
                        for (int j = 0; j < 12; ++j) v[j] = v[j] * rs * gn[d0 + j];
                        if (lat) {
#pragma unroll
                            for (int j = 0; j < 12; j += 2) { const int d = d0 + j;
                                if (d >= 64) { const int pi = (d - 64) >> 1;
                                    const float inv = powf(10000.0f, -(float)(pi & 7) / 8.0f);
                                    const float ang = ((pi < 8) ? frow : fcol) * inv;
                                    const float cs = cosf(ang), sn = sinf(ang);
                                    const float aa = v[j], bb = v[j + 1];
                                    v[j] = aa * cs - bb * sn; v[j + 1] = aa * sn + bb * cs; } }
                        }
                        bf16_t* dst = (which ? K : Q) + (size_t)m * 768 + lane * 12;
#pragma unroll
                        for (int j = 0; j < 6; ++j) *(unsigned*)(dst + 2 * j) = pk2(v[2 * j], v[2 * j + 1]);
                    }
                }
            } else if (EN_E5 && even && step == 5) {
                const int nscan = (G >= 256) ? 128 : (G / 2);
                if (EN_SCAN && bid < nscan) {
                    const bf16_t* PRW = (const bf16_t*)(BIG + ((layer == 0) ? 0 : 0) + EV_A);
                    bf16_t* OUT = (bf16_t*)(BIG + EV_E);
                    constexpr int TC = 32;
                    LAS float* WUPs = (LAS float*)lds;
                    LAS float* AUPs = WUPs + 4096;
                    LAS float* SH = AUPs + 4096;
                    LAS float* ST = SH + TC * 320;
                    const float* mup = INP(I_MUP) + e * 1792; const float* mun = INP(I_MUN) + e * 1792;
                    for (int chain = bid; chain < 128; chain += nscan) {
                        const int b = chain >> 4, hh = (chain >> 1) & 7, dir = chain & 1;
                        __syncthreads();
                        for (int i = tid; i < 4096; i += NTHREADS) { const int j = i >> 6, c = i & 63;
                            WUPs[i] = INP(I_WUP)[(((size_t)e * 2 + dir) * 64 + j) * 512 + hh * 64 + c];
                            AUPs[i] = INP(I_AUP)[(((size_t)e * 2 + dir) * 64 + j) * 512 + hh * 64 + c]; }
                        float S[8];
#pragma unroll
                        for (int j = 0; j < 8; ++j) S[j] = 0.f;
                        const int vrow = tid >> 3, ks = tid & 7;
                        for (int ch = 0; ch < 2304 / TC; ++ch) {
                            const int j0 = ch * TC; const bool isctx = j0 < 256; const int seglen = isctx ? 256 : 2048;
                            const int rowbase = isctx ? (NLAT + b * 256) : (b * 2048);
                            __syncthreads();
                            for (int i = tid; i < TC * 320; i += NTHREADS) {
                                const int s = i / 320, rem = i - s * 320, grp = rem >> 6, c = rem & 63;
                                const int jj = j0 + s; const int tt = isctx ? (dir ? 255 - jj : jj) : (dir ? 2047 - (jj - 256) : (jj - 256));
                                const int col = (grp < 3) ? (grp * 512 + hh * 64 + c) : ((grp == 3 ? 1536 : 1664) + dir * 64 + c);
                                const bf16_t* pp = PRW + (size_t)(rowbase + tt) * 1792 + col;
                                const float p = bf2f(pp[0]);
                                const float pv = (tt > 0) ? bf2f(pp[-1792]) : 0.f;
                                const float nx = (tt < seglen - 1) ? bf2f(pp[1792]) : 0.f;
                                float v = p + (pv - p) * mup[col] + (nx - p) * mun[col];
                                if (grp == 3) v = tanhf(v);
                                SH[i] = v;
                            }
                            __syncthreads();
                            {
                                const int c = lane, tq = wave;
                                float wz[4], az[4];
                                const float w0v = INP(I_W0)[((size_t)e * 2 + dir) * 512 + hh * 64 + c], a0v = INP(I_A0)[((size_t)e * 2 + dir) * 512 + hh * 64 + c];
#pragma unroll
                                for (int q = 0; q < 4; ++q) { wz[q] = w0v; az[q] = a0v; }
                                for (int j = 0; j < 64; ++j) {
                                    const float wu = WUPs[j * 64 + c], au = AUPs[j * 64 + c];
#pragma unroll
                                    for (int q = 0; q < 4; ++q) { const int s = tq * 4 + q; wz[q] += SH[s * 320 + 3 * 64 + j] * wu; az[q] += SH[s * 320 + 4 * 64 + j] * au; }
                                }
                                const float kkw = INP(I_KK)[e * 512 + hh * 64 + c], kaw = INP(I_KA)[e * 512 + hh * 64 + c];
                                const float rkw = INP(I_RK)[(((size_t)e * 2 + dir) * 8 + hh) * 64 + c];
#pragma unroll
                                for (int q = 0; q < 4; ++q) {
                                    const int s = tq * 4 + q;
                                    const float x = -wz[q];
                                    const float sp = fmaxf(x, 0.f) + log1pf(expf(-fabsf(x)));
                                    const float wlog = -sp - 0.5f;
                                    const float dec = expf(-expf(wlog));
                                    const float av = 1.0f / (1.0f + expf(-az[q]));
                                    const float rv = SH[s * 320 + c], kv = SH[s * 320 + 64 + c];
                                    const float kr = kv * kkw;
                                    const float nrm = wave_sum(kr * kr, lane);
                                    const float kkn = kr * (1.0f / sqrtf(fmaxf(nrm, 1e-24f)));
                                    const float kd = kv * (1.0f + (av - 1.0f) * kaw);
                                    const float bon = wave_sum(rv * kd * rkw, lane);
                                    ST[s * 320 + c] = -kkn; ST[s * 320 + 64 + c] = dec; ST[s * 320 + 128 + c] = kkn * av; ST[s * 320 + 192 + c] = kd; ST[s * 320 + 256 + c] = rv;
                                    if (lane == 0) { const int jj = j0 + s; const int tt = isctx ? (dir ? 255 - jj : jj) : (dir ? 2047 - (jj - 256) : (jj - 256));
                                        BONUS[((size_t)(rowbase + tt) * 2 + dir) * 8 + hh] = bon; }
                                }
                            }
                            __syncthreads();
                            for (int s = 0; s < TC; ++s) {
                                const LAS float* st = ST + s * 320 + ks * 8;
                                const f32x4 n0 = *(const LAS f32x4*)(st), n1 = *(const LAS f32x4*)(st + 4);
                                const f32x4 w0 = *(const LAS f32x4*)(st + 64), w1 = *(const LAS f32x4*)(st + 68);
                                const f32x4 b0 = *(const LAS f32x4*)(st + 128), b1 = *(const LAS f32x4*)(st + 132);
                                const f32x4 k0 = *(const LAS f32x4*)(st + 192), k1 = *(const LAS f32x4*)(st + 196);
                                const f32x4 r0 = *(const LAS f32x4*)(st + 256), r1 = *(const LAS f32x4*)(st + 260);
                                const float vv = SH[s * 320 + 128 + vrow];
                                float sa = (S[0] * n0.x + S[1] * n0.y) + (S[2] * n0.z + S[3] * n0.w) + (S[4] * n1.x + S[5] * n1.y) + (S[6] * n1.z + S[7] * n1.w);
                                sa = sum8(sa, lane);
                                S[0] = S[0] * w0.x + sa * b0.x + vv * k0.x; S[1] = S[1] * w0.y + sa * b0.y + vv * k0.y;
                                S[2] = S[2] * w0.z + sa * b0.z + vv * k0.z; S[3] = S[3] * w0.w + sa * b0.w + vv * k0.w;
                                S[4] = S[4] * w1.x + sa * b1.x + vv * k1.x; S[5] = S[5] * w1.y + sa * b1.y + vv * k1.y;
                                S[6] = S[6] * w1.z + sa * b1.z + vv * k1.z; S[7] = S[7] * w1.w + sa * b1.w + vv * k1.w;
                                float o = (S[0] * r0.x + S[1] * r0.y) + (S[2] * r0.z + S[3] * r0.w) + (S[4] * r1.x + S[5] * r1.y) + (S[6] * r1.z + S[7] * r1.w);
                                o = sum8(o, lane);
                                if (ks == 0) { const int jj = j0 + s; const int tt = isctx ? (dir ? 255 - jj : jj) : (dir ? 2047 - (jj - 256) : (jj - 256));
                                    OUT[((size_t)(rowbase + tt) * 2 + dir) * 512 + hh * 64 + vrow] = (bf16_t)f2bf(o); }
                            }
                        }
                    }
                } else if (EN_ATTN && bid >= nscan) {
                    bf16_t* Q = (bf16_t*)(BIG + EV_C); const bf16_t* K = (const bf16_t*)(BIG + EV_G); const bf16_t* V = (const bf16_t*)(BIG + EV_D);
                    const int nq = 131072 + (ctx_out ? 16384 : 0);
                    const int nab = G - nscan;
                    const float scale = 0.10206207261596575f;
                    for (int unit = bid - nscan; unit * NTHREADS < nq; unit += nab) {
                        const int qi = unit * NTHREADS + tid;
                        int b, hh, row, nk1, nk2;
                        if (qi < 131072) { b = qi >> 14; hh = (qi >> 11) & 7; row = b * 2048 + (qi & 2047); nk1 = 2048; nk2 = 256; }
                        else { const int q2 = qi - 131072; b = q2 >> 11; hh = (q2 >> 8) & 7; row = NLAT + b * 256 + (q2 & 255); nk1 = 0; nk2 = 256; }
                        float q[96];
                        { const bf16_t* qp = Q + (size_t)row * 768 + hh * 96;
#pragma unroll
                          for (int j = 0; j < 48; ++j) { const unsigned w = *(const unsigned*)(qp + 2 * j); q[2 * j] = bflo(w) * scale; q[2 * j + 1] = bfhi(w) * scale; } }
                        float o[64];
#pragma unroll
                        for (int j = 0; j < 64; ++j) o[j] = 0.f;
                        float mx = -1e30f, l = 0.f;
                        for (int seg = 0; seg < 2; ++seg) {
                            const int nk = seg ? nk2 : nk1; const int kr0 = seg ? (NLAT + b * 256) : (b * 2048);
                            for (int kk = 0; kk < nk; ++kk) {
                                const bf16_t* kp = K + (size_t)(kr0 + kk) * 768 + hh * 96;
                                float s = 0.f;
#pragma unroll
                                for (int j = 0; j < 12; ++j) { const u32x4 w = *(const u32x4*)(kp + 8 * j);
                                    s += q[8 * j] * bflo(w.x) + q[8 * j + 1] * bfhi(w.x) + q[8 * j + 2] * bflo(w.y) + q[8 * j + 3] * bfhi(w.y)
                                       + q[8 * j + 4] * bflo(w.z) + q[8 * j + 5] * bfhi(w.z) + q[8 * j + 6] * bflo(w.w) + q[8 * j + 7] * bfhi(w.w); }
                                const float mn = fmaxf(mx, s);
                                const float corr = __expf(mx - mn), p = __expf(s - mn);
                                mx = mn; l = l * corr + p;
                                const bf16_t* vp = V + (size_t)(kr0 + kk) * 512 + hh * 64;
#pragma unroll
                                for (int j = 0; j < 8; ++j) { const u32x4 w = *(const u32x4*)(vp + 8 * j);
                                    o[8 * j] = o[8 * j] * corr + p * bflo(w.x); o[8 * j + 1] = o[8 * j + 1] * corr + p * bfhi(w.x);
                                    o[8 * j + 2] = o[8 * j + 2] * corr + p * bflo(w.y); o[8 * j + 3] = o[8 * j + 3] * corr + p * bfhi(w.y);
                                    o[8 * j + 4] = o[8 * j + 4] * corr + p * bflo(w.z); o[8 * j + 5] = o[8 * j + 5] * corr + p * bfhi(w.z);
                                    o[8 * j + 6] = o[8 * j + 6] * corr + p * bflo(w.w); o[8 * j + 7] = o[8 * j + 7] * corr + p * bfhi(w.w); }
                            }
                        }
                        const float il = 1.0f / l;
                        bf16_t* op = Q + (size_t)row * 768 + hh * 96;
#pragma unroll
                        for (int j = 0; j < 32; ++j) *(unsigned*)(op + 2 * j) = pk2(o[2 * j] * il, o[2 * j + 1] * il);
                    }
                }
            } else if (EN_E6 && even && step == 6) {
                const bf16_t* O = (const bf16_t*)(BIG + EV_C); const bf16_t* PG = (const bf16_t*)(BIG + EV_B); const bf16_t* PRW = (const bf16_t*)(BIG + EV_A);
                const bf16_t* OUT = (const bf16_t*)(BIG + EV_E);
                bf16_t* U = (bf16_t*)(BIG + EV_D);
                const float* mup = INP(I_MUP) + e * 1792 + 1024; const float* mun = INP(I_MUN) + e * 1792 + 1024;
                const float* lnw = INP(I_LNW) + e * 512; const float* lnb = INP(I_LNB) + e * 512;
                for (int m = gw; m < Mout; m += NGW) {
                    const int hh = lane >> 3, ch0 = lane * 8;
                    {
                        const u32x4 ow = *(const u32x4*)(O + (size_t)m * 768 + hh * 96 + (lane & 7) * 8);
                        const u32x4 gwd = *(const u32x4*)(PG + (size_t)m * 1024 + ch0);
                        u32x4 r;
                        r.x = pk2(bflo(ow.x) * silu_f(bflo(gwd.x)), bfhi(ow.x) * silu_f(bfhi(gwd.x)));
                        r.y = pk2(bflo(ow.y) * silu_f(bflo(gwd.y)), bfhi(ow.y) * silu_f(bfhi(gwd.y)));
                        r.z = pk2(bflo(ow.z) * silu_f(bflo(gwd.z)), bfhi(ow.z) * silu_f(bfhi(gwd.z)));
                        r.w = pk2(bflo(ow.w) * silu_f(bflo(gwd.w)), bfhi(ow.w) * silu_f(bfhi(gwd.w)));
                        *(u32x4*)(U + (size_t)m * 1024 + ch0) = r;
                    }
                    {
                        const u32x4 o0 = *(const u32x4*)(OUT + ((size_t)m * 2 + 0) * 512 + ch0), o1 = *(const u32x4*)(OUT + ((size_t)m * 2 + 1) * 512 + ch0);
                        float ov[8];
                        ov[0] = bflo(o0.x) + bflo(o1.x); ov[1] = bfhi(o0.x) + bfhi(o1.x); ov[2] = bflo(o0.y) + bflo(o1.y); ov[3] = bfhi(o0.y) + bfhi(o1.y);
                        ov[4] = bflo(o0.z) + bflo(o1.z); ov[5] = bfhi(o0.z) + bfhi(o1.z); ov[6] = bflo(o0.w) + bflo(o1.w); ov[7] = bfhi(o0.w) + bfhi(o1.w);
                        float s = 0.f;
#pragma unroll
                        for (int j = 0; j < 8; ++j) s += ov[j];
                        const float mu = sum8(s, lane) * (1.f / 64.f);
                        float s2 = 0.f;
#pragma unroll
                        for (int j = 0; j < 8; ++j) { ov[j] -= mu; s2 += ov[j] * ov[j]; }
                        const float rstd = 1.0f / sqrtf(sum8(s2, lane) * (1.f / 64.f) + 64e-5f);
                        const float bon = BONUS[((size_t)m * 2 + 0) * 8 + hh] + BONUS[((size_t)m * 2 + 1) * 8 + hh];
                        const bool lat = m < NLAT; const int tt = lat ? (m & 2047) : ((m - NLAT) & 255); const int seglen = lat ? 2048 : 256;
                        const bf16_t* pp = PRW + (size_t)m * 1792 + 1024 + ch0;
                        const u32x4 pc = *(const u32x4*)pp;
                        u32x4 pv = (u32x4){0u, 0u, 0u, 0u}, pn = (u32x4){0u, 0u, 0u, 0u};
                        if (tt > 0) pv = *(const u32x4*)(pp - 1792);
                        if (tt < seglen - 1) pn = *(const u32x4*)(pp + 1792);
                        const u32x4 gwd = *(const u32x4*)(PG + (size_t)m * 1024 + 512 + ch0);
                        float res[8];
#pragma unroll
                        for (int j = 0; j < 8; ++j) {
                            const unsigned wc_ = (j < 2) ? pc.x : (j < 4) ? pc.y : (j < 6) ? pc.z : pc.w;
                            const unsigned wp_ = (j < 2) ? pv.x : (j < 4) ? pv.y : (j < 6) ? pv.z : pv.w;
                            const unsigned wn_ = (j < 2) ? pn.x : (j < 4) ? pn.y : (j < 6) ? pn.z : pn.w;
                            const unsigned wg_ = (j < 2) ? gwd.x : (j < 4) ? gwd.y : (j < 6) ? gwd.z : gwd.w;
                            const float p = (j & 1) ? bfhi(wc_) : bflo(wc_), pr = (j & 1) ? bfhi(wp_) : bflo(wp_), nx = (j & 1) ? bfhi(wn_) : bflo(wn_);
                            const float gg = (j & 1) ? bfhi(wg_) : bflo(wg_);
                            const float vs = p + (pr - p) * mup[ch0 + j] + (nx - p) * mun[ch0 + j];
                            const float on = ov[j] * rstd * lnw[ch0 + j] + lnb[ch0 + j] + bon * vs;
                            res[j] = on * silu_f(gg);
                        }
                        u32x4 r; r.x = pk2(res[0], res[1]); r.y = pk2(res[2], res[3]); r.z = pk2(res[4], res[5]); r.w = pk2(res[6], res[7]);
                        *(u32x4*)(U + (size_t)m * 1024 + 512 + ch0) = r;
                    }
                }
            } else if (EN_O2 && !even && step == 2) {
                const bf16_t* P0 = (const bf16_t*)(BIG + OD_P); const bf16_t* P1 = (const bf16_t*)(BIG + OD_P + UU); const bf16_t* P2 = (const bf16_t*)(BIG + OD_P + 2 * UU);
                bf16_t* P3 = (bf16_t*)(BIG + OD_P + 3 * UU); bf16_t* VX = (bf16_t*)(BIG + OD_HV);
                const float* cw = INP(I_CONVW) + (size_t)e * 3 * 3072; const float* cb = INP(I_CONVB) + (size_t)e * 3072;
                for (int m = gw; m < Mrows; m += NGW) {
                    const bool lat = m < NLAT; const int tt = lat ? (m & 2047) : ((m - NLAT) & 255); const int seglen = lat ? 2048 : 256;
                    const bool hp = tt > 0, hn = tt < seglen - 1;
#pragma unroll
                    for (int j = 0; j < 2; ++j) {
                        const int c0 = lane * 8 + j * 512;
                        float cv[3][8];
#pragma unroll
                        for (int part = 0; part < 3; ++part) {
                            const bf16_t* pp = ((part == 0) ? P0 : (part == 1) ? P1 : P2) + (size_t)m * 1024 + c0;
                            const u32x4 wc_ = *(const u32x4*)pp;
                            u32x4 wp_ = (u32x4){0u, 0u, 0u, 0u}, wn_ = (u32x4){0u, 0u, 0u, 0u};
                            if (hp) wp_ = *(const u32x4*)(pp - 1024);
                            if (hn) wn_ = *(const u32x4*)(pp + 1024);
                            const float* w0 = cw + part * 1024 + c0; const float* w1 = cw + 3072 + part * 1024 + c0; const float* w2 = cw + 6144 + part * 1024 + c0;
                            const float* bb = cb + part * 1024 + c0;
#pragma unroll
                            for (int q = 0; q < 8; ++q) {
                                const unsigned a_ = (q < 2) ? wc_.x : (q < 4) ? wc_.y : (q < 6) ? wc_.z : wc_.w;
                                const unsigned p_ = (q < 2) ? wp_.x : (q < 4) ? wp_.y : (q < 6) ? wp_.z : wp_.w;
                                const unsigned n_ = (q < 2) ? wn_.x : (q < 4) ? wn_.y : (q < 6) ? wn_.z : wn_.w;
                                const float cc = (q & 1) ? bfhi(a_) : bflo(a_), pr = (q & 1) ? bfhi(p_) : bflo(p_), nx = (q & 1) ? bfhi(n_) : bflo(n_);
                                cv[part][q] = pr * w0[q] + cc * w1[q] + nx * w2[q] + bb[q];
                            }
                        }
                        const u32x4 gw_ = *(const u32x4*)(P3 + (size_t)m * 1024 + c0);
                        float vx[8], zz[8];
#pragma unroll
                        for (int q = 0; q < 8; ++q) {
                            const unsigned g_ = (q < 2) ? gw_.x : (q < 4) ? gw_.y : (q < 6) ? gw_.z : gw_.w;
                            const float gg = (q & 1) ? bfhi(g_) : bflo(g_);
                            vx[q] = cv[2][q] * cv[1][q]; zz[q] = cv[0][q] * silu_f(gg);
                        }
                        u32x4 r; r.x = pk2(vx[0], vx[1]); r.y = pk2(vx[2], vx[3]); r.z = pk2(vx[4], vx[5]); r.w = pk2(vx[6], vx[7]);
                        *(u32x4*)(VX + (size_t)m * 1024 + c0) = r;
                        u32x4 r2; r2.x = pk2(zz[0], zz[1]); r2.y = pk2(zz[2], zz[3]); r2.z = pk2(zz[4], zz[5]); r2.w = pk2(zz[6], zz[7]);
                        *(u32x4*)(P3 + (size_t)m * 1024 + c0) = r2;
                    }
                }
            } else if (EN_O3 && !even && step == 3) {
                const bf16_t* VX = (const bf16_t*)(BIG + OD_HV); const bf16_t* Z = (const bf16_t*)(BIG + OD_P + 3 * UU);
                bf16_t* U2 = (bf16_t*)(BIG + OD_P + UU);
                const float* FILT = (const float*)(BIG + OD_FILT); const float* FILTC = FILT + (size_t)2 * 2048 * 1024;
                const float* NS = HDN + (size_t)(2048 + 256 + 2048) * 64;
                const float* bd = INP(I_BIASD) + e * 1024;
                for (int item = bid; item < Mrows / 4; item += G) {
                    const int m0 = item * 4;
                    const bool lat = m0 < NLAT; const int tt0 = lat ? (m0 & 2047) : ((m0 - NLAT) & 255); const int Lf = lat ? 2048 : 256;
                    const int r0 = m0 - tt0; const int sel = lat ? 0 : 1;
                    const float* FU = lat ? FILT : FILTC;
                    const int c = 2 * tid;
                    float2 w0 = *(const float2*)(FU + (size_t)(tt0 + 0 + Lf) * 1024 + c), w1 = *(const float2*)(FU + (size_t)(tt0 + 1 + Lf) * 1024 + c);
                    float2 w2 = *(const float2*)(FU + (size_t)(tt0 + 2 + Lf) * 1024 + c), w3 = *(const float2*)(FU + (size_t)(tt0 + 3 + Lf) * 1024 + c);
                    float ya[4] = {0.f, 0.f, 0.f, 0.f}, yb[4] = {0.f, 0.f, 0.f, 0.f};
                    for (int s = 0; s < Lf; ++s) {
                        const unsigned w = *(const unsigned*)(VX + (size_t)(r0 + s) * 1024 + c);
                        const float va = bflo(w), vb = bfhi(w);
                        ya[0] += va * w0.x; yb[0] += vb * w0.y; ya[1] += va * w1.x; yb[1] += vb * w1.y;
                        ya[2] += va * w2.x; yb[2] += vb * w2.y; ya[3] += va * w3.x; yb[3] += vb * w3.y;
                        w3 = w2; w2 = w1; w1 = w0; w0 = *(const float2*)(FU + (size_t)(tt0 - s - 1 + Lf) * 1024 + c);
                    }
                    const float n0 = 1.0f / (NS[((size_t)sel * 2 + 0) * 1024 + c] + NS[((size_t)sel * 2 + 1) * 1024 + c]);
                    const float n1 = 1.0f / (NS[((size_t)sel * 2 + 0) * 1024 + c + 1] + NS[((size_t)sel * 2 + 1) * 1024 + c + 1]);
#pragma unroll
                    for (int i = 0; i < 4; ++i) {
                        const int m = m0 + i;
                        const unsigned wv = *(const unsigned*)(VX + (size_t)m * 1024 + c), wz = *(const unsigned*)(Z + (size_t)m * 1024 + c);
                        const float u0 = (ya[i] * n0 + bflo(wv) * bd[c]) * bflo(wz), u1 = (yb[i] * n1 + bfhi(wv) * bd[c + 1]) * bfhi(wz);
                        *(unsigned*)(U2 + (size_t)m * 1024 + c) = pk2(u0, u1);
                    }
                }
            }

            for (int jb = 0; EN_GR && jb < nroute; ++jb) {
                pg8::Gemm g; pg8::EpiRoute E;
                if (even && step == 1) {
                    g = pg8::Gemm{(const bf16_t*)(BIG + EV_E), WIN, MTOT, 3328, 1024};
                    E.base[0] = (bf16_t*)(BIG + EV_A); E.ld[0] = 1792; E.base[1] = (bf16_t*)(BIG + EV_B); E.ld[1] = 1024; E.base[2] = (bf16_t*)(BIG + EV_F); E.ld[2] = 512;
                    E.base[3] = E.base[2]; E.ld[3] = 512; E.t0 = 7; E.t1 = 11; E.t2 = 64;
                } else if (even && jb == 0) {
                    g = pg8::Gemm{(const bf16_t*)(BIG + EV_E), WUQ, MTOT, 768, 256};
                    E.base[0] = (bf16_t*)(BIG + EV_C); E.ld[0] = 768; E.base[1] = E.base[0]; E.ld[1] = 768; E.base[2] = E.base[0]; E.ld[2] = 768; E.base[3] = E.base[0]; E.ld[3] = 768;
                    E.t0 = 64; E.t1 = 64; E.t2 = 64;
                } else if (even) {
                    g = pg8::Gemm{(const bf16_t*)(BIG + EV_E + UU / 4), WUKV, MTOT, 1024, 256};
                    E.base[0] = (bf16_t*)(BIG + EV_E + UU / 2); E.ld[0] = 512; E.base[1] = (bf16_t*)(BIG + EV_D); E.ld[1] = 512; E.base[2] = E.base[1]; E.ld[2] = 512; E.base[3] = E.base[1]; E.ld[3] = 512;
                    E.t0 = 2; E.t1 = 64; E.t2 = 64;
                } else {
                    g = pg8::Gemm{(const bf16_t*)(BIG + OD_HV), WIN, Mrows, 4096, 1024};
                    E.base[0] = (bf16_t*)(BIG + OD_P); E.base[1] = (bf16_t*)(BIG + OD_P + UU); E.base[2] = (bf16_t*)(BIG + OD_P + 2 * UU); E.base[3] = (bf16_t*)(BIG + OD_P + 3 * UU);
                    E.ld[0] = E.ld[1] = E.ld[2] = E.ld[3] = 1024; E.t0 = 4; E.t1 = 8; E.t2 = 12;
                }
                pg8::StaticOrder S; S.init(g.M, g.N, G, bid);
                pg8::gemm_phase<pg8::EpiRoute, pg8::StaticOrder, true, true>(lds, g, S, E, tid);
            }
            if (EN_GS && resid) {
                pg8::Gemm g{(const bf16_t*)(BIG + (even ? EV_D : (OD_P + UU))), WOUT, Mout, 1024, 1024};
                pg8::EpiResid E{xsrc, a.out, xcsrc, XC, mods};
                pg8::StaticOrder S; S.init(g.M, g.N, G, bid);
                pg8::gemm_phase<pg8::EpiResid, pg8::StaticOrder, true, true>(lds, g, S, E, tid);
            }
            grid.sync();
        }
    }
}

extern "C" void kernel_launch(void* const* d_in, const int* in_sizes, int n_in, void* d_out, int out_size,
                              void* d_ws, size_t ws_size, hipStream_t stream) {
    static int grid_blocks = 0;
    if (!grid_blocks) {
        int dev = 0, cus = 0, per_cu = 0;
        (void)hipGetDevice(&dev);
        (void)hipDeviceGetAttribute(&cus, hipDeviceAttributeMultiprocessorCount, dev);
        (void)hipFuncSetAttribute((const void*)mega_fwd, hipFuncAttributeMaxDynamicSharedMemorySize, LDS_BYTES);
        (void)hipOccupancyMaxActiveBlocksPerMultiprocessor(&per_cu, (const void*)mega_fwd, NTHREADS, LDS_BYTES);
        if (per_cu < 1) per_cu = 1;
        if (per_cu > 1) per_cu = 1;
        grid_blocks = cus * per_cu;
        if (n_in != 37 || ws_size < 268435456) fprintf(stderr, "kernel_launch: unexpected n_in %d / ws %zu\n", n_in, ws_size);
    }
    Args a{};
    for (int i = 0; i < 37 && i < n_in; ++i) a.in[i] = (const float*)d_in[i];
    a.out = (float*)d_out; a.ws = (unsigned char*)d_ws;
    void* args[] = {&a};
    hipError_t e = hipLaunchCooperativeKernel((const void*)mega_fwd, dim3(grid_blocks), dim3(NTHREADS), args, LDS_BYTES, stream);
    if (e != hipSuccess) fprintf(stderr, "cooperative launch failed: %s (grid %d)\n", hipGetErrorString(e), grid_blocks);
}
```

```cpp
#include <hip/hip_runtime.h>
#include <hip/hip_cooperative_groups.h>
#include <cstdio>
#include <cstdint>
namespace cg = cooperative_groups;

#define LAS __attribute__((address_space(3)))
#define GAS __attribute__((address_space(1)))
typedef unsigned short bf16_t;
typedef short bf16x8 __attribute__((ext_vector_type(8)));
typedef float f32x4 __attribute__((ext_vector_type(4)));
typedef unsigned u32x4 __attribute__((ext_vector_type(4)));
typedef unsigned u32x2 __attribute__((ext_vector_type(2)));

#ifndef EN_P0
#define EN_P0 1
#endif
#ifndef EN_NORM
#define EN_NORM 1
#endif
#ifndef EN_E2
#define EN_E2 1
#endif
#ifndef EN_E4
#define EN_E4 1
#endif
#ifndef EN_E5
#define EN_E5 1
#endif
#ifndef EN_SCAN
#define EN_SCAN 1
#endif
#ifndef EN_ATTN
#define EN_ATTN 1
#endif
#ifndef EN_E6
#define EN_E6 1
#endif
#ifndef EN_O2
#define EN_O2 1
#endif
#ifndef EN_O3
#define EN_O3 1
#endif
#ifndef EN_GR
#define EN_GR 1
#endif
#ifndef EN_GS
#define EN_GS 1
#endif
constexpr int NB = 8, SEQ = 2048, DM = 1024, CTXL = 256;
constexpr int NLAT = NB * SEQ;
constexpr int NCTX = NB * CTXL;
constexpr int MTOT = NLAT + NCTX;
constexpr int NTHREADS = 512, NWAVES = 8;
constexpr int LDS_BYTES = 147456;
constexpr float NORM_EPS = 1e-6f;

constexpr size_t UU = (size_t)MTOT * 1024 * 2;
constexpr size_t MiB = 1u << 20;
constexpr size_t OFF_MODS = 0;
constexpr size_t OFF_BONUS = MiB / 2;
constexpr size_t OFF_HDN = 2 * MiB;
constexpr size_t OFF_WTS = 4 * MiB;
constexpr size_t OFF_XC = 15 * MiB;
constexpr size_t OFF_BIG = 23 * MiB;
constexpr size_t EV_A = 0;
constexpr size_t EV_B = EV_A + UU * 7 / 4;
constexpr size_t EV_C = EV_B + UU;
constexpr size_t EV_D = EV_C + UU * 3 / 4;
constexpr size_t EV_F = EV_D + UU / 2;
constexpr size_t EV_E = EV_F + UU / 2;
constexpr size_t EV_G = EV_E + UU;
constexpr size_t EV_END = EV_G + UU * 3 / 4;
constexpr size_t OD_P = 0;
constexpr size_t OD_HV = 4 * UU;
constexpr size_t OD_FILT = 5 * UU;
constexpr size_t OD_END = OD_FILT + (size_t)2 * 2048 * 1024 * 4 + (size_t)2 * 256 * 1024 * 4;
static_assert(OFF_BIG + EV_END <= 268435456 && OFF_BIG + OD_END <= 268435456, "ws map");
constexpr size_t W_IN = 0;
constexpr size_t W_OUT = (size_t)4096 * 1024 * 2;
constexpr size_t W_UQ = W_OUT + (size_t)1024 * 1024 * 2;
constexpr size_t W_UKV = W_UQ + (size_t)768 * 256 * 2;
static_assert(W_UKV + (size_t)1024 * 256 * 2 <= 11 * MiB, "weights region");

__device__ __forceinline__ unsigned f2bf(float f) { unsigned u = __builtin_bit_cast(unsigned, f); return (u + 0x7fffu + ((u >> 16) & 1u)) >> 16; }
__device__ __forceinline__ unsigned pk2(float lo, float hi) { return f2bf(lo) | (f2bf(hi) << 16); }
__device__ __forceinline__ float bf2f(unsigned h) { return __builtin_bit_cast(float, (h & 0xffffu) << 16); }
__device__ __forceinline__ float bflo(unsigned w) { return __builtin_bit_cast(float, w << 16); }
__device__ __forceinline__ float bfhi(unsigned w) { return __builtin_bit_cast(float, w & 0xffff0000u); }
__device__ __forceinline__ float shx(float v, int m, int lane) { return __builtin_bit_cast(float, __builtin_amdgcn_ds_bpermute((lane ^ m) << 2, __builtin_bit_cast(int, v))); }
__device__ __forceinline__ float bcast(float v, int src) { return __builtin_bit_cast(float, __builtin_amdgcn_readlane(__builtin_bit_cast(int, v), src)); }
__device__ __forceinline__ float wave_sum(float v, int lane) {
#pragma unroll
    for (int o = 1; o < 64; o <<= 1) v += shx(v, o, lane);
    return v;
}
__device__ __forceinline__ float sum8(float v, int lane) { v += shx(v, 1, lane); v += shx(v, 2, lane); v += shx(v, 4, lane); return v; }
__device__ __forceinline__ float silu_f(float x) { return x / (1.0f + __expf(-x)); }
__device__ __forceinline__ float sigmoid_f(float x) { return 1.0f / (1.0f + __expf(-x)); }

namespace pg8 {
constexpr int BM = 256, BK = 64, HALF = 128, HTB = HALF * BK * 2, STAGE_BYTES = 8 * HTB, NXCD = 8, WGM = 8;
__host__ __device__ __forceinline__ int lds_byte(int r, int c) { const int st = (r >> 4) * 2 + (c >> 5), rr = r & 15, cc = c & 31, ob = rr * 64 + cc * 2; return st * 1024 + (ob ^ (((ob >> 9) & 1) << 5)); }
__host__ __device__ __forceinline__ void stage_rc(int b, int& R, int& C) { const int st = b / 1024, sb = b % 1024, swz = sb ^ (((sb >> 9) & 1) << 5); R = (st >> 1) * 16 + swz / 64; C = (st & 1) * 32 + (swz % 64) / 2; }
__host__ __device__ __forceinline__ int perm32(int rho) { const int n = rho >> 4, i = rho & 15; return 8 * (i >> 2) + 4 * n + (i & 3); }
struct Unit { int pm, pn; };
struct Gemm { const bf16_t* A; const bf16_t* Bt; int M, N, K; };
struct StaticOrder {
    int nM, nN, nwg, G, c;
    __host__ __device__ void init(int M, int N, int G_, int c_) { nM = M / BM; nN = N / BM; nwg = nM * nN; G = G_; c = c_; }
    __host__ __device__ bool next(int i, Unit& u) const {
        const long L = (long)i * G + c; if (L >= nwg) return false;
        int wgid = (int)L; { const int q = nwg / NXCD, r = nwg % NXCD, xcd = wgid % NXCD, off = wgid / NXCD; wgid = (xcd < r ? xcd * (q + 1) : r * (q + 1) + (xcd - r) * q) + off; }
        const int nig = WGM * nN, gid = wgid / nig, fm = gid * WGM, gsz = (nM - fm) < WGM ? (nM - fm) : WGM;
        u.pm = fm + ((wgid % nig) % gsz); u.pn = (wgid % nig) / gsz; return true;
    }
    __device__ __forceinline__ void a_ready(const Unit&) const {}
    __device__ __forceinline__ void done(const Unit&) const {}
};

struct EpiRoute {
    static constexpr bool PERM = true, AFTER_DRAIN = false;
    bf16_t* base[4]; int ld[4]; int t0, t1, t2;
    __device__ __forceinline__ void operator()(const f32x4 (&acc)[2][2][4][2], const Unit& u, int wr, int wc, int fr, int fq) const {
        const int row0 = u.pm * BM + wr * 64 + fr;
        bf16_t* b; int ldc, colt;
        if (u.pn < t0) { b = base[0]; ldc = ld[0]; colt = u.pn * BM; }
        else if (u.pn < t1) { b = base[1]; ldc = ld[1]; colt = (u.pn - t0) * BM; }
        else if (u.pn < t2) { b = base[2]; ldc = ld[2]; colt = (u.pn - t1) * BM; }
        else { b = base[3]; ldc = ld[3]; colt = (u.pn - t2) * BM; }
        const int col0 = colt + wc * 32 + 8 * fq;
#pragma unroll
        for (int ai = 0; ai < 2; ++ai)
#pragma unroll
            for (int m = 0; m < 4; ++m) {
                const int row = row0 + ai * HALF + m * 16;
                {
                    bf16_t* rowp = b + (size_t)row * ldc + col0;
#pragma unroll
                    for (int bj = 0; bj < 2; ++bj) {
                        const f32x4 v0 = acc[ai][bj][m][0], v1 = acc[ai][bj][m][1];
                        u32x4 w; w.x = pk2(v0[0], v0[1]); w.y = pk2(v0[2], v0[3]); w.z = pk2(v1[0], v1[1]); w.w = pk2(v1[2], v1[3]);
                        *(u32x4*)(rowp + bj * HALF) = w;
                    }
                }
            }
    }
};
struct EpiResid {
    static constexpr bool PERM = false, AFTER_DRAIN = false;
    const float* xsrc; float* xdst; const float* xcsrc; float* xcdst; const float* mods;
    __device__ __forceinline__ void operator()(const f32x4 (&acc)[2][2][4][2], const Unit& u, int wr, int wc, int fr, int fq) const {
        const int row0 = u.pm * BM + wr * 64 + fr, col0 = u.pn * BM + wc * 32 + 4 * fq;
#pragma unroll
        for (int ai = 0; ai < 2; ++ai)
#pragma unroll
            for (int m = 0; m < 4; ++m) {
                const int row = row0 + ai * HALF + m * 16;
                const float* src; float* dst; const float* gt;
                if (row < NLAT) { src = xsrc + (size_t)row * DM; dst = xdst + (size_t)row * DM; gt = mods + (row >> 11) * 3072 + 2048; }
                else { const int r2 = row - NLAT; src = xcsrc + (size_t)r2 * DM; dst = xcdst + (size_t)r2 * DM; gt = mods + 8 * 3072 + 2048; }
#pragma unroll
                for (int bj = 0; bj < 2; ++bj)
#pragma unroll
                    for (int n = 0; n < 2; ++n) {
                        const int col = col0 + bj * HALF + n * 16;
                        const f32x4 xs = *(const f32x4*)(src + col), g = *(const f32x4*)(gt + col);
                        *(f32x4*)(dst + col) = xs + g * acc[ai][bj][m][n];
                    }
            }
    }
};

template <class Epi, class Sched, bool ALIGN_EPI = false, bool SP2 = false>
__device__ __forceinline__ void gemm_phase(LAS unsigned char* lds, const Gemm g, const Sched& S, const Epi& E, const int tid) {
    const int wid = __builtin_amdgcn_readfirstlane(tid >> 6), lane = tid & 63, wr = wid >> 2, wc = wid & 3, fr = lane & 15, fq = lane >> 4;
    const int K = g.K, nt = K / BK;
    unsigned voffA[2], voffB[2];
#pragma unroll
    for (int i = 0; i < 2; ++i) { int R, C; stage_rc(tid * 16 + i * 8192, R, C); const int Rb = Epi::PERM ? ((R & ~31) + perm32(R & 31)) : R;
        voffA[i] = (unsigned)(R * K + C) * 2u; voffB[i] = (unsigned)(Rb * K + C) * 2u; }
    const size_t kstep = (size_t)(BK * 2);
    const size_t hstep = (size_t)HALF * K * 2;
    const size_t tstep = 2 * hstep;
    const unsigned ldsw = (unsigned)wid * 1024u;
    const int aoff = lds_byte(wr * 64 + fr, fq * 8), boff = lds_byte(wc * 32 + fr, fq * 8);
#define PG8_SA(b, h) (((b) * 2 + (h)) * HTB)
#define PG8_SB(b, h) ((4 + (b) * 2 + (h)) * HTB)
#define PG8_STAGE(bufoff, gbase, voff) do { _Pragma("unroll") for (int _i = 0; _i < 2; ++_i) \
        __builtin_amdgcn_global_load_lds((const unsigned*)((const char*)(gbase) + (voff)[_i]), (LAS unsigned*)(lds + (bufoff) + ldsw + _i * 8192), 16, 0, 0); } while (0)
#define PG8_LDA(dst, b, h) do { _Pragma("unroll") for (int m = 0; m < 4; ++m) _Pragma("unroll") for (int k = 0; k < 2; ++k) dst[m][k] = *(const LAS bf16x8*)(lds + PG8_SA(b, h) + aoff + m * 2048 + k * 1024); } while (0)
#define PG8_LDB(dst, b, h) do { _Pragma("unroll") for (int n = 0; n < 2; ++n) _Pragma("unroll") for (int k = 0; k < 2; ++k) dst[n][k] = *(const LAS bf16x8*)(lds + PG8_SB(b, h) + boff + n * 2048 + k * 1024); } while (0)
#define PG8_MMA(ai, bj, At, Bt) do { __builtin_amdgcn_s_setprio(1); _Pragma("unroll") for (int m = 0; m < 4; ++m) _Pragma("unroll") for (int n = 0; n < 2; ++n) _Pragma("unroll") for (int k = 0; k < 2; ++k) \
        acc[ai][bj][m][n] = __builtin_amdgcn_mfma_f32_16x16x32_bf16(Bt[n][k], At[m][k], acc[ai][bj][m][n], 0, 0, 0); __builtin_amdgcn_s_setprio(0); } while (0)
#define PG8_WAIT_V(n) asm volatile("s_waitcnt vmcnt(" #n ")" ::: "memory")
#define PG8_WAIT_L(n) asm volatile("s_waitcnt lgkmcnt(" #n ")" ::: "memory")
#define PG8_BAR __builtin_amdgcn_s_barrier()
#define PG8_SCHED __builtin_amdgcn_sched_barrier(0)
    Unit cur, nxt; int ui = 0;
    if (!S.next(0, cur)) return;
    f32x4 acc[2][2][4][2];
#pragma unroll
    for (int a = 0; a < 2; ++a)
#pragma unroll
        for (int b = 0; b < 2; ++b)
#pragma unroll
            for (int m = 0; m < 4; ++m)
#pragma unroll
                for (int n = 0; n < 2; ++n) acc[a][b][m][n] = (f32x4){0.f, 0.f, 0.f, 0.f};
    bf16x8 At[4][2], B0[2][2], B1[2][2];
    const char* cA = (const char*)g.A + (size_t)cur.pm * tstep; const char* cB = (const char*)g.Bt + (size_t)cur.pn * tstep;
    S.a_ready(cur);
    if constexpr (SP2) {
        PG8_STAGE(PG8_SB(0, 0), cB, voffB); PG8_STAGE(PG8_SB(0, 1), cB + hstep, voffB); PG8_STAGE(PG8_SA(0, 0), cA, voffA); PG8_STAGE(PG8_SA(0, 1), cA + hstep, voffA);
        if (wr == 1) PG8_BAR;
        PG8_WAIT_V(2); PG8_BAR;
        PG8_STAGE(PG8_SB(1, 0), cB + kstep, voffB); PG8_STAGE(PG8_SA(1, 0), cA + kstep, voffA); PG8_STAGE(PG8_SB(1, 1), cB + hstep + kstep, voffB);
        PG8_WAIT_V(6); PG8_BAR;
    } else {
        PG8_STAGE(PG8_SB(0, 0), cB, voffB); PG8_STAGE(PG8_SA(0, 0), cA, voffA); PG8_STAGE(PG8_SB(0, 1), cB + hstep, voffB); PG8_STAGE(PG8_SA(0, 1), cA + hstep, voffA);
        if (wr == 1) PG8_BAR;
        PG8_WAIT_V(4); PG8_BAR;
        PG8_STAGE(PG8_SB(1, 0), cB + kstep, voffB); PG8_STAGE(PG8_SA(1, 0), cA + kstep, voffA); PG8_STAGE(PG8_SB(1, 1), cB + hstep + kstep, voffB);
        PG8_WAIT_V(6); PG8_BAR;
    }
    for (;;) {
        const bool has_next = S.next(ui + 1, nxt);
        const char* nA = has_next ? (const char*)g.A + (size_t)nxt.pm * tstep : cA; const char* nB = has_next ? (const char*)g.Bt + (size_t)nxt.pn * tstep : cB;
        for (int t = 0; t < nt; t += 2) {
            const bool last = (t == nt - 2);
            const char* a1 = cA + (size_t)(t + 1) * kstep;
            const char* a2 = last ? nA : cA + (size_t)(t + 2) * kstep; const char* b2 = last ? nB : cB + (size_t)(t + 2) * kstep;
            const char* a3 = a2 + kstep; const char* b3 = b2 + kstep;
            if (last && has_next) S.a_ready(nxt);
            if constexpr (SP2) {
            PG8_LDB(B0, 0, 0); PG8_LDB(B1, 0, 1); PG8_SCHED; PG8_LDA(At, 0, 0); PG8_STAGE(PG8_SA(1, 1), a1 + hstep, voffA);
            PG8_WAIT_V(8); PG8_WAIT_L(0); PG8_BAR; PG8_MMA(0, 0, At, B0); PG8_MMA(0, 1, At, B1); PG8_BAR; PG8_SCHED;
            PG8_LDA(At, 0, 1); PG8_STAGE(PG8_SB(0, 0), b2, voffB); PG8_STAGE(PG8_SB(0, 1), b2 + hstep, voffB); PG8_STAGE(PG8_SA(0, 0), a2, voffA);
            PG8_WAIT_V(8); PG8_WAIT_L(0); PG8_BAR; PG8_MMA(1, 0, At, B0); PG8_MMA(1, 1, At, B1); PG8_BAR; PG8_SCHED;
            PG8_LDB(B0, 1, 0); PG8_LDB(B1, 1, 1); PG8_SCHED; PG8_LDA(At, 1, 0); PG8_STAGE(PG8_SA(0, 1), a2 + hstep, voffA);
            PG8_WAIT_V(8); PG8_WAIT_L(0); PG8_BAR; PG8_MMA(0, 0, At, B0); PG8_MMA(0, 1, At, B1); PG8_BAR; PG8_SCHED;
            PG8_LDA(At, 1, 1); PG8_STAGE(PG8_SB(1, 0), b3, voffB); PG8_STAGE(PG8_SB(1, 1), b3 + hstep, voffB); PG8_STAGE(PG8_SA(1, 0), a3, voffA);
            PG8_WAIT_V(8); PG8_WAIT_L(0); PG8_BAR; PG8_MMA(1, 0, At, B0); PG8_MMA(1, 1, At, B1); PG8_BAR; PG8_SCHED;
            } else {
            PG8_LDB(B0, 0, 0); PG8_SCHED; PG8_LDA(At, 0, 0); PG8_STAGE(PG8_SA(1, 1), a1 + hstep, voffA);
            PG8_WAIT_L(8); PG8_BAR; PG8_WAIT_L(0); PG8_MMA(0, 0, At, B0); PG8_BAR; PG8_SCHED;
            PG8_LDB(B1, 0, 1); PG8_STAGE(PG8_SB(0, 0), b2, voffB);
            PG8_BAR; PG8_WAIT_L(0); PG8_MMA(0, 1, At, B1); PG8_BAR;
            PG8_LDA(At, 0, 1); PG8_STAGE(PG8_SA(0, 0), a2, voffA);
            PG8_BAR; PG8_WAIT_L(0); PG8_MMA(1, 0, At, B0); PG8_BAR; PG8_SCHED;
            PG8_STAGE(PG8_SB(0, 1), b2 + hstep, voffB);
            PG8_WAIT_V(6); PG8_BAR; PG8_MMA(1, 1, At, B1); PG8_BAR;
            PG8_LDB(B0, 1, 0); PG8_SCHED; PG8_LDA(At, 1, 0); PG8_STAGE(PG8_SA(0, 1), a2 + hstep, voffA);
            PG8_WAIT_L(8); PG8_BAR; PG8_WAIT_L(0); PG8_MMA(0, 0, At, B0); PG8_BAR; PG8_SCHED;
            PG8_LDB(B1, 1, 1); PG8_STAGE(PG8_SB(1, 0), b3, voffB);
            PG8_BAR; PG8_WAIT_L(0); PG8_MMA(0, 1, At, B1); PG8_BAR;
            PG8_LDA(At, 1, 1); PG8_STAGE(PG8_SA(1, 0), a3, voffA);
            PG8_BAR; PG8_WAIT_L(0); PG8_MMA(1, 0, At, B0); PG8_BAR; PG8_SCHED;
            PG8_STAGE(PG8_SB(1, 1), b3 + hstep, voffB);
            PG8_WAIT_V(6); PG8_BAR; PG8_MMA(1, 1, At, B1); PG8_BAR;
            }
        }
        if constexpr (ALIGN_EPI) { if (wr == 0) PG8_BAR; }
        if constexpr (!Epi::AFTER_DRAIN) { E(acc, cur, wr, wc, fr, fq); S.done(cur); }
        if (!has_next) break;
#pragma unroll
        for (int a = 0; a < 2; ++a)
#pragma unroll
            for (int b = 0; b < 2; ++b)
#pragma unroll
                for (int m = 0; m < 4; ++m)
#pragma unroll
                    for (int n = 0; n < 2; ++n) acc[a][b][m][n] = (f32x4){0.f, 0.f, 0.f, 0.f};
        cur = nxt; cA = nA; cB = nB; ++ui;
        if constexpr (ALIGN_EPI) { if (wr == 1) PG8_BAR; }
    }
    PG8_WAIT_V(0);
    if constexpr (!ALIGN_EPI) { if (wr == 0) PG8_BAR; }
    PG8_BAR;
#undef PG8_SA
#undef PG8_SB
#undef PG8_STAGE
#undef PG8_LDA
#undef PG8_LDB
#undef PG8_MMA
#undef PG8_WAIT_V
#undef PG8_WAIT_L
#undef PG8_BAR
#undef PG8_SCHED
}
}


namespace att {
using f32x16 = __attribute__((ext_vector_type(16))) float;
using s16x4 = __attribute__((ext_vector_type(4))) short;
constexpr int NW = 8, QBLK = 32, KVBLK = 64, LDQ = 768, LDK = 768, LDV = 512;
constexpr float SCALE = 0.10206207261596575f;
constexpr float THR = 8.f;
constexpr int SHM_V = 16384, SHM_K = 16384, SHM_ATTN = 2 * SHM_V + 2 * SHM_K + NW * 64 * 4;
#define KSWZ(row, colB) ((row) * 256 + ((colB) ^ (((row) & 7) << 4)))
#define SBAR() __builtin_amdgcn_sched_barrier(0)
__device__ __forceinline__ int crow(int r, int hi) { return (r & 3) + 8 * (r >> 2) + 4 * hi; }
__device__ __forceinline__ unsigned cvtpk(float lo, float hi) { unsigned r; asm volatile("v_cvt_pk_bf16_f32 %0, %1, %2" : "=v"(r) : "v"(lo), "v"(hi)); return r; }
__device__ __forceinline__ void partialSM(f32x16& p0, f32x16& p1, float& m_reg, float& mn, float& alpha) {
  constexpr float C = SCALE * 1.4426950408889634f;
  float pmax = p0[0];
#pragma unroll
  for (int r = 1; r < 16; ++r) pmax = fmaxf(pmax, p0[r]);
#pragma unroll
  for (int r = 0; r < 16; ++r) pmax = fmaxf(pmax, p1[r]);
  { auto rr = __builtin_amdgcn_permlane32_swap(__float_as_uint(pmax), __float_as_uint(pmax), false, false);
    pmax = fmaxf(__uint_as_float(rr[0]), __uint_as_float(rr[1])); }
  if (__builtin_expect(__all(pmax - m_reg <= THR / SCALE), 1)) { mn = m_reg; alpha = 1.f; }
  else { mn = fmaxf(m_reg, pmax); alpha = __builtin_amdgcn_exp2f((m_reg - mn) * C); m_reg = mn; }
  float mnC = -mn * C;
#pragma unroll
  for (int r = 0; r < 16; ++r) p0[r] = fmaf(p0[r], C, mnC);
#pragma unroll
  for (int r = 0; r < 16; ++r) p1[r] = fmaf(p1[r], C, mnC);
#pragma unroll
  for (int r = 0; r < 16; ++r) p0[r] = __builtin_amdgcn_exp2f(p0[r]);
}
__device__ __forceinline__ void finishSM(f32x16& p0, f32x16& p1, float alpha, float& l_reg, bf16x8& pa0, bf16x8& pa1, bf16x8& pa2, bf16x8& pa3) {
#pragma unroll
  for (int r = 0; r < 16; ++r) p1[r] = __builtin_amdgcn_exp2f(p1[r]);
  float ps = 0;
#pragma unroll
  for (int r = 0; r < 16; ++r) ps += p0[r];
#pragma unroll
  for (int r = 0; r < 16; ++r) ps += p1[r];
  { auto rr = __builtin_amdgcn_permlane32_swap(__float_as_uint(ps), __float_as_uint(ps), false, false);
    ps = __uint_as_float(rr[0]) + __uint_as_float(rr[1]); }
  l_reg = l_reg * alpha + ps;
#define PK4(P, BASE, OUT) do { unsigned a0 = cvtpk(P[BASE + 0], P[BASE + 1]), a1 = cvtpk(P[BASE + 2], P[BASE + 3]);   \
    unsigned b0 = cvtpk(P[BASE + 4], P[BASE + 5]), b1 = cvtpk(P[BASE + 6], P[BASE + 7]);                              \
    auto r0 = __builtin_amdgcn_permlane32_swap(a0, b0, false, false); auto r1 = __builtin_amdgcn_permlane32_swap(a1, b1, false, false); \
    u32x4 w = {r0[0], r1[0], r0[1], r1[1]}; OUT = __builtin_bit_cast(bf16x8, w); } while (0)
  PK4(p0, 0, pa0); PK4(p0, 8, pa1); PK4(p1, 0, pa2); PK4(p1, 8, pa3);
#undef PK4
}
__device__ __forceinline__ void qkt(f32x16& p0, f32x16& p1, const LAS char* Ks, const bf16x8* qr, int r32, int hi) {
  p0 = f32x16{}; p1 = f32x16{};
#pragma unroll
  for (int d0 = 0; d0 < 6; ++d0) { const int cb = (d0 * 16 + hi * 8) * 2;
    const bf16x8 b0 = *(const LAS bf16x8*)(Ks + KSWZ(r32, cb));
    const bf16x8 b1 = *(const LAS bf16x8*)(Ks + KSWZ(32 + r32, cb));
    p0 = __builtin_amdgcn_mfma_f32_32x32x16_bf16(b0, qr[d0], p0, 0, 0, 0);
    p1 = __builtin_amdgcn_mfma_f32_32x32x16_bf16(b1, qr[d0], p1, 0, 0, 0); }
}
__device__ __forceinline__ int v_st(int k, int c) { const int kk = (k & ~0xC) | ((k & 4) << 1) | ((k & 8) >> 1); return ((kk >> 3) * 4 + (c >> 5)) * 512 + ((kk & 7) * 32 + (c & 31)) * 2; }
__device__ __forceinline__ int v_rd_base(int lane) { return ((lane & 3) << 3) | (((lane >> 2) & 3) << 6) | (((lane >> 4) & 1) << 5) | (((lane >> 5) & 1) << 8); }
constexpr int v_rd_off(int d0, int ks, int half) { return d0 * 512 + ks * 4096 + half * 2048; }
template <int OFF> __device__ __forceinline__ s16x4 tr_read(int vb) {
  s16x4 r; asm volatile("ds_read_b64_tr_b16 %0, %1 offset:%2" : "=&v"(r) : "v"(vb), "i"(OFF) : "memory"); return r;
}
template <int D0> __device__ __forceinline__ void pv_one(f32x16& od, int vb, bf16x8 pa0, bf16x8 pa1, bf16x8 pa2, bf16x8 pa3) {
  const s16x4 l0 = tr_read<v_rd_off(D0, 0, 0)>(vb), h0 = tr_read<v_rd_off(D0, 0, 1)>(vb), l1 = tr_read<v_rd_off(D0, 1, 0)>(vb), h1 = tr_read<v_rd_off(D0, 1, 1)>(vb);
  const s16x4 l2 = tr_read<v_rd_off(D0, 2, 0)>(vb), h2 = tr_read<v_rd_off(D0, 2, 1)>(vb), l3 = tr_read<v_rd_off(D0, 3, 0)>(vb), h3 = tr_read<v_rd_off(D0, 3, 1)>(vb);
  asm volatile("s_waitcnt lgkmcnt(0)" ::: "memory"); SBAR();
#define PK(L, H) (bf16x8){L[0], L[1], L[2], L[3], H[0], H[1], H[2], H[3]}
  od = __builtin_amdgcn_mfma_f32_32x32x16_bf16(pa0, PK(l0, h0), od, 0, 0, 0);
  od = __builtin_amdgcn_mfma_f32_32x32x16_bf16(pa1, PK(l1, h1), od, 0, 0, 0);
  od = __builtin_amdgcn_mfma_f32_32x32x16_bf16(pa2, PK(l2, h2), od, 0, 0, 0);
  od = __builtin_amdgcn_mfma_f32_32x32x16_bf16(pa3, PK(l3, h3), od, 0, 0, 0);
#undef PK
}
__device__ __forceinline__ void pv_d0(f32x16* o, int vb, bf16x8 pa0, bf16x8 pa1, bf16x8 pa2, bf16x8 pa3) {
  pv_one<0>(o[0], vb, pa0, pa1, pa2, pa3); pv_one<1>(o[1], vb, pa0, pa1, pa2, pa3);
}
__device__ __forceinline__ void attn_body(const bf16_t* Qb, const bf16_t* Kh, const bf16_t* Vh, bf16_t* Ob, int rlat, int rctx, int nlat, int NT, LAS char* lds, int tid) {
  const int wid = tid >> 6, lane = tid & 63, r32 = lane & 31, hi = lane >> 5;
  LAS char* V_lds = lds; LAS char* K_lds = lds + 2 * SHM_V;
  LAS float* wsl = (LAS float*)(lds + 2 * SHM_V + 2 * SHM_K) + wid * 64; LAS float* li_l = wsl; LAS float* al_l = wsl + 32;
  float m_reg = -1e30f, l_reg = 0; f32x16 o[2] = {}; bf16x8 qr[6];
  const bf16_t* Qw = Qb + (long)(wid * QBLK + r32) * LDQ + hi * 8;
#pragma unroll
  for (int d0 = 0; d0 < 6; ++d0) qr[d0] = *(const bf16x8*)(Qw + d0 * 16);
  const int cid1 = 512 + (tid & 255);
  const int kr0 = tid / 12, kc0 = (tid % 12) * 8, kr1 = cid1 / 12, kc1 = (cid1 % 12) * 8, vr = tid >> 3, vc = (tid & 7) * 8;
  const int vst0 = v_st(vr, vc), kst0 = KSWZ(kr0, kc0 * 2), kst1 = KSWZ(kr1, kc1 * 2);
  const int vb0 = (int)(unsigned)(unsigned long)V_lds + v_rd_base(lane);
  struct { bf16x8 vs0, ks0, ks1; } sr_[2];
#define TROW(j) ((j) < nlat ? rlat + 64 * (j) : rctx + 64 * ((j) - nlat))
#define SLOAD(i, j) do { const long rb_ = TROW(j); sr_[i].vs0 = *(const bf16x8*)(Vh + (rb_ + vr) * LDV + vc); \
    sr_[i].ks0 = *(const bf16x8*)(Kh + (rb_ + kr0) * LDK + kc0); sr_[i].ks1 = *(const bf16x8*)(Kh + (rb_ + kr1) * LDK + kc1); } while (0)
#define SWRITE(b, i) do { *(LAS bf16x8*)(V_lds + (b) * SHM_V + vst0) = sr_[i].vs0; \
    *(LAS bf16x8*)(K_lds + (b) * SHM_K + kst0) = sr_[i].ks0; *(LAS bf16x8*)(K_lds + (b) * SHM_K + kst1) = sr_[i].ks1; } while (0)
#define SWAIT() asm volatile("s_waitcnt vmcnt(3)" ::: "memory")
#define RESC(a) do { if (__any((a) < 1.f)) { if (hi == 0) al_l[r32] = (a); asm volatile("s_waitcnt lgkmcnt(0)" ::: "memory"); \
    _Pragma("unroll") for (int d = 0; d < 2; ++d) _Pragma("unroll") for (int r = 0; r < 16; ++r) o[d][r] *= al_l[crow(r, hi)]; } } while (0)
  f32x16 pA0, pA1, pB0, pB1; float mnA, mnB, alA, alB; bf16x8 pa0, pa1, pa2, pa3;
  constexpr int SE = 0, SO = 1;
  SLOAD(SE, 0); asm volatile("s_waitcnt vmcnt(0)" ::: "memory"); SWRITE(0, SE); __syncthreads();
  qkt(pA0, pA1, K_lds, qr, r32, hi); partialSM(pA0, pA1, m_reg, mnA, alA);
  SLOAD(SO, 1); if (2 < NT) SLOAD(SE, 2);
  SWAIT(); SWRITE(1, SO); __syncthreads();
  for (int j = 1; j + 1 < NT; j += 2) {
    SBAR(); qkt(pB0, pB1, K_lds + SHM_K, qr, r32, hi);
    finishSM(pA0, pA1, alA, l_reg, pa0, pa1, pa2, pa3); SBAR();
    SLOAD(SO, j + 2); SBAR();
    pv_d0(o, vb0, pa0, pa1, pa2, pa3); partialSM(pB0, pB1, m_reg, mnB, alB);
    __syncthreads(); SWAIT(); SWRITE(0, SE);
    RESC(alB); __syncthreads();
    SBAR(); qkt(pA0, pA1, K_lds, qr, r32, hi);
    finishSM(pB0, pB1, alB, l_reg, pa0, pa1, pa2, pa3); SBAR();
    if (j + 3 < NT) SLOAD(SE, j + 3); SBAR();
    pv_d0(o, vb0 + SHM_V, pa0, pa1, pa2, pa3); partialSM(pA0, pA1, m_reg, mnA, alA);
    __syncthreads(); SWAIT(); SWRITE(1, SO);
    RESC(alA); __syncthreads();
  }
  SBAR(); qkt(pB0, pB1, K_lds + SHM_K, qr, r32, hi);
  finishSM(pA0, pA1, alA, l_reg, pa0, pa1, pa2, pa3); SBAR();
  pv_d0(o, vb0, pa0, pa1, pa2, pa3); partialSM(pB0, pB1, m_reg, mnB, alB);
  __syncthreads(); RESC(alB);
  finishSM(pB0, pB1, alB, l_reg, pa0, pa1, pa2, pa3); SBAR();
  pv_d0(o, vb0 + SHM_V, pa0, pa1, pa2, pa3);
  if (hi == 0) li_l[r32] = l_reg; asm volatile("s_waitcnt lgkmcnt(0)" ::: "memory");
  float rli[16];
#pragma unroll
  for (int r = 0; r < 16; ++r) rli[r] = __builtin_amdgcn_rcpf(li_l[crow(r, hi)]);
  bf16_t* Ow = Ob + (long)(wid * QBLK) * LDQ;
#pragma unroll
  for (int r = 0; r < 16; ++r) { const int orow = crow(r, hi);
#pragma unroll
    for (int d0 = 0; d0 < 2; ++d0) Ow[(long)orow * LDQ + d0 * 32 + r32] = (bf16_t)f2bf(o[d0][r] * rli[r]); }
  __syncthreads();
#undef TROW
#undef SLOAD
#undef SWRITE
#undef SWAIT
#undef RESC
}
}

struct Args { const float* in[37]; float* out; unsigned char* ws; };

enum { I_X = 0, I_C, I_CTX, I_CCTX, I_MODW, I_MODB, I_NORMG, I_EVWIN, I_EVWOUT, I_QAN, I_WUQ, I_KVAN, I_WUKV, I_QN, I_KN,
       I_MUP, I_MUN, I_W0, I_WUP, I_A0, I_AUP, I_KK, I_KA, I_RK, I_LNW, I_LNB, I_ODWIN, I_ODWOUT, I_CONVW, I_CONVB, I_BIASD,
       I_FW1, I_FB1, I_FW2, I_FB2, I_FWOUT, I_FREQ };

#define INP(i) (a.in[(i) + opq0])
__device__ __forceinline__ void transpose_item(const float* W, int ldw, int src_col0, bool valid, bf16_t* WT, int Kd, int dst_row0, int k0, LAS float* scr, int lane) {
    if (valid) {
#pragma unroll 8
        for (int i = 0; i < 32; ++i) { const int kk = 2 * i + (lane >> 5); scr[kk * 33 + (lane & 31)] = W[(size_t)(k0 + kk) * ldw + src_col0 + (lane & 31)]; }
    } else {
#pragma unroll 8
        for (int i = 0; i < 32; ++i) { const int kk = 2 * i + (lane >> 5); scr[kk * 33 + (lane & 31)] = 0.f; }
    }
    asm volatile("s_waitcnt vmcnt(0) lgkmcnt(0)" ::: "memory");
    const int c = lane & 7;
#pragma unroll
    for (int j = 0; j < 4; ++j) { const int n = (lane >> 3) + 8 * j; const LAS float* s = scr + (8 * c) * 33 + n;
        u32x4 o; o.x = pk2(s[0 * 33], s[1 * 33]); o.y = pk2(s[2 * 33], s[3 * 33]); o.z = pk2(s[4 * 33], s[5 * 33]); o.w = pk2(s[6 * 33], s[7 * 33]);
        *(u32x4*)(WT + (size_t)(dst_row0 + n) * Kd + k0 + 8 * c) = o; }
    asm volatile("s_waitcnt lgkmcnt(0)" ::: "memory");
}

__device__ __forceinline__ void norm_row(const float* xrow, const float* g, const float* md, bf16_t* orow, int lane) {
    const f32x4* xr = (const f32x4*)xrow + lane;
    f32x4 v[4]; float s = 0.f;
#pragma unroll
    for (int j = 0; j < 4; ++j) { v[j] = xr[64 * j]; s += (v[j].x * v[j].x + v[j].y * v[j].y) + (v[j].z * v[j].z + v[j].w * v[j].w); }
    const float rstd = 1.0f / sqrtf(wave_sum(s, lane) * (1.f / DM) + NORM_EPS);
    u32x2* o8 = (u32x2*)orow + lane;
#pragma unroll
    for (int j = 0; j < 4; ++j) {
        const f32x4 gg = ((const f32x4*)g)[lane + 64 * j], sh = ((const f32x4*)md)[lane + 64 * j], sc = ((const f32x4*)(md + 1024))[lane + 64 * j];
        const f32x4 y = (v[j] * rstd) * gg * (sc + 1.0f) + sh;
        u32x2 w; w.x = pk2(y.x, y.y); w.y = pk2(y.z, y.w); o8[64 * j] = w;
    }
}

__global__ void __launch_bounds__(NTHREADS, 2) mega_fwd(Args a) {
    extern __shared__ __attribute__((aligned(16))) unsigned char lds_raw[];
    cg::grid_group grid = cg::this_grid();
    LAS unsigned char* lds = (LAS unsigned char*)lds_raw;
    const int G = gridDim.x, bid = blockIdx.x;
    const int NGW = G * NWAVES;
#define PHASE_LOCALS \
    int tid = threadIdx.x; asm volatile("" : "+v"(tid)); \
    const int lane = tid & 63, wave = __builtin_amdgcn_readfirstlane(tid >> 6); \
    const int gw = bid * NWAVES + wave; \
    int opq0 = 0; asm volatile("" : "+s"(opq0)); \
    unsigned char* ws = a.ws + opq0; \
    (void)lane; (void)wave; (void)gw; (void)ws; (void)opq0;
#define MODS ((float*)(ws + OFF_MODS))
#define BONUS ((float*)(ws + OFF_BONUS))
#define HDN ((float*)(ws + OFF_HDN))
#define XC ((float*)(ws + OFF_XC))
#define BIG (ws + OFF_BIG)
#define WIN ((bf16_t*)(ws + OFF_WTS + W_IN))
#define WOUT ((bf16_t*)(ws + OFF_WTS + W_OUT))
#define WUQ ((bf16_t*)(ws + OFF_WTS + W_UQ))
#define WUKV ((bf16_t*)(ws + OFF_WTS + W_UKV))

    if (EN_P0) {
        PHASE_LOCALS
        LAS float* sc = (LAS float*)lds;
        LAS float* red = (LAS float*)(lds + 9 * 1024 * 4);
        bool have_silu = false;
        for (int it = bid; it < 4 * 48; it += G) {
            if (!have_silu) {
                for (int i = tid; i < 9 * 1024; i += NTHREADS) { const float cv = (i < 8192) ? INP(I_C)[i] : INP(I_CCTX)[i - 8192]; sc[i] = silu_f(cv); }
                have_silu = true;
            }
            __syncthreads();
            const int layer = it / 48, cg0 = (it % 48) * 64, cl = tid & 63, kg = tid >> 6;
            const float* W = INP(I_MODW) + (size_t)layer * 1024 * 3072 + cg0 + cl;
            float acc[9];
#pragma unroll
            for (int r = 0; r < 9; ++r) acc[r] = 0.f;
            for (int k = kg * 128; k < kg * 128 + 128; ++k) {
                const float w = W[(size_t)k * 3072];
#pragma unroll
                for (int r = 0; r < 9; ++r) acc[r] += sc[r * 1024 + k] * w;
            }
#pragma unroll
            for (int r = 0; r < 9; ++r) red[(kg * 9 + r) * 64 + cl] = acc[r];
            __syncthreads();
            for (int idx = tid; idx < 9 * 64; idx += NTHREADS) {
                const int r = idx >> 6, c2 = idx & 63; float s = 0.f;
#pragma unroll
                for (int q = 0; q < 8; ++q) s += red[(q * 9 + r) * 64 + c2];
                MODS[((size_t)layer * 9 + r) * 3072 + cg0 + c2] = s + INP(I_MODB)[layer * 3072 + cg0 + c2];
            }
        }
        for (int it = gw; it < 2048 + 256 + 2048; it += NGW) {
            int o, Lf, pos; float* outp;
            if (it < 2048) { o = 0; Lf = 2048; pos = it; outp = HDN + (size_t)pos * 64; }
            else if (it < 2304) { o = 0; Lf = 256; pos = it - 2048; outp = HDN + (size_t)(2048 + pos) * 64; }
            else { o = 1; Lf = 2048; pos = it - 2304; outp = HDN + (size_t)(2304 + pos) * 64; }
            const float fpos = (float)pos, tt = fpos / (float)(Lf - 1);
            float z = 0.f;
            if (lane == 0) z = tt;
            else if (lane < 33) {
                const int bi = (lane - 1) & 15;
                const float band = 1e-4f + (float)bi * ((15.0f - 1e-4f) / 15.0f);
                const float ang = fpos * (6.283185307179586f / (float)Lf) * band;
                z = (lane < 17) ? cosf(ang) : -sinf(ang);
            }
            const float fr = INP(I_FREQ)[o * 64 + lane];
            float h = INP(I_FB1)[o * 64 + lane];
            const float* w1 = INP(I_FW1) + (size_t)o * 33 * 64;
            for (int i = 0; i < 33; ++i) h += bcast(z, i) * w1[i * 64 + lane];
            h = sinf(fr * h);
            for (int jj = 0; jj < 2; ++jj) {
                const float* w2 = INP(I_FW2) + ((size_t)o * 2 + jj) * 64 * 64;
                float h2 = INP(I_FB2)[(o * 2 + jj) * 64 + lane];
                for (int i = 0; i < 64; ++i) h2 += bcast(h, i) * w2[i * 64 + lane];
                h = sinf(fr * h2);
            }
            outp[lane] = h;
        }
    }
    grid.sync();

    for (int ph = 0; ph < 26; ++ph) {
        {
            PHASE_LOCALS
            int phs = ph; asm volatile("" : "+s"(phs));
            int layer, step;
            if (phs < 8) { layer = 0; step = phs; } else if (phs < 13) { layer = 1; step = phs - 8; } else if (phs < 21) { layer = 2; step = phs - 13; } else { layer = 3; step = phs - 21; }
            const bool even = !(layer & 1);
            const int e = layer >> 1;
            const bool ctx_out = (layer < 2);
            const bool ctx_in = (layer < 3);
            const int Mrows = ctx_in ? MTOT : NLAT;
            const int Mout = ctx_out ? MTOT : NLAT;
            const float* xsrc = (layer == 0) ? INP(I_X) : a.out;
            const float* xcsrc = (layer == 0) ? INP(I_CTX) : XC;
            const float* mods = MODS + (size_t)layer * 9 * 3072;
            int nroute = 0; bool resid = false;
            if (even) { if (step == 1) nroute = 1; else if (step == 3) nroute = 2; else if (step == 7) resid = true; }
            else { if (step == 1) nroute = 1; else if (step == 4) resid = true; }

            if (EN_NORM && step == 0) {
                bf16_t* H = (bf16_t*)(BIG + (even ? EV_E : OD_HV));
                const float* ng = INP(I_NORMG) + layer * 1024;
                for (int m = gw; m < Mrows; m += NGW) {
                    const float* xr; const float* md;
                    if (m < NLAT) { xr = xsrc + (size_t)m * DM; md = mods + (m >> 11) * 3072; }
                    else { xr = xcsrc + (size_t)(m - NLAT) * DM; md = mods + 8 * 3072; }
                    norm_row(xr, ng, md, H + (size_t)m * DM, lane);
                }
                LAS float* scr = (LAS float*)(lds + wave * 8448);
                if (even) {
                    const float* win = INP(I_EVWIN) + (size_t)e * 1024 * 3232;
                    const float* wout = INP(I_EVWOUT) + (size_t)e * 1024 * 1024;
                    const float* wuq = INP(I_WUQ) + (size_t)e * 256 * 768;
                    const float* wukv = INP(I_WUKV) + (size_t)e * 128 * 1024;
                    constexpr int N1 = 104 * 16, N2 = 32 * 16, N3 = 24 * 4, N4 = 32 * 4;
                    for (int it = gw; it < N1 + N2 + N3 + N4; it += NGW) {
                        int r = it;
                        if (r < N1) { const int nb = r / 16, kb = r % 16; const int d0 = nb * 32; int s0;
                            if (d0 < 1792) s0 = 416 + d0; else if (d0 < 2816) s0 = 2208 + (d0 - 1792); else if (d0 < 3072) s0 = d0 - 2816; else if (d0 < 3232) s0 = 256 + (d0 - 3072); else s0 = -1;
                            transpose_item(win, 3232, s0, s0 >= 0, WIN, 1024, d0, kb * 64, scr, lane); continue; }
                        r -= N1;
                        if (r < N2) { const int nb = r / 16, kb = r % 16; transpose_item(wout, 1024, nb * 32, true, WOUT, 1024, nb * 32, kb * 64, scr, lane); continue; }
                        r -= N2;
                        if (r < N3) { const int nb = r / 4, kb = r % 4; transpose_item(wuq, 768, nb * 32, true, WUQ, 256, nb * 32, kb * 64, scr, lane); continue; }
                        r -= N3;
                        { const int nb = r / 4, kb = r % 4; const int d0 = nb * 32; const int hh = (d0 & 511) >> 6, dd = d0 & 63; const int s0 = hh * 128 + dd + ((d0 >= 512) ? 64 : 0);
                          transpose_item(wukv, 1024, s0, kb < 2, WUKV, 256, d0, kb * 64, scr, lane); }
                    }
                } else {
                    const float* win = INP(I_ODWIN) + (size_t)e * 1024 * 4096;
                    const float* wout = INP(I_ODWOUT) + (size_t)e * 1024 * 1024;
                    constexpr int N1 = 128 * 16, N2 = 32 * 16;
                    for (int it = gw; it < N1 + N2; it += NGW) {
                        int r = it;
                        if (r < N1) { const int nb = r / 16, kb = r % 16; transpose_item(win, 4096, nb * 32, true, WIN, 1024, nb * 32, kb * 64, scr, lane); continue; }
                        r -= N1;
                        { const int nb = r / 16, kb = r % 16; transpose_item(wout, 1024, nb * 32, true, WOUT, 1024, nb * 32, kb * 64, scr, lane); }
                    }
                    __syncthreads();
                    float* FILT = (float*)(BIG + OD_FILT);
                    float* FILTC = FILT + (size_t)2 * 2048 * 1024;
                    LAS float* fred = (LAS float*)(lds + 8 * 8448);
                    const int nsel = (layer == 1) ? 2 : 1;
                    for (int it = bid; it < nsel * 128; it += G) {
                        const int sel = it >> 7, dir = (it >> 6) & 1, cg0 = (it & 63) * 16;
                        const int Lf = sel ? 256 : 2048;
                        const float* hd = HDN + (size_t)(e == 0 ? (sel ? 2048 : 0) : 2304) * 64;
                        float* fo = (sel ? FILTC : FILT);
                        const int ch = tid & 15, lg = tid >> 4, c = cg0 + ch;
                        const float* wo = INP(I_FWOUT) + (size_t)e * 64 * 2048 + dir * 1024 + c;
                        const float dstart = -15.350567286626973f, dstop = -3.0701134573253946f;
                        const float delta = fabsf(dstart + (float)c * ((dstop - dstart) / 1023.0f));
                        float asum = 0.f;
                        for (int l = lg; l < Lf; l += 32) {
                            float f = 0.f;
                            for (int j = 0; j < 64; ++j) f += hd[(size_t)l * 64 + j] * wo[(size_t)j * 2048];
                            const float tt = (float)l / (float)(Lf - 1);
                            f *= expf(-tt * delta);
                            if (dir == 1 && l == 0) { fo[c] = 0.f; }
                            else { fo[(size_t)(dir ? (Lf - l) : (Lf + l)) * 1024 + c] = f; asum += fabsf(f); }
                        }
                        fred[lg * 16 + ch] = asum;
                        __syncthreads();
                        if (tid < 16) { float s = 0.f; for (int q = 0; q < 32; ++q) s += fred[q * 16 + tid];
                            float* NS = HDN + (size_t)(2048 + 256 + 2048) * 64;
                            NS[((size_t)sel * 2 + dir) * 1024 + cg0 + tid] = s; }
                        __syncthreads();
                    }
                }
            } else if (EN_E2 && even && step == 2) {
                const bf16_t* PDQ = (const bf16_t*)(BIG + EV_F);
                bf16_t* QLAT = (bf16_t*)(BIG + EV_E); bf16_t* KVLAT = (bf16_t*)(BIG + EV_E + UU / 4);
                const float* qan = INP(I_QAN) + e * 256; const float* kvan = INP(I_KVAN) + e * 128;
                for (int m = gw; m < MTOT; m += NGW) {
                    const bf16_t* pr = PDQ + (size_t)m * 512;
                    const u32x2 wq = *(const u32x2*)(pr + 4 * lane);
                    const float q0 = bflo(wq.x), q1 = bfhi(wq.x), q2 = bflo(wq.y), q3 = bfhi(wq.y);
                    const float rq = 1.0f / sqrtf(wave_sum(q0 * q0 + q1 * q1 + q2 * q2 + q3 * q3, lane) * (1.f / 256.f) + NORM_EPS);
                    const f32x4 gq = *(const f32x4*)(qan + 4 * lane);
                    u32x2 oq; oq.x = pk2(q0 * rq * gq.x, q1 * rq * gq.y); oq.y = pk2(q2 * rq * gq.z, q3 * rq * gq.w);
                    *(u32x2*)(QLAT + (size_t)m * 256 + 4 * lane) = oq;
                    const unsigned wk = *(const unsigned*)(pr + 256 + 2 * lane);
                    const float k0 = bflo(wk), k1 = bfhi(wk);
                    const float rk = 1.0f / sqrtf(wave_sum(k0 * k0 + k1 * k1, lane) * (1.f / 128.f) + NORM_EPS);
                    *(unsigned*)(KVLAT + (size_t)m * 256 + 2 * lane) = pk2(k0 * rk * kvan[2 * lane], k1 * rk * kvan[2 * lane + 1]);
                    *(unsigned*)(KVLAT + (size_t)m * 256 + 128 + 2 * lane) = 0u;
                }
            } else if (EN_E4 && even && step == 4) {
                bf16_t* Q = (bf16_t*)(BIG + EV_C); bf16_t* K = (bf16_t*)(BIG + EV_G);
                const bf16_t* KNOPE = (const bf16_t*)(BIG + EV_E + UU / 2); const bf16_t* PDQ = (const bf16_t*)(BIG + EV_F);
                const float* qn = INP(I_QN) + e * 96; const float* kn = INP(I_KN) + e * 96;
                const int hh = lane >> 3, d0 = (lane & 7) * 12;
                for (int m = gw; m < MTOT; m += NGW) {
                    const bool lat = m < NLAT; const int t = m & 2047;
                    const float frow = (float)(t >> 6), fcol = (float)(t & 63);
#pragma unroll
                    for (int which = 0; which < 2; ++which) {
                        float v[12];
                        if (which == 0) {
                            const bf16_t* src = Q + (size_t)m * 768 + lane * 12;
#pragma unroll
                            for (int j = 0; j < 6; ++j) { const unsigned w = *(const unsigned*)(src + 2 * j); v[2 * j] = bflo(w); v[2 * j + 1] = bfhi(w); }
                        } else {
#pragma unroll
                            for (int j = 0; j < 12; ++j) { const int d = d0 + j;
                                v[j] = (d < 64) ? bf2f(KNOPE[(size_t)m * 512 + hh * 64 + d]) : bf2f(PDQ[(size_t)m * 512 + 384 + (d - 64)]); }
                        }
                        float ss = 0.f;
#pragma unroll
                        for (int j = 0; j < 12; ++j) ss += v[j] * v[j];
                        const float rs = 1.0f / sqrtf(sum8(ss, lane) * (1.f / 96.f) + NORM_EPS);
                        const float* gn = which ? kn : qn;
#pragma unroll
                        for (int j = 0; j < 12; ++j) v[j] = v[j] * rs * gn[d0 + j];
                        if (lat) {
#pragma unroll
                            for (int j = 0; j < 12; j += 2) { const int d = d0 + j;
                                if (d >= 64) { const int pi = (d - 64) >> 1;
                                    const float inv = powf(10000.0f, -(float)(pi & 7) / 8.0f);
                                    const float ang = ((pi < 8) ? frow : fcol) * inv;
                                    const float cs = cosf(ang), sn = sinf(ang);
                                    const float aa = v[j], bb = v[j + 1];
                                    v[j] = aa * cs - bb * sn; v[j + 1] = aa * sn + bb * cs; } }
                        }
                        bf16_t* dst = (which ? K : Q) + (size_t)m * 768 + lane * 12;
#pragma unroll
                        for (int j = 0; j < 6; ++j) *(unsigned*)(dst + 2 * j) = pk2(v[2 * j], v[2 * j + 1]);
                    }
                }
            } else if (EN_E5 && even && step == 5) {
                const int nscan = (G >= 256) ? 128 : (G / 2);
                if (EN_SCAN && bid < nscan) {
                    const bf16_t* PRW = (const bf16_t*)(BIG + ((layer == 0) ? 0 : 0) + EV_A);
                    bf16_t* OUT = (bf16_t*)(BIG + EV_E);
                    constexpr int TC = 32;
                    LAS float* WUPs = (LAS float*)lds;
                    LAS float* AUPs = WUPs + 4096;
                    LAS float* SH = AUPs + 4096;
                    LAS float* ST = SH + TC * 320;
                    const float* mup = INP(I_MUP) + e * 1792; const float* mun = INP(I_MUN) + e * 1792;
                    for (int chain = bid; chain < 128; chain += nscan) {
                        const int b = chain >> 4, hh = (chain >> 1) & 7, dir = chain & 1;
                        __syncthreads();
                        for (int i = tid; i < 4096; i += NTHREADS) { const int j = i >> 6, c = i & 63;
                            WUPs[i] = INP(I_WUP)[(((size_t)e * 2 + dir) * 64 + j) * 512 + hh * 64 + c];
                            AUPs[i] = INP(I_AUP)[(((size_t)e * 2 + dir) * 64 + j) * 512 + hh * 64 + c]; }
                        float S[8];
#pragma unroll
                        for (int j = 0; j < 8; ++j) S[j] = 0.f;
                        const int vrow = tid >> 3, ks = tid & 7;
                        for (int ch = 0; ch < 2304 / TC; ++ch) {
                            const int j0 = ch * TC; const bool isctx = j0 < 256; const int seglen = isctx ? 256 : 2048;
                            const int rowbase = isctx ? (NLAT + b * 256) : (b * 2048);
                            __syncthreads();
                            for (int i = tid; i < TC * 320; i += NTHREADS) {
                                const int s = i / 320, rem = i - s * 320, grp = rem >> 6, c = rem & 63;
                                const int jj = j0 + s; const int tt = isctx ? (dir ? 255 - jj : jj) : (dir ? 2047 - (jj - 256) : (jj - 256));
                                const int col = (grp < 3) ? (grp * 512 + hh * 64 + c) : ((grp == 3 ? 1536 : 1664) + dir * 64 + c);
                                const bf16_t* pp = PRW + (size_t)(rowbase + tt) * 1792 + col;
                                const float p = bf2f(pp[0]);
                                const float pv = (tt > 0) ? bf2f(pp[-1792]) : 0.f;
                                const float nx = (tt < seglen - 1) ? bf2f(pp[1792]) : 0.f;
                                float v = p + (pv - p) * mup[col] + (nx - p) * mun[col];
                                if (grp == 3) v = tanhf(v);
                                SH[i] = v;
                            }
                            __syncthreads();
                            {
                                const int c = lane, tq = wave;
                                float wz[4], az[4];
                                const float w0v = INP(I_W0)[((size_t)e * 2 + dir) * 512 + hh * 64 + c], a0v = INP(I_A0)[((size_t)e * 2 + dir) * 512 + hh * 64 + c];
#pragma unroll
                                for (int q = 0; q < 4; ++q) { wz[q] = w0v; az[q] = a0v; }
                                for (int j = 0; j < 64; ++j) {
                                    const float wu = WUPs[j * 64 + c], au = AUPs[j * 64 + c];
#pragma unroll
                                    for (int q = 0; q < 4; ++q) { const int s = tq * 4 + q; wz[q] += SH[s * 320 + 3 * 64 + j] * wu; az[q] += SH[s * 320 + 4 * 64 + j] * au; }
                                }
                                const float kkw = INP(I_KK)[e * 512 + hh * 64 + c], kaw = INP(I_KA)[e * 512 + hh * 64 + c];
                                const float rkw = INP(I_RK)[(((size_t)e * 2 + dir) * 8 + hh) * 64 + c];
#pragma unroll
                                for (int q = 0; q < 4; ++q) {
                                    const int s = tq * 4 + q;
                                    const float x = -wz[q];
                                    const float sp = fmaxf(x, 0.f) + log1pf(expf(-fabsf(x)));
                                    const float wlog = -sp - 0.5f;
                                    const float dec = expf(-expf(wlog));
                                    const float av = 1.0f / (1.0f + expf(-az[q]));
                                    const float rv = SH[s * 320 + c], kv = SH[s * 320 + 64 + c];
                                    const float kr = kv * kkw;
                                    const float nrm = wave_sum(kr * kr, lane);
                                    const float kkn = kr * (1.0f / sqrtf(fmaxf(nrm, 1e-24f)));
                                    const float kd = kv * (1.0f + (av - 1.0f) * kaw);
                                    const float bon = wave_sum(rv * kd * rkw, lane);
                                    ST[s * 320 + c] = -kkn; ST[s * 320 + 64 + c] = dec; ST[s * 320 + 128 + c] = kkn * av; ST[s * 320 + 192 + c] = kd; ST[s * 320 + 256 + c] = rv;
                                    if (lane == 0) { const int jj = j0 + s; const int tt = isctx ? (dir ? 255 - jj : jj) : (dir ? 2047 - (jj - 256) : (jj - 256));
                                        BONUS[((size_t)(rowbase + tt) * 2 + dir) * 8 + hh] = bon; }
                                }
                            }
                            __syncthreads();
                            for (int s = 0; s < TC; ++s) {
                                const LAS float* st = ST + s * 320 + ks * 8;
                                const f32x4 n0 = *(const LAS f32x4*)(st), n1 = *(const LAS f32x4*)(st + 4);
                                const f32x4 w0 = *(const LAS f32x4*)(st + 64), w1 = *(const LAS f32x4*)(st + 68);
                                const f32x4 b0 = *(const LAS f32x4*)(st + 128), b1 = *(const LAS f32x4*)(st + 132);
                                const f32x4 k0 = *(const LAS f32x4*)(st + 192), k1 = *(const LAS f32x4*)(st + 196);
                                const f32x4 r0 = *(const LAS f32x4*)(st + 256), r1 = *(const LAS f32x4*)(st + 260);
                                const float vv = SH[s * 320 + 128 + vrow];
                                float sa = (S[0] * n0.x + S[1] * n0.y) + (S[2] * n0.z + S[3] * n0.w) + (S[4] * n1.x + S[5] * n1.y) + (S[6] * n1.z + S[7] * n1.w);
                                sa = sum8(sa, lane);
                                S[0] = S[0] * w0.x + sa * b0.x + vv * k0.x; S[1] = S[1] * w0.y + sa * b0.y + vv * k0.y;
                                S[2] = S[2] * w0.z + sa * b0.z + vv * k0.z; S[3] = S[3] * w0.w + sa * b0.w + vv * k0.w;
                                S[4] = S[4] * w1.x + sa * b1.x + vv * k1.x; S[5] = S[5] * w1.y + sa * b1.y + vv * k1.y;
                                S[6] = S[6] * w1.z + sa * b1.z + vv * k1.z; S[7] = S[7] * w1.w + sa * b1.w + vv * k1.w;
                                float o = (S[0] * r0.x + S[1] * r0.y) + (S[2] * r0.z + S[3] * r0.w) + (S[4] * r1.x + S[5] * r1.y) + (S[6] * r1.z + S[7] * r1.w);
                                o = sum8(o, lane);
                                if (ks == 0) { const int jj = j0 + s; const int tt = isctx ? (dir ? 255 - jj : jj) : (dir ? 2047 - (jj - 256) : (jj - 256));
                                    OUT[((size_t)(rowbase + tt) * 2 + dir) * 512 + hh * 64 + vrow] = (bf16_t)f2bf(o); }
                            }
                        }
                    }
                } else if (EN_ATTN && bid >= nscan) {
                    bf16_t* Q = (bf16_t*)(BIG + EV_C); const bf16_t* K = (const bf16_t*)(BIG + EV_G); const bf16_t* V = (const bf16_t*)(BIG + EV_D);
                    const int nunits = 512 + (ctx_out ? 64 : 0);
                    const int nab = G - nscan;
                    for (int unit = bid - nscan; unit < nunits; unit += nab) {
                        int b, hh, q0, nlat, NT;
                        if (unit < 512) { b = unit >> 6; hh = (unit >> 3) & 7; q0 = b * 2048 + (unit & 7) * 256; nlat = 32; NT = 36; }
                        else { const int u2 = unit - 512; b = u2 >> 3; hh = u2 & 7; q0 = NLAT + b * 256; nlat = 0; NT = 4; }
                        att::attn_body(Q + (size_t)q0 * 768 + hh * 96, K + hh * 96, V + hh * 64, Q + (size_t)q0 * 768 + hh * 96, b * 2048, NLAT + b * 256, nlat, NT, (LAS char*)lds, tid);
                    }
}
            } else if (EN_E6 && even && step == 6) {
                const bf16_t* O = (const bf16_t*)(BIG + EV_C); const bf16_t* PG = (const bf16_t*)(BIG + EV_B); const bf16_t* PRW = (const bf16_t*)(BIG + EV_A);
                const bf16_t* OUT = (const bf16_t*)(BIG + EV_E);
                bf16_t* U = (bf16_t*)(BIG + EV_D);
                const float* mup = INP(I_MUP) + e * 1792 + 1024; const float* mun = INP(I_MUN) + e * 1792 + 1024;
                const float* lnw = INP(I_LNW) + e * 512; const float* lnb = INP(I_LNB) + e * 512;
                for (int m = gw; m < Mout; m += NGW) {
                    const int hh = lane >> 3, ch0 = lane * 8;
                    {
                        const u32x4 ow = *(const u32x4*)(O + (size_t)m * 768 + hh * 96 + (lane & 7) * 8);
                        const u32x4 gwd = *(const u32x4*)(PG + (size_t)m * 1024 + ch0);
                        u32x4 r;
                        r.x = pk2(bflo(ow.x) * silu_f(bflo(gwd.x)), bfhi(ow.x) * silu_f(bfhi(gwd.x)));
                        r.y = pk2(bflo(ow.y) * silu_f(bflo(gwd.y)), bfhi(ow.y) * silu_f(bfhi(gwd.y)));
                        r.z = pk2(bflo(ow.z) * silu_f(bflo(gwd.z)), bfhi(ow.z) * silu_f(bfhi(gwd.z)));
                        r.w = pk2(bflo(ow.w) * silu_f(bflo(gwd.w)), bfhi(ow.w) * silu_f(bfhi(gwd.w)));
                        *(u32x4*)(U + (size_t)m * 1024 + ch0) = r;
                    }
                    {
                        const u32x4 o0 = *(const u32x4*)(OUT + ((size_t)m * 2 + 0) * 512 + ch0), o1 = *(const u32x4*)(OUT + ((size_t)m * 2 + 1) * 512 + ch0);
                        float ov[8];
                        ov[0] = bflo(o0.x) + bflo(o1.x); ov[1] = bfhi(o0.x) + bfhi(o1.x); ov[2] = bflo(o0.y) + bflo(o1.y); ov[3] = bfhi(o0.y) + bfhi(o1.y);
                        ov[4] = bflo(o0.z) + bflo(o1.z); ov[5] = bfhi(o0.z) + bfhi(o1.z); ov[6] = bflo(o0.w) + bflo(o1.w); ov[7] = bfhi(o0.w) + bfhi(o1.w);
                        float s = 0.f;
#pragma unroll
                        for (int j = 0; j < 8; ++j) s += ov[j];
                        const float mu = sum8(s, lane) * (1.f / 64.f);
                        float s2 = 0.f;
#pragma unroll
                        for (int j = 0; j < 8; ++j) { ov[j] -= mu; s2 += ov[j] * ov[j]; }
                        const float rstd = 1.0f / sqrtf(sum8(s2, lane) * (1.f / 64.f) + 64e-5f);
                        const float bon = BONUS[((size_t)m * 2 + 0) * 8 + hh] + BONUS[((size_t)m * 2 + 1) * 8 + hh];
                        const bool lat = m < NLAT; const int tt = lat ? (m & 2047) : ((m - NLAT) & 255); const int seglen = lat ? 2048 : 256;
                        const bf16_t* pp = PRW + (size_t)m * 1792 + 1024 + ch0;
                        const u32x4 pc = *(const u32x4*)pp;
                        u32x4 pv = (u32x4){0u, 0u, 0u, 0u}, pn = (u32x4){0u, 0u, 0u, 0u};
                        if (tt > 0) pv = *(const u32x4*)(pp - 1792);
                        if (tt < seglen - 1) pn = *(const u32x4*)(pp + 1792);
                        const u32x4 gwd = *(const u32x4*)(PG + (size_t)m * 1024 + 512 + ch0);
                        float res[8];
#pragma unroll
                        for (int j = 0; j < 8; ++j) {
                            const unsigned wc_ = (j < 2) ? pc.x : (j < 4) ? pc.y : (j < 6) ? pc.z : pc.w;
                            const unsigned wp_ = (j < 2) ? pv.x : (j < 4) ? pv.y : (j < 6) ? pv.z : pv.w;
                            const unsigned wn_ = (j < 2) ? pn.x : (j < 4) ? pn.y : (j < 6) ? pn.z : pn.w;
                            const unsigned wg_ = (j < 2) ? gwd.x : (j < 4) ? gwd.y : (j < 6) ? gwd.z : gwd.w;
                            const float p = (j & 1) ? bfhi(wc_) : bflo(wc_), pr = (j & 1) ? bfhi(wp_) : bflo(wp_), nx = (j & 1) ? bfhi(wn_) : bflo(wn_);
                            const float gg = (j & 1) ? bfhi(wg_) : bflo(wg_);
                            const float vs = p + (pr - p) * mup[ch0 + j] + (nx - p) * mun[ch0 + j];
                            const float on = ov[j] * rstd * lnw[ch0 + j] + lnb[ch0 + j] + bon * vs;
                            res[j] = on * silu_f(gg);
                        }
                        u32x4 r; r.x = pk2(res[0], res[1]); r.y = pk2(res[2], res[3]); r.z = pk2(res[4], res[5]); r.w = pk2(res[6], res[7]);
                        *(u32x4*)(U + (size_t)m * 1024 + 512 + ch0) = r;
                    }
                }
            } else if (EN_O2 && !even && step == 2) {
                const bf16_t* P0 = (const bf16_t*)(BIG + OD_P); const bf16_t* P1 = (const bf16_t*)(BIG + OD_P + UU); const bf16_t* P2 = (const bf16_t*)(BIG + OD_P + 2 * UU);
                bf16_t* P3 = (bf16_t*)(BIG + OD_P + 3 * UU); bf16_t* VX = (bf16_t*)(BIG + OD_HV);
                const float* cw = INP(I_CONVW) + (size_t)e * 3 * 3072; const float* cb = INP(I_CONVB) + (size_t)e * 3072;
                for (int m = gw; m < Mrows; m += NGW) {
                    const bool lat = m < NLAT; const int tt = lat ? (m & 2047) : ((m - NLAT) & 255); const int seglen = lat ? 2048 : 256;
                    const bool hp = tt > 0, hn = tt < seglen - 1;
#pragma unroll
                    for (int j = 0; j < 2; ++j) {
                        const int c0 = lane * 8 + j * 512;
                        float cv[3][8];
#pragma unroll
                        for (int part = 0; part < 3; ++part) {
                            const bf16_t* pp = ((part == 0) ? P0 : (part == 1) ? P1 : P2) + (size_t)m * 1024 + c0;
                            const u32x4 wc_ = *(const u32x4*)pp;
                            u32x4 wp_ = (u32x4){0u, 0u, 0u, 0u}, wn_ = (u32x4){0u, 0u, 0u, 0u};
                            if (hp) wp_ = *(const u32x4*)(pp - 1024);
                            if (hn) wn_ = *(const u32x4*)(pp + 1024);
                            const float* w0 = cw + part * 1024 + c0; const float* w1 = cw + 3072 + part * 1024 + c0; const float* w2 = cw + 6144 + part * 1024 + c0;
                            const float* bb = cb + part * 1024 + c0;
#pragma unroll
                            for (int q = 0; q < 8; ++q) {
                                const unsigned a_ = (q < 2) ? wc_.x : (q < 4) ? wc_.y : (q < 6) ? wc_.z : wc_.w;
                                const unsigned p_ = (q < 2) ? wp_.x : (q < 4) ? wp_.y : (q < 6) ? wp_.z : wp_.w;
                                const unsigned n_ = (q < 2) ? wn_.x : (q < 4) ? wn_.y : (q < 6) ? wn_.z : wn_.w;
                                const float cc = (q & 1) ? bfhi(a_) : bflo(a_), pr = (q & 1) ? bfhi(p_) : bflo(p_), nx = (q & 1) ? bfhi(n_) : bflo(n_);
                                cv[part][q] = pr * w0[q] + cc * w1[q] + nx * w2[q] + bb[q];
                            }
                        }
                        const u32x4 gw_ = *(const u32x4*)(P3 + (size_t)m * 1024 + c0);
                        float vx[8], zz[8];
#pragma unroll
                        for (int q = 0; q < 8; ++q) {
                            const unsigned g_ = (q < 2) ? gw_.x : (q < 4) ? gw_.y : (q < 6) ? gw_.z : gw_.w;
                            const float gg = (q & 1) ? bfhi(g_) : bflo(g_);
                            vx[q] = cv[2][q] * cv[1][q]; zz[q] = cv[0][q] * silu_f(gg);
                        }
                        u32x4 r; r.x = pk2(vx[0], vx[1]); r.y = pk2(vx[2], vx[3]); r.z = pk2(vx[4], vx[5]); r.w = pk2(vx[6], vx[7]);
                        *(u32x4*)(VX + (size_t)m * 1024 + c0) = r;
                        u32x4 r2; r2.x = pk2(zz[0], zz[1]); r2.y = pk2(zz[2], zz[3]); r2.z = pk2(zz[4], zz[5]); r2.w = pk2(zz[6], zz[7]);
                        *(u32x4*)(P3 + (size_t)m * 1024 + c0) = r2;
                    }
                }
            } else if (EN_O3 && !even && step == 3) {
                const bf16_t* VX = (const bf16_t*)(BIG + OD_HV); const bf16_t* Z = (const bf16_t*)(BIG + OD_P + 3 * UU);
                bf16_t* U2 = (bf16_t*)(BIG + OD_P + UU);
                const float* FILT = (const float*)(BIG + OD_FILT); const float* FILTC = FILT + (size_t)2 * 2048 * 1024;
                const float* NS = HDN + (size_t)(2048 + 256 + 2048) * 64;
                const float* bd = INP(I_BIASD) + e * 1024;
                for (int item = bid; item < Mrows / 4; item += G) {
                    const int m0 = item * 4;
                    const bool lat = m0 < NLAT; const int tt0 = lat ? (m0 & 2047) : ((m0 - NLAT) & 255); const int Lf = lat ? 2048 : 256;
                    const int r0 = m0 - tt0; const int sel = lat ? 0 : 1;
                    const float* FU = lat ? FILT : FILTC;
                    const int c = 2 * tid;
                    float2 w0 = *(const float2*)(FU + (size_t)(tt0 + 0 + Lf) * 1024 + c), w1 = *(const float2*)(FU + (size_t)(tt0 + 1 + Lf) * 1024 + c);
                    float2 w2 = *(const float2*)(FU + (size_t)(tt0 + 2 + Lf) * 1024 + c), w3 = *(const float2*)(FU + (size_t)(tt0 + 3 + Lf) * 1024 + c);
                    float ya[4] = {0.f, 0.f, 0.f, 0.f}, yb[4] = {0.f, 0.f, 0.f, 0.f};
                    for (int s = 0; s < Lf; ++s) {
                        const unsigned w = *(const unsigned*)(VX + (size_t)(r0 + s) * 1024 + c);
                        const float va = bflo(w), vb = bfhi(w);
                        ya[0] += va * w0.x; yb[0] += vb * w0.y; ya[1] += va * w1.x; yb[1] += vb * w1.y;
                        ya[2] += va * w2.x; yb[2] += vb * w2.y; ya[3] += va * w3.x; yb[3] += vb * w3.y;
                        w3 = w2; w2 = w1; w1 = w0; w0 = *(const float2*)(FU + (size_t)(tt0 - s - 1 + Lf) * 1024 + c);
                    }
                    const float n0 = 1.0f / (NS[((size_t)sel * 2 + 0) * 1024 + c] + NS[((size_t)sel * 2 + 1) * 1024 + c]);
                    const float n1 = 1.0f / (NS[((size_t)sel * 2 + 0) * 1024 + c + 1] + NS[((size_t)sel * 2 + 1) * 1024 + c + 1]);
#pragma unroll
                    for (int i = 0; i < 4; ++i) {
                        const int m = m0 + i;
                        const unsigned wv = *(const unsigned*)(VX + (size_t)m * 1024 + c), wz = *(const unsigned*)(Z + (size_t)m * 1024 + c);
                        const float u0 = (ya[i] * n0 + bflo(wv) * bd[c]) * bflo(wz), u1 = (yb[i] * n1 + bfhi(wv) * bd[c + 1]) * bfhi(wz);
                        *(unsigned*)(U2 + (size_t)m * 1024 + c) = pk2(u0, u1);
                    }
                }
            }

            for (int jb = 0; EN_GR && jb < nroute; ++jb) {
                pg8::Gemm g; pg8::EpiRoute E;
                if (even && step == 1) {
                    g = pg8::Gemm{(const bf16_t*)(BIG + EV_E), WIN, MTOT, 3328, 1024};
                    E.base[0] = (bf16_t*)(BIG + EV_A); E.ld[0] = 1792; E.base[1] = (bf16_t*)(BIG + EV_B); E.ld[1] = 1024; E.base[2] = (bf16_t*)(BIG + EV_F); E.ld[2] = 512;
                    E.base[3] = E.base[2]; E.ld[3] = 512; E.t0 = 7; E.t1 = 11; E.t2 = 64;
                } else if (even && jb == 0) {
                    g = pg8::Gemm{(const bf16_t*)(BIG + EV_E), WUQ, MTOT, 768, 256};
                    E.base[0] = (bf16_t*)(BIG + EV_C); E.ld[0] = 768; E.base[1] = E.base[0]; E.ld[1] = 768; E.base[2] = E.base[0]; E.ld[2] = 768; E.base[3] = E.base[0]; E.ld[3] = 768;
                    E.t0 = 64; E.t1 = 64; E.t2 = 64;
                } else if (even) {
                    g = pg8::Gemm{(const bf16_t*)(BIG + EV_E + UU / 4), WUKV, MTOT, 1024, 256};
                    E.base[0] = (bf16_t*)(BIG + EV_E + UU / 2); E.ld[0] = 512; E.base[1] = (bf16_t*)(BIG + EV_D); E.ld[1] = 512; E.base[2] = E.base[1]; E.ld[2] = 512; E.base[3] = E.base[1]; E.ld[3] = 512;
                    E.t0 = 2; E.t1 = 64; E.t2 = 64;
                } else {
                    g = pg8::Gemm{(const bf16_t*)(BIG + OD_HV), WIN, Mrows, 4096, 1024};
                    E.base[0] = (bf16_t*)(BIG + OD_P); E.base[1] = (bf16_t*)(BIG + OD_P + UU); E.base[2] = (bf16_t*)(BIG + OD_P + 2 * UU); E.base[3] = (bf16_t*)(BIG + OD_P + 3 * UU);
                    E.ld[0] = E.ld[1] = E.ld[2] = E.ld[3] = 1024; E.t0 = 4; E.t1 = 8; E.t2 = 12;
                }
                pg8::StaticOrder S; S.init(g.M, g.N, G, bid);
                pg8::gemm_phase<pg8::EpiRoute, pg8::StaticOrder, true, true>(lds, g, S, E, tid);
            }
            if (EN_GS && resid) {
                pg8::Gemm g{(const bf16_t*)(BIG + (even ? EV_D : (OD_P + UU))), WOUT, Mout, 1024, 1024};
                pg8::EpiResid E{xsrc, a.out, xcsrc, XC, mods};
                pg8::StaticOrder S; S.init(g.M, g.N, G, bid);
                pg8::gemm_phase<pg8::EpiResid, pg8::StaticOrder, true, true>(lds, g, S, E, tid);
            }
            grid.sync();
        }
    }
}

extern "C" void kernel_launch(void* const* d_in, const int* in_sizes, int n_in, void* d_out, int out_size,
                              void* d_ws, size_t ws_size, hipStream_t stream) {
    static int grid_blocks = 0;
    if (!grid_blocks) {
        int dev = 0, cus = 0, per_cu = 0;
        (void)hipGetDevice(&dev);
        (void)hipDeviceGetAttribute(&cus, hipDeviceAttributeMultiprocessorCount, dev);
        (void)hipFuncSetAttribute((const void*)mega_fwd, hipFuncAttributeMaxDynamicSharedMemorySize, LDS_BYTES);
        (void)hipOccupancyMaxActiveBlocksPerMultiprocessor(&per_cu, (const void*)mega_fwd, NTHREADS, LDS_BYTES);
        if (per_cu < 1) per_cu = 1;
        if (per_cu > 1) per_cu = 1;
        grid_blocks = cus * per_cu;
        if (n_in != 37 || ws_size < 268435456) fprintf(stderr, "kernel_launch: unexpected n_in %d / ws %zu\n", n_in, ws_size);
    }
    Args a{};
    for (int i = 0; i < 37 && i < n_in; ++i) a.in[i] = (const float*)d_in[i];
    a.out = (float*)d_out; a.ws = (unsigned char*)d_ws;
    void* args[] = {&a};
    hipError_t e = hipLaunchCooperativeKernel((const void*)mega_fwd, dim3(grid_blocks), dim3(NTHREADS), args, LDS_BYTES, stream);
    if (e != hipSuccess) fprintf(stderr, "cooperative launch failed: %s (grid %d)\n", hipGetErrorString(e), grid_blocks);
}
```

```cpp
#include <hip/hip_runtime.h>
#include <hip/hip_cooperative_groups.h>
#include <cstdio>
#include <cstdint>
namespace cg = cooperative_groups;

#define LAS __attribute__((address_space(3)))
#define GAS __attribute__((address_space(1)))
typedef unsigned short bf16_t;
typedef short bf16x8 __attribute__((ext_vector_type(8)));
typedef float f32x4 __attribute__((ext_vector_type(4)));
typedef unsigned u32x4 __attribute__((ext_vector_type(4)));
typedef unsigned u32x2 __attribute__((ext_vector_type(2)));

#ifndef EN_P0
#define EN_P0 1
#endif
#ifndef EN_NORM
#define EN_NORM 1
#endif
#ifndef EN_E2
#define EN_E2 1
#endif
#ifndef EN_E4
#define EN_E4 1
#endif
#ifndef EN_E5
#define EN_E5 1
#endif
#ifndef EN_SCAN
#define EN_SCAN 1
#endif
#ifndef EN_ATTN
#define EN_ATTN 1
#endif
#ifndef EN_E6
#define EN_E6 1
#endif
#ifndef EN_O2
#define EN_O2 1
#endif
#ifndef EN_O3
#define EN_O3 1
#endif
#ifndef EN_GR
#define EN_GR 1
#endif
#ifndef EN_GS
#define EN_GS 1
#endif
constexpr int NB = 8, SEQ = 2048, DM = 1024, CTXL = 256;
constexpr int NLAT = NB * SEQ;
constexpr int NCTX = NB * CTXL;
constexpr int MTOT = NLAT + NCTX;
constexpr int NTHREADS = 512, NWAVES = 8;
constexpr int LDS_BYTES = 147456;
constexpr float NORM_EPS = 1e-6f;

constexpr size_t UU = (size_t)MTOT * 1024 * 2;
constexpr size_t MiB = 1u << 20;
constexpr size_t OFF_MODS = 0;
constexpr size_t OFF_BONUS = MiB / 2;
constexpr size_t OFF_HDN = 2 * MiB;
constexpr size_t OFF_WTS = 4 * MiB;
constexpr size_t OFF_XC = 15 * MiB;
constexpr size_t OFF_BIG = 23 * MiB;
constexpr size_t EV_A = 0;
constexpr size_t EV_B = EV_A + UU * 7 / 4;
constexpr size_t EV_C = EV_B + UU;
constexpr size_t EV_D = EV_C + UU * 3 / 4;
constexpr size_t EV_F = EV_D + UU / 2;
constexpr size_t EV_E = EV_F + UU / 2;
constexpr size_t EV_G = EV_E + UU;
constexpr size_t EV_END = EV_G + UU * 3 / 4;
constexpr size_t OD_P = 0;
constexpr size_t OD_HV = 4 * UU;
constexpr size_t OD_FILT = 5 * UU;
constexpr size_t OD_END = OD_FILT + (size_t)1024 * 4112 * 2 + (size_t)1024 * 528 * 2;
static_assert(OFF_BIG + EV_END <= 268435456 && OFF_BIG + OD_END <= 268435456, "ws map");
constexpr size_t W_IN = 0;
constexpr size_t W_OUT = (size_t)4096 * 1024 * 2;
constexpr size_t W_UQ = W_OUT + (size_t)1024 * 1024 * 2;
constexpr size_t W_UKV = W_UQ + (size_t)768 * 256 * 2;
static_assert(W_UKV + (size_t)1024 * 256 * 2 <= 11 * MiB, "weights region");

__device__ __forceinline__ unsigned f2bf(float f) { unsigned u = __builtin_bit_cast(unsigned, f); return (u + 0x7fffu + ((u >> 16) & 1u)) >> 16; }
__device__ __forceinline__ unsigned pk2(float lo, float hi) { return f2bf(lo) | (f2bf(hi) << 16); }
__device__ __forceinline__ float bf2f(unsigned h) { return __builtin_bit_cast(float, (h & 0xffffu) << 16); }
__device__ __forceinline__ float bflo(unsigned w) { return __builtin_bit_cast(float, w << 16); }
__device__ __forceinline__ float bfhi(unsigned w) { return __builtin_bit_cast(float, w & 0xffff0000u); }
__device__ __forceinline__ float shx(float v, int m, int lane) { return __builtin_bit_cast(float, __builtin_amdgcn_ds_bpermute((lane ^ m) << 2, __builtin_bit_cast(int, v))); }
__device__ __forceinline__ float bcast(float v, int src) { return __builtin_bit_cast(float, __builtin_amdgcn_readlane(__builtin_bit_cast(int, v), src)); }
__device__ __forceinline__ float wave_sum(float v, int lane) {
#pragma unroll
    for (int o = 1; o < 64; o <<= 1) v += shx(v, o, lane);
    return v;
}
__device__ __forceinline__ float sum8(float v, int lane) { v += shx(v, 1, lane); v += shx(v, 2, lane); v += shx(v, 4, lane); return v; }
__device__ __forceinline__ float silu_f(float x) { return x / (1.0f + __expf(-x)); }
__device__ __forceinline__ float sigmoid_f(float x) { return 1.0f / (1.0f + __expf(-x)); }

namespace pg8 {
constexpr int BM = 256, BK = 64, HALF = 128, HTB = HALF * BK * 2, STAGE_BYTES = 8 * HTB, NXCD = 8, WGM = 8;
__host__ __device__ __forceinline__ int lds_byte(int r, int c) { const int st = (r >> 4) * 2 + (c >> 5), rr = r & 15, cc = c & 31, ob = rr * 64 + cc * 2; return st * 1024 + (ob ^ (((ob >> 9) & 1) << 5)); }
__host__ __device__ __forceinline__ void stage_rc(int b, int& R, int& C) { const int st = b / 1024, sb = b % 1024, swz = sb ^ (((sb >> 9) & 1) << 5); R = (st >> 1) * 16 + swz / 64; C = (st & 1) * 32 + (swz % 64) / 2; }
__host__ __device__ __forceinline__ int perm32(int rho) { const int n = rho >> 4, i = rho & 15; return 8 * (i >> 2) + 4 * n + (i & 3); }
struct Unit { int pm, pn; };
struct Gemm { const bf16_t* A; const bf16_t* Bt; int M, N, K; };
struct StaticOrder {
    int nM, nN, nwg, G, c;
    __host__ __device__ void init(int M, int N, int G_, int c_) { nM = M / BM; nN = N / BM; nwg = nM * nN; G = G_; c = c_; }
    __host__ __device__ bool next(int i, Unit& u) const {
        const long L = (long)i * G + c; if (L >= nwg) return false;
        int wgid = (int)L; { const int q = nwg / NXCD, r = nwg % NXCD, xcd = wgid % NXCD, off = wgid / NXCD; wgid = (xcd < r ? xcd * (q + 1) : r * (q + 1) + (xcd - r) * q) + off; }
        const int nig = WGM * nN, gid = wgid / nig, fm = gid * WGM, gsz = (nM - fm) < WGM ? (nM - fm) : WGM;
        u.pm = fm + ((wgid % nig) % gsz); u.pn = (wgid % nig) / gsz; return true;
    }
    __device__ __forceinline__ void a_ready(const Unit&) const {}
    __device__ __forceinline__ void done(const Unit&) const {}
};

struct EpiRoute {
    static constexpr bool PERM = true, AFTER_DRAIN = false;
    bf16_t* base[4]; int ld[4]; int t0, t1, t2;
    __device__ __forceinline__ void operator()(const f32x4 (&acc)[2][2][4][2], const Unit& u, int wr, int wc, int fr, int fq) const {
        const int row0 = u.pm * BM + wr * 64 + fr;
        bf16_t* b; int ldc, colt;
        if (u.pn < t0) { b = base[0]; ldc = ld[0]; colt = u.pn * BM; }
        else if (u.pn < t1) { b = base[1]; ldc = ld[1]; colt = (u.pn - t0) * BM; }
        else if (u.pn < t2) { b = base[2]; ldc = ld[2]; colt = (u.pn - t1) * BM; }
        else { b = base[3]; ldc = ld[3]; colt = (u.pn - t2) * BM; }
        const int col0 = colt + wc * 32 + 8 * fq;
#pragma unroll
        for (int ai = 0; ai < 2; ++ai)
#pragma unroll
            for (int m = 0; m < 4; ++m) {
                const int row = row0 + ai * HALF + m * 16;
                {
                    bf16_t* rowp = b + (size_t)row * ldc + col0;
#pragma unroll
                    for (int bj = 0; bj < 2; ++bj) {
                        const f32x4 v0 = acc[ai][bj][m][0], v1 = acc[ai][bj][m][1];
                        u32x4 w; w.x = pk2(v0[0], v0[1]); w.y = pk2(v0[2], v0[3]); w.z = pk2(v1[0], v1[1]); w.w = pk2(v1[2], v1[3]);
                        *(u32x4*)(rowp + bj * HALF) = w;
                    }
                }
            }
    }
};
struct EpiResid {
    static constexpr bool PERM = false, AFTER_DRAIN = false;
    const float* xsrc; float* xdst; const float* xcsrc; float* xcdst; const float* mods;
    __device__ __forceinline__ void operator()(const f32x4 (&acc)[2][2][4][2], const Unit& u, int wr, int wc, int fr, int fq) const {
        const int row0 = u.pm * BM + wr * 64 + fr, col0 = u.pn * BM + wc * 32 + 4 * fq;
#pragma unroll
        for (int ai = 0; ai < 2; ++ai)
#pragma unroll
            for (int m = 0; m < 4; ++m) {
                const int row = row0 + ai * HALF + m * 16;
                const float* src; float* dst; const float* gt;
                if (row < NLAT) { src = xsrc + (size_t)row * DM; dst = xdst + (size_t)row * DM; gt = mods + (row >> 11) * 3072 + 2048; }
                else { const int r2 = row - NLAT; src = xcsrc + (size_t)r2 * DM; dst = xcdst + (size_t)r2 * DM; gt = mods + 8 * 3072 + 2048; }
#pragma unroll
                for (int bj = 0; bj < 2; ++bj)
#pragma unroll
                    for (int n = 0; n < 2; ++n) {
                        const int col = col0 + bj * HALF + n * 16;
                        const f32x4 xs = *(const f32x4*)(src + col), g = *(const f32x4*)(gt + col);
                        *(f32x4*)(dst + col) = xs + g * acc[ai][bj][m][n];
                    }
            }
    }
};

template <class Epi, class Sched, bool ALIGN_EPI = false, bool SP2 = false>
__device__ __forceinline__ void gemm_phase(LAS unsigned char* lds, const Gemm g, const Sched& S, const Epi& E, const int tid) {
    const int wid = __builtin_amdgcn_readfirstlane(tid >> 6), lane = tid & 63, wr = wid >> 2, wc = wid & 3, fr = lane & 15, fq = lane >> 4;
    const int K = g.K, nt = K / BK;
    unsigned voffA[2], voffB[2];
#pragma unroll
    for (int i = 0; i < 2; ++i) { int R, C; stage_rc(tid * 16 + i * 8192, R, C); const int Rb = Epi::PERM ? ((R & ~31) + perm32(R & 31)) : R;
        voffA[i] = (unsigned)(R * K + C) * 2u; voffB[i] = (unsigned)(Rb * K + C) * 2u; }
    const size_t kstep = (size_t)(BK * 2);
    const size_t hstep = (size_t)HALF * K * 2;
    const size_t tstep = 2 * hstep;
    const unsigned ldsw = (unsigned)wid * 1024u;
    const int aoff = lds_byte(wr * 64 + fr, fq * 8), boff = lds_byte(wc * 32 + fr, fq * 8);
#define PG8_SA(b, h) (((b) * 2 + (h)) * HTB)
#define PG8_SB(b, h) ((4 + (b) * 2 + (h)) * HTB)
#define PG8_STAGE(bufoff, gbase, voff) do { _Pragma("unroll") for (int _i = 0; _i < 2; ++_i) \
        __builtin_amdgcn_global_load_lds((const unsigned*)((const char*)(gbase) + (voff)[_i]), (LAS unsigned*)(lds + (bufoff) + ldsw + _i * 8192), 16, 0, 0); } while (0)
#define PG8_LDA(dst, b, h) do { _Pragma("unroll") for (int m = 0; m < 4; ++m) _Pragma("unroll") for (int k = 0; k < 2; ++k) dst[m][k] = *(const LAS bf16x8*)(lds + PG8_SA(b, h) + aoff + m * 2048 + k * 1024); } while (0)
#define PG8_LDB(dst, b, h) do { _Pragma("unroll") for (int n = 0; n < 2; ++n) _Pragma("unroll") for (int k = 0; k < 2; ++k) dst[n][k] = *(const LAS bf16x8*)(lds + PG8_SB(b, h) + boff + n * 2048 + k * 1024); } while (0)
#define PG8_MMA(ai, bj, At, Bt) do { __builtin_amdgcn_s_setprio(1); _Pragma("unroll") for (int m = 0; m < 4; ++m) _Pragma("unroll") for (int n = 0; n < 2; ++n) _Pragma("unroll") for (int k = 0; k < 2; ++k) \
        acc[ai][bj][m][n] = __builtin_amdgcn_mfma_f32_16x16x32_bf16(Bt[n][k], At[m][k], acc[ai][bj][m][n], 0, 0, 0); __builtin_amdgcn_s_setprio(0); } while (0)
#define PG8_WAIT_V(n) asm volatile("s_waitcnt vmcnt(" #n ")" ::: "memory")
#define PG8_WAIT_L(n) asm volatile("s_waitcnt lgkmcnt(" #n ")" ::: "memory")
#define PG8_BAR __builtin_amdgcn_s_barrier()
#define PG8_SCHED __builtin_amdgcn_sched_barrier(0)
    Unit cur, nxt; int ui = 0;
    if (!S.next(0, cur)) return;
    f32x4 acc[2][2][4][2];
#pragma unroll
    for (int a = 0; a < 2; ++a)
#pragma unroll
        for (int b = 0; b < 2; ++b)
#pragma unroll
            for (int m = 0; m < 4; ++m)
#pragma unroll
                for (int n = 0; n < 2; ++n) acc[a][b][m][n] = (f32x4){0.f, 0.f, 0.f, 0.f};
    bf16x8 At[4][2], B0[2][2], B1[2][2];
    const char* cA = (const char*)g.A + (size_t)cur.pm * tstep; const char* cB = (const char*)g.Bt + (size_t)cur.pn * tstep;
    S.a_ready(cur);
    if constexpr (SP2) {
        PG8_STAGE(PG8_SB(0, 0), cB, voffB); PG8_STAGE(PG8_SB(0, 1), cB + hstep, voffB); PG8_STAGE(PG8_SA(0, 0), cA, voffA); PG8_STAGE(PG8_SA(0, 1), cA + hstep, voffA);
        if (wr == 1) PG8_BAR;
        PG8_WAIT_V(2); PG8_BAR;
        PG8_STAGE(PG8_SB(1, 0), cB + kstep, voffB); PG8_STAGE(PG8_SA(1, 0), cA + kstep, voffA); PG8_STAGE(PG8_SB(1, 1), cB + hstep + kstep, voffB);
        PG8_WAIT_V(6); PG8_BAR;
    } else {
        PG8_STAGE(PG8_SB(0, 0), cB, voffB); PG8_STAGE(PG8_SA(0, 0), cA, voffA); PG8_STAGE(PG8_SB(0, 1), cB + hstep, voffB); PG8_STAGE(PG8_SA(0, 1), cA + hstep, voffA);
        if (wr == 1) PG8_BAR;
        PG8_WAIT_V(4); PG8_BAR;
        PG8_STAGE(PG8_SB(1, 0), cB + kstep, voffB); PG8_STAGE(PG8_SA(1, 0), cA + kstep, voffA); PG8_STAGE(PG8_SB(1, 1), cB + hstep + kstep, voffB);
        PG8_WAIT_V(6); PG8_BAR;
    }
    for (;;) {
        const bool has_next = S.next(ui + 1, nxt);
        const char* nA = has_next ? (const char*)g.A + (size_t)nxt.pm * tstep : cA; const char* nB = has_next ? (const char*)g.Bt + (size_t)nxt.pn * tstep : cB;
        for (int t = 0; t < nt; t += 2) {
            const bool last = (t == nt - 2);
            const char* a1 = cA + (size_t)(t + 1) * kstep;
            const char* a2 = last ? nA : cA + (size_t)(t + 2) * kstep; const char* b2 = last ? nB : cB + (size_t)(t + 2) * kstep;
            const char* a3 = a2 + kstep; const char* b3 = b2 + kstep;
            if (last && has_next) S.a_ready(nxt);
            if constexpr (SP2) {
            PG8_LDB(B0, 0, 0); PG8_LDB(B1, 0, 1); PG8_SCHED; PG8_LDA(At, 0, 0); PG8_STAGE(PG8_SA(1, 1), a1 + hstep, voffA);
            PG8_WAIT_V(8); PG8_WAIT_L(0); PG8_BAR; PG8_MMA(0, 0, At, B0); PG8_MMA(0, 1, At, B1); PG8_BAR; PG8_SCHED;
            PG8_LDA(At, 0, 1); PG8_STAGE(PG8_SB(0, 0), b2, voffB); PG8_STAGE(PG8_SB(0, 1), b2 + hstep, voffB); PG8_STAGE(PG8_SA(0, 0), a2, voffA);
            PG8_WAIT_V(8); PG8_WAIT_L(0); PG8_BAR; PG8_MMA(1, 0, At, B0); PG8_MMA(1, 1, At, B1); PG8_BAR; PG8_SCHED;
            PG8_LDB(B0, 1, 0); PG8_LDB(B1, 1, 1); PG8_SCHED; PG8_LDA(At, 1, 0); PG8_STAGE(PG8_SA(0, 1), a2 + hstep, voffA);
            PG8_WAIT_V(8); PG8_WAIT_L(0); PG8_BAR; PG8_MMA(0, 0, At, B0); PG8_MMA(0, 1, At, B1); PG8_BAR; PG8_SCHED;
            PG8_LDA(At, 1, 1); PG8_STAGE(PG8_SB(1, 0), b3, voffB); PG8_STAGE(PG8_SB(1, 1), b3 + hstep, voffB); PG8_STAGE(PG8_SA(1, 0), a3, voffA);
            PG8_WAIT_V(8); PG8_WAIT_L(0); PG8_BAR; PG8_MMA(1, 0, At, B0); PG8_MMA(1, 1, At, B1); PG8_BAR; PG8_SCHED;
            } else {
            PG8_LDB(B0, 0, 0); PG8_SCHED; PG8_LDA(At, 0, 0); PG8_STAGE(PG8_SA(1, 1), a1 + hstep, voffA);
            PG8_WAIT_L(8); PG8_BAR; PG8_WAIT_L(0); PG8_MMA(0, 0, At, B0); PG8_BAR; PG8_SCHED;
            PG8_LDB(B1, 0, 1); PG8_STAGE(PG8_SB(0, 0), b2, voffB);
            PG8_BAR; PG8_WAIT_L(0); PG8_MMA(0, 1, At, B1); PG8_BAR;
            PG8_LDA(At, 0, 1); PG8_STAGE(PG8_SA(0, 0), a2, voffA);
            PG8_BAR; PG8_WAIT_L(0); PG8_MMA(1, 0, At, B0); PG8_BAR; PG8_SCHED;
            PG8_STAGE(PG8_SB(0, 1), b2 + hstep, voffB);
            PG8_WAIT_V(6); PG8_BAR; PG8_MMA(1, 1, At, B1); PG8_BAR;
            PG8_LDB(B0, 1, 0); PG8_SCHED; PG8_LDA(At, 1, 0); PG8_STAGE(PG8_SA(0, 1), a2 + hstep, voffA);
            PG8_WAIT_L(8); PG8_BAR; PG8_WAIT_L(0); PG8_MMA(0, 0, At, B0); PG8_BAR; PG8_SCHED;
            PG8_LDB(B1, 1, 1); PG8_STAGE(PG8_SB(1, 0), b3, voffB);
            PG8_BAR; PG8_WAIT_L(0); PG8_MMA(0, 1, At, B1); PG8_BAR;
            PG8_LDA(At, 1, 1); PG8_STAGE(PG8_SA(1, 0), a3, voffA);
            PG8_BAR; PG8_WAIT_L(0); PG8_MMA(1, 0, At, B0); PG8_BAR; PG8_SCHED;
            PG8_STAGE(PG8_SB(1, 1), b3 + hstep, voffB);
            PG8_WAIT_V(6); PG8_BAR; PG8_MMA(1, 1, At, B1); PG8_BAR;
            }
        }
        if constexpr (ALIGN_EPI) { if (wr == 0) PG8_BAR; }
        if constexpr (!Epi::AFTER_DRAIN) { E(acc, cur, wr, wc, fr, fq); S.done(cur); }
        if (!has_next) break;
#pragma unroll
        for (int a = 0; a < 2; ++a)
#pragma unroll
            for (int b = 0; b < 2; ++b)
#pragma unroll
                for (int m = 0; m < 4; ++m)
#pragma unroll
                    for (int n = 0; n < 2; ++n) acc[a][b][m][n] = (f32x4){0.f, 0.f, 0.f, 0.f};
        cur = nxt; cA = nA; cB = nB; ++ui;
        if constexpr (ALIGN_EPI) { if (wr == 1) PG8_BAR; }
    }
    PG8_WAIT_V(0);
    if constexpr (!ALIGN_EPI) { if (wr == 0) PG8_BAR; }
    PG8_BAR;
#undef PG8_SA
#undef PG8_SB
#undef PG8_STAGE
#undef PG8_LDA
#undef PG8_LDB
#undef PG8_MMA
#undef PG8_WAIT_V
#undef PG8_WAIT_L
#undef PG8_BAR
#undef PG8_SCHED
}
}


namespace att {
using f32x16 = __attribute__((ext_vector_type(16))) float;
using s16x4 = __attribute__((ext_vector_type(4))) short;
constexpr int NW = 8, QBLK = 32, KVBLK = 64, LDQ = 768, LDK = 768, LDV = 512;
constexpr float SCALE = 0.10206207261596575f;
constexpr float THR = 8.f;
constexpr int SHM_V = 16384, SHM_K = 16384, SHM_ATTN = 2 * SHM_V + 2 * SHM_K + NW * 64 * 4;
#define KSWZ(row, colB) ((row) * 256 + ((colB) ^ (((row) & 7) << 4)))
#define SBAR() __builtin_amdgcn_sched_barrier(0)
__device__ __forceinline__ int crow(int r, int hi) { return (r & 3) + 8 * (r >> 2) + 4 * hi; }
__device__ __forceinline__ unsigned cvtpk(float lo, float hi) { unsigned r; asm volatile("v_cvt_pk_bf16_f32 %0, %1, %2" : "=v"(r) : "v"(lo), "v"(hi)); return r; }
__device__ __forceinline__ void partialSM(f32x16& p0, f32x16& p1, float& m_reg, float& mn, float& alpha) {
  constexpr float C = SCALE * 1.4426950408889634f;
  float pmax = p0[0];
#pragma unroll
  for (int r = 1; r < 16; ++r) pmax = fmaxf(pmax, p0[r]);
#pragma unroll
  for (int r = 0; r < 16; ++r) pmax = fmaxf(pmax, p1[r]);
  { auto rr = __builtin_amdgcn_permlane32_swap(__float_as_uint(pmax), __float_as_uint(pmax), false, false);
    pmax = fmaxf(__uint_as_float(rr[0]), __uint_as_float(rr[1])); }
  if (__builtin_expect(__all(pmax - m_reg <= THR / SCALE), 1)) { mn = m_reg; alpha = 1.f; }
  else { mn = fmaxf(m_reg, pmax); alpha = __builtin_amdgcn_exp2f((m_reg - mn) * C); m_reg = mn; }
  float mnC = -mn * C;
#pragma unroll
  for (int r = 0; r < 16; ++r) p0[r] = fmaf(p0[r], C, mnC);
#pragma unroll
  for (int r = 0; r < 16; ++r) p1[r] = fmaf(p1[r], C, mnC);
#pragma unroll
  for (int r = 0; r < 16; ++r) p0[r] = __builtin_amdgcn_exp2f(p0[r]);
}
__device__ __forceinline__ void finishSM(f32x16& p0, f32x16& p1, float alpha, float& l_reg, bf16x8& pa0, bf16x8& pa1, bf16x8& pa2, bf16x8& pa3) {
#pragma unroll
  for (int r = 0; r < 16; ++r) p1[r] = __builtin_amdgcn_exp2f(p1[r]);
  float ps = 0;
#pragma unroll
  for (int r = 0; r < 16; ++r) ps += p0[r];
#pragma unroll
  for (int r = 0; r < 16; ++r) ps += p1[r];
  { auto rr = __builtin_amdgcn_permlane32_swap(__float_as_uint(ps), __float_as_uint(ps), false, false);
    ps = __uint_as_float(rr[0]) + __uint_as_float(rr[1]); }
  l_reg = l_reg * alpha + ps;
#define PK4(P, BASE, OUT) do { unsigned a0 = cvtpk(P[BASE + 0], P[BASE + 1]), a1 = cvtpk(P[BASE + 2], P[BASE + 3]);   \
    unsigned b0 = cvtpk(P[BASE + 4], P[BASE + 5]), b1 = cvtpk(P[BASE + 6], P[BASE + 7]);                              \
    auto r0 = __builtin_amdgcn_permlane32_swap(a0, b0, false, false); auto r1 = __builtin_amdgcn_permlane32_swap(a1, b1, false, false); \
    u32x4 w = {r0[0], r1[0], r0[1], r1[1]}; OUT = __builtin_bit_cast(bf16x8, w); } while (0)
  PK4(p0, 0, pa0); PK4(p0, 8, pa1); PK4(p1, 0, pa2); PK4(p1, 8, pa3);
#undef PK4
}
__device__ __forceinline__ void qkt(f32x16& p0, f32x16& p1, const LAS char* Ks, const bf16x8* qr, int r32, int hi) {
  p0 = f32x16{}; p1 = f32x16{};
#pragma unroll
  for (int d0 = 0; d0 < 6; ++d0) { const int cb = (d0 * 16 + hi * 8) * 2;
    const bf16x8 b0 = *(const LAS bf16x8*)(Ks + KSWZ(r32, cb));
    const bf16x8 b1 = *(const LAS bf16x8*)(Ks + KSWZ(32 + r32, cb));
    p0 = __builtin_amdgcn_mfma_f32_32x32x16_bf16(b0, qr[d0], p0, 0, 0, 0);
    p1 = __builtin_amdgcn_mfma_f32_32x32x16_bf16(b1, qr[d0], p1, 0, 0, 0); }
}
__device__ __forceinline__ int v_st(int k, int c) { const int kk = (k & ~0xC) | ((k & 4) << 1) | ((k & 8) >> 1); return ((kk >> 3) * 4 + (c >> 5)) * 512 + ((kk & 7) * 32 + (c & 31)) * 2; }
__device__ __forceinline__ int v_rd_base(int lane) { return ((lane & 3) << 3) | (((lane >> 2) & 3) << 6) | (((lane >> 4) & 1) << 5) | (((lane >> 5) & 1) << 8); }
constexpr int v_rd_off(int d0, int ks, int half) { return d0 * 512 + ks * 4096 + half * 2048; }
template <int OFF> __device__ __forceinline__ s16x4 tr_read(int vb) {
  s16x4 r; asm volatile("ds_read_b64_tr_b16 %0, %1 offset:%2" : "=&v"(r) : "v"(vb), "i"(OFF) : "memory"); return r;
}
template <int D0> __device__ __forceinline__ void pv_one(f32x16& od, int vb, bf16x8 pa0, bf16x8 pa1, bf16x8 pa2, bf16x8 pa3) {
  const s16x4 l0 = tr_read<v_rd_off(D0, 0, 0)>(vb), h0 = tr_read<v_rd_off(D0, 0, 1)>(vb), l1 = tr_read<v_rd_off(D0, 1, 0)>(vb), h1 = tr_read<v_rd_off(D0, 1, 1)>(vb);
  const s16x4 l2 = tr_read<v_rd_off(D0, 2, 0)>(vb), h2 = tr_read<v_rd_off(D0, 2, 1)>(vb), l3 = tr_read<v_rd_off(D0, 3, 0)>(vb), h3 = tr_read<v_rd_off(D0, 3, 1)>(vb);
  asm volatile("s_waitcnt lgkmcnt(0)" ::: "memory"); SBAR();
#define PK(L, H) (bf16x8){L[0], L[1], L[2], L[3], H[0], H[1], H[2], H[3]}
  od = __builtin_amdgcn_mfma_f32_32x32x16_bf16(pa0, PK(l0, h0), od, 0, 0, 0);
  od = __builtin_amdgcn_mfma_f32_32x32x16_bf16(pa1, PK(l1, h1), od, 0, 0, 0);
  od = __builtin_amdgcn_mfma_f32_32x32x16_bf16(pa2, PK(l2, h2), od, 0, 0, 0);
  od = __builtin_amdgcn_mfma_f32_32x32x16_bf16(pa3, PK(l3, h3), od, 0, 0, 0);
#undef PK
}
__device__ __forceinline__ void pv_d0(f32x16* o, int vb, bf16x8 pa0, bf16x8 pa1, bf16x8 pa2, bf16x8 pa3) {
  pv_one<0>(o[0], vb, pa0, pa1, pa2, pa3); pv_one<1>(o[1], vb, pa0, pa1, pa2, pa3);
}
__device__ __forceinline__ void attn_body(const bf16_t* Qb, const bf16_t* Kh, const bf16_t* Vh, bf16_t* Ob, int rlat, int rctx, int nlat, int NT, LAS char* lds, int tid) {
  const int wid = tid >> 6, lane = tid & 63, r32 = lane & 31, hi = lane >> 5;
  LAS char* V_lds = lds; LAS char* K_lds = lds + 2 * SHM_V;
  LAS float* wsl = (LAS float*)(lds + 2 * SHM_V + 2 * SHM_K) + wid * 64; LAS float* li_l = wsl; LAS float* al_l = wsl + 32;
  float m_reg = -1e30f, l_reg = 0; f32x16 o[2] = {}; bf16x8 qr[6];
  const bf16_t* Qw = Qb + (long)(wid * QBLK + r32) * LDQ + hi * 8;
#pragma unroll
  for (int d0 = 0; d0 < 6; ++d0) qr[d0] = *(const bf16x8*)(Qw + d0 * 16);
  const int cid1 = 512 + (tid & 255);
  const int kr0 = tid / 12, kc0 = (tid % 12) * 8, kr1 = cid1 / 12, kc1 = (cid1 % 12) * 8, vr = tid >> 3, vc = (tid & 7) * 8;
  const int vst0 = v_st(vr, vc), kst0 = KSWZ(kr0, kc0 * 2), kst1 = KSWZ(kr1, kc1 * 2);
  const int vb0 = (int)(unsigned)(unsigned long)V_lds + v_rd_base(lane);
  struct { bf16x8 vs0, ks0, ks1; } sr_[2];
#define TROW(j) ((j) < nlat ? rlat + 64 * (j) : rctx + 64 * ((j) - nlat))
#define SLOAD(i, j) do { const long rb_ = TROW(j); sr_[i].vs0 = *(const bf16x8*)(Vh + (rb_ + vr) * LDV + vc); \
    sr_[i].ks0 = *(const bf16x8*)(Kh + (rb_ + kr0) * LDK + kc0); sr_[i].ks1 = *(const bf16x8*)(Kh + (rb_ + kr1) * LDK + kc1); } while (0)
#define SWRITE(b, i) do { *(LAS bf16x8*)(V_lds + (b) * SHM_V + vst0) = sr_[i].vs0; \
    *(LAS bf16x8*)(K_lds + (b) * SHM_K + kst0) = sr_[i].ks0; *(LAS bf16x8*)(K_lds + (b) * SHM_K + kst1) = sr_[i].ks1; } while (0)
#define SWAIT() asm volatile("s_waitcnt vmcnt(3)" ::: "memory")
#define RESC(a) do { if (__any((a) < 1.f)) { if (hi == 0) al_l[r32] = (a); asm volatile("s_waitcnt lgkmcnt(0)" ::: "memory"); \
    _Pragma("unroll") for (int d = 0; d < 2; ++d) _Pragma("unroll") for (int r = 0; r < 16; ++r) o[d][r] *= al_l[crow(r, hi)]; } } while (0)
  f32x16 pA0, pA1, pB0, pB1; float mnA, mnB, alA, alB; bf16x8 pa0, pa1, pa2, pa3;
  constexpr int SE = 0, SO = 1;
  SLOAD(SE, 0); asm volatile("s_waitcnt vmcnt(0)" ::: "memory"); SWRITE(0, SE); __syncthreads();
  qkt(pA0, pA1, K_lds, qr, r32, hi); partialSM(pA0, pA1, m_reg, mnA, alA);
  SLOAD(SO, 1); if (2 < NT) SLOAD(SE, 2);
  SWAIT(); SWRITE(1, SO); __syncthreads();
  for (int j = 1; j + 1 < NT; j += 2) {
    SBAR(); qkt(pB0, pB1, K_lds + SHM_K, qr, r32, hi);
    finishSM(pA0, pA1, alA, l_reg, pa0, pa1, pa2, pa3); SBAR();
    SLOAD(SO, j + 2); SBAR();
    pv_d0(o, vb0, pa0, pa1, pa2, pa3); partialSM(pB0, pB1, m_reg, mnB, alB);
    __syncthreads(); SWAIT(); SWRITE(0, SE);
    RESC(alB); __syncthreads();
    SBAR(); qkt(pA0, pA1, K_lds, qr, r32, hi);
    finishSM(pB0, pB1, alB, l_reg, pa0, pa1, pa2, pa3); SBAR();
    if (j + 3 < NT) SLOAD(SE, j + 3); SBAR();
    pv_d0(o, vb0 + SHM_V, pa0, pa1, pa2, pa3); partialSM(pA0, pA1, m_reg, mnA, alA);
    __syncthreads(); SWAIT(); SWRITE(1, SO);
    RESC(alA); __syncthreads();
  }
  SBAR(); qkt(pB0, pB1, K_lds + SHM_K, qr, r32, hi);
  finishSM(pA0, pA1, alA, l_reg, pa0, pa1, pa2, pa3); SBAR();
  pv_d0(o, vb0, pa0, pa1, pa2, pa3); partialSM(pB0, pB1, m_reg, mnB, alB);
  __syncthreads(); RESC(alB);
  finishSM(pB0, pB1, alB, l_reg, pa0, pa1, pa2, pa3); SBAR();
  pv_d0(o, vb0 + SHM_V, pa0, pa1, pa2, pa3);
  if (hi == 0) li_l[r32] = l_reg; asm volatile("s_waitcnt lgkmcnt(0)" ::: "memory");
  float rli[16];
#pragma unroll
  for (int r = 0; r < 16; ++r) rli[r] = __builtin_amdgcn_rcpf(li_l[crow(r, hi)]);
  bf16_t* Ow = Ob + (long)(wid * QBLK) * LDQ;
#pragma unroll
  for (int r = 0; r < 16; ++r) { const int orow = crow(r, hi);
#pragma unroll
    for (int d0 = 0; d0 < 2; ++d0) Ow[(long)orow * LDQ + d0 * 32 + r32] = (bf16_t)f2bf(o[d0][r] * rli[r]); }
  __syncthreads();
#undef TROW
#undef SLOAD
#undef SWRITE
#undef SWAIT
#undef RESC
}
}

struct Args { const float* in[37]; float* out; unsigned char* ws; };

enum { I_X = 0, I_C, I_CTX, I_CCTX, I_MODW, I_MODB, I_NORMG, I_EVWIN, I_EVWOUT, I_QAN, I_WUQ, I_KVAN, I_WUKV, I_QN, I_KN,
       I_MUP, I_MUN, I_W0, I_WUP, I_A0, I_AUP, I_KK, I_KA, I_RK, I_LNW, I_LNB, I_ODWIN, I_ODWOUT, I_CONVW, I_CONVB, I_BIASD,
       I_FW1, I_FB1, I_FW2, I_FB2, I_FWOUT, I_FREQ };

#define INP(i) (a.in[(i) + opq0])
__device__ __forceinline__ void transpose_item(const float* W, int ldw, int src_col0, bool valid, bf16_t* WT, int Kd, int dst_row0, int k0, LAS float* scr, int lane) {
    if (valid) {
#pragma unroll 8
        for (int i = 0; i < 32; ++i) { const int kk = 2 * i + (lane >> 5); scr[kk * 33 + (lane & 31)] = W[(size_t)(k0 + kk) * ldw + src_col0 + (lane & 31)]; }
    } else {
#pragma unroll 8
        for (int i = 0; i < 32; ++i) { const int kk = 2 * i + (lane >> 5); scr[kk * 33 + (lane & 31)] = 0.f; }
    }
    asm volatile("s_waitcnt vmcnt(0) lgkmcnt(0)" ::: "memory");
    const int c = lane & 7;
#pragma unroll
    for (int j = 0; j < 4; ++j) { const int n = (lane >> 3) + 8 * j; const LAS float* s = scr + (8 * c) * 33 + n;
        u32x4 o; o.x = pk2(s[0 * 33], s[1 * 33]); o.y = pk2(s[2 * 33], s[3 * 33]); o.z = pk2(s[4 * 33], s[5 * 33]); o.w = pk2(s[6 * 33], s[7 * 33]);
        *(u32x4*)(WT + (size_t)(dst_row0 + n) * Kd + k0 + 8 * c) = o; }
    asm volatile("s_waitcnt lgkmcnt(0)" ::: "memory");
}

__device__ __forceinline__ void norm_row(const float* xrow, const float* g, const float* md, bf16_t* orow, int lane) {
    const f32x4* xr = (const f32x4*)xrow + lane;
    f32x4 v[4]; float s = 0.f;
#pragma unroll
    for (int j = 0; j < 4; ++j) { v[j] = xr[64 * j]; s += (v[j].x * v[j].x + v[j].y * v[j].y) + (v[j].z * v[j].z + v[j].w * v[j].w); }
    const float rstd = 1.0f / sqrtf(wave_sum(s, lane) * (1.f / DM) + NORM_EPS);
    u32x2* o8 = (u32x2*)orow + lane;
#pragma unroll
    for (int j = 0; j < 4; ++j) {
        const f32x4 gg = ((const f32x4*)g)[lane + 64 * j], sh = ((const f32x4*)md)[lane + 64 * j], sc = ((const f32x4*)(md + 1024))[lane + 64 * j];
        const f32x4 y = (v[j] * rstd) * gg * (sc + 1.0f) + sh;
        u32x2 w; w.x = pk2(y.x, y.y); w.y = pk2(y.z, y.w); o8[64 * j] = w;
    }
}

__global__ void __launch_bounds__(NTHREADS, 2) mega_fwd(Args a) {
    extern __shared__ __attribute__((aligned(16))) unsigned char lds_raw[];
    cg::grid_group grid = cg::this_grid();
    LAS unsigned char* lds = (LAS unsigned char*)lds_raw;
    const int G = gridDim.x, bid = blockIdx.x;
    const int NGW = G * NWAVES;
#define PHASE_LOCALS \
    int tid = threadIdx.x; asm volatile("" : "+v"(tid)); \
    const int lane = tid & 63, wave = __builtin_amdgcn_readfirstlane(tid >> 6); \
    const int gw = bid * NWAVES + wave; \
    int opq0 = 0; asm volatile("" : "+s"(opq0)); \
    unsigned char* ws = a.ws + opq0; \
    (void)lane; (void)wave; (void)gw; (void)ws; (void)opq0;
#define MODS ((float*)(ws + OFF_MODS))
#define BONUS ((float*)(ws + OFF_BONUS))
#define HDN ((float*)(ws + OFF_HDN))
#define XC ((float*)(ws + OFF_XC))
#define BIG (ws + OFF_BIG)
#define WIN ((bf16_t*)(ws + OFF_WTS + W_IN))
#define WOUT ((bf16_t*)(ws + OFF_WTS + W_OUT))
#define WUQ ((bf16_t*)(ws + OFF_WTS + W_UQ))
#define WUKV ((bf16_t*)(ws + OFF_WTS + W_UKV))

    if (EN_P0) {
        PHASE_LOCALS
        LAS float* sc = (LAS float*)lds;
        LAS float* red = (LAS float*)(lds + 9 * 1024 * 4);
        bool have_silu = false;
        for (int it = bid; it < 4 * 48; it += G) {
            if (!have_silu) {
                for (int i = tid; i < 9 * 1024; i += NTHREADS) { const float cv = (i < 8192) ? INP(I_C)[i] : INP(I_CCTX)[i - 8192]; sc[i] = silu_f(cv); }
                have_silu = true;
            }
            __syncthreads();
            const int layer = it / 48, cg0 = (it % 48) * 64, cl = tid & 63, kg = tid >> 6;
            const float* W = INP(I_MODW) + (size_t)layer * 1024 * 3072 + cg0 + cl;
            float acc[9];
#pragma unroll
            for (int r = 0; r < 9; ++r) acc[r] = 0.f;
            for (int k = kg * 128; k < kg * 128 + 128; ++k) {
                const float w = W[(size_t)k * 3072];
#pragma unroll
                for (int r = 0; r < 9; ++r) acc[r] += sc[r * 1024 + k] * w;
            }
#pragma unroll
            for (int r = 0; r < 9; ++r) red[(kg * 9 + r) * 64 + cl] = acc[r];
            __syncthreads();
            for (int idx = tid; idx < 9 * 64; idx += NTHREADS) {
                const int r = idx >> 6, c2 = idx & 63; float s = 0.f;
#pragma unroll
                for (int q = 0; q < 8; ++q) s += red[(q * 9 + r) * 64 + c2];
                MODS[((size_t)layer * 9 + r) * 3072 + cg0 + c2] = s + INP(I_MODB)[layer * 3072 + cg0 + c2];
            }
        }
        for (int it = gw; it < 2048 + 256 + 2048; it += NGW) {
            int o, Lf, pos; float* outp;
            if (it < 2048) { o = 0; Lf = 2048; pos = it; outp = HDN + (size_t)pos * 64; }
            else if (it < 2304) { o = 0; Lf = 256; pos = it - 2048; outp = HDN + (size_t)(2048 + pos) * 64; }
            else { o = 1; Lf = 2048; pos = it - 2304; outp = HDN + (size_t)(2304 + pos) * 64; }
            const float fpos = (float)pos, tt = fpos / (float)(Lf - 1);
            float z = 0.f;
            if (lane == 0) z = tt;
            else if (lane < 33) {
                const int bi = (lane - 1) & 15;
                const float band = 1e-4f + (float)bi * ((15.0f - 1e-4f) / 15.0f);
                const float ang = fpos * (6.283185307179586f / (float)Lf) * band;
                z = (lane < 17) ? cosf(ang) : -sinf(ang);
            }
            const float fr = INP(I_FREQ)[o * 64 + lane];
            float h = INP(I_FB1)[o * 64 + lane];
            const float* w1 = INP(I_FW1) + (size_t)o * 33 * 64;
            for (int i = 0; i < 33; ++i) h += bcast(z, i) * w1[i * 64 + lane];
            h = sinf(fr * h);
            for (int jj = 0; jj < 2; ++jj) {
                const float* w2 = INP(I_FW2) + ((size_t)o * 2 + jj) * 64 * 64;
                float h2 = INP(I_FB2)[(o * 2 + jj) * 64 + lane];
                for (int i = 0; i < 64; ++i) h2 += bcast(h, i) * w2[i * 64 + lane];
                h = sinf(fr * h2);
            }
            outp[lane] = h;
        }
    }
    grid.sync();

    for (int ph = 0; ph < 28; ++ph) {
        {
            PHASE_LOCALS
            int phs = ph; asm volatile("" : "+s"(phs));
            int layer, step;
            if (phs < 8) { layer = 0; step = phs; } else if (phs < 14) { layer = 1; step = phs - 8; } else if (phs < 22) { layer = 2; step = phs - 14; } else { layer = 3; step = phs - 22; }
            const bool even = !(layer & 1);
            const int e = layer >> 1;
            const bool ctx_out = (layer < 2);
            const bool ctx_in = (layer < 3);
            const int Mrows = ctx_in ? MTOT : NLAT;
            const int Mout = ctx_out ? MTOT : NLAT;
            const float* xsrc = (layer == 0) ? INP(I_X) : a.out;
            const float* xcsrc = (layer == 0) ? INP(I_CTX) : XC;
            const float* mods = MODS + (size_t)layer * 9 * 3072;
            int nroute = 0; bool resid = false;
            if (even) { if (step == 1) nroute = 1; else if (step == 3) nroute = 2; else if (step == 7) resid = true; }
            else { if (step == 1) nroute = 1; else if (step == 5) resid = true; }

            if (EN_NORM && step == 0) {
                bf16_t* H = (bf16_t*)(BIG + (even ? EV_E : OD_HV));
                const float* ng = INP(I_NORMG) + layer * 1024;
                for (int m = gw; m < Mrows; m += NGW) {
                    const float* xr; const float* md;
                    if (m < NLAT) { xr = xsrc + (size_t)m * DM; md = mods + (m >> 11) * 3072; }
                    else { xr = xcsrc + (size_t)(m - NLAT) * DM; md = mods + 8 * 3072; }
                    norm_row(xr, ng, md, H + (size_t)m * DM, lane);
                }
                LAS float* scr = (LAS float*)(lds + wave * 8448);
                if (even) {
                    const float* win = INP(I_EVWIN) + (size_t)e * 1024 * 3232;
                    const float* wout = INP(I_EVWOUT) + (size_t)e * 1024 * 1024;
                    const float* wuq = INP(I_WUQ) + (size_t)e * 256 * 768;
                    const float* wukv = INP(I_WUKV) + (size_t)e * 128 * 1024;
                    constexpr int N1 = 104 * 16, N2 = 32 * 16, N3 = 24 * 4, N4 = 32 * 4;
                    for (int it = gw; it < N1 + N2 + N3 + N4; it += NGW) {
                        int r = it;
                        if (r < N1) { const int nb = r / 16, kb = r % 16; const int d0 = nb * 32; int s0;
                            if (d0 < 1792) s0 = 416 + d0; else if (d0 < 2816) s0 = 2208 + (d0 - 1792); else if (d0 < 3072) s0 = d0 - 2816; else if (d0 < 3232) s0 = 256 + (d0 - 3072); else s0 = -1;
                            transpose_item(win, 3232, s0, s0 >= 0, WIN, 1024, d0, kb * 64, scr, lane); continue; }
                        r -= N1;
                        if (r < N2) { const int nb = r / 16, kb = r % 16; transpose_item(wout, 1024, nb * 32, true, WOUT, 1024, nb * 32, kb * 64, scr, lane); continue; }
                        r -= N2;
                        if (r < N3) { const int nb = r / 4, kb = r % 4; transpose_item(wuq, 768, nb * 32, true, WUQ, 256, nb * 32, kb * 64, scr, lane); continue; }
                        r -= N3;
                        { const int nb = r / 4, kb = r % 4; const int d0 = nb * 32; const int hh = (d0 & 511) >> 6, dd = d0 & 63; const int s0 = hh * 128 + dd + ((d0 >= 512) ? 64 : 0);
                          transpose_item(wukv, 1024, s0, kb < 2, WUKV, 256, d0, kb * 64, scr, lane); }
                    }
                } else {
                    const float* win = INP(I_ODWIN) + (size_t)e * 1024 * 4096;
                    const float* wout = INP(I_ODWOUT) + (size_t)e * 1024 * 1024;
                    constexpr int N1 = 128 * 16, N2 = 32 * 16;
                    for (int it = gw; it < N1 + N2; it += NGW) {
                        int r = it;
                        if (r < N1) { const int nb = r / 16, kb = r % 16; transpose_item(win, 4096, nb * 32, true, WIN, 1024, nb * 32, kb * 64, scr, lane); continue; }
                        r -= N1;
                        { const int nb = r / 16, kb = r % 16; transpose_item(wout, 1024, nb * 32, true, WOUT, 1024, nb * 32, kb * 64, scr, lane); }
                    }
                    __syncthreads();
                    bf16_t* GR = (bf16_t*)(BIG + OD_FILT);
                    bf16_t* GRC = GR + (size_t)1024 * 4112;
                    LAS float* fred = (LAS float*)(lds + 8 * 8448);
                    const int nsel = (layer == 1) ? 2 : 1;
                    const float* hdn = HDN;
                    for (int it = bid; it < nsel * 256; it += G) {
                        const int sel = it >> 8, cg0 = (it & 255) * 4;
                        const int Lf = sel ? 256 : 2048;
                        const float* hd = hdn + (size_t)(e == 0 ? (sel ? 2048 : 0) : 2304) * 64;
                        bf16_t* go = (sel ? GRC : GR);
                        const int grl = 2 * Lf + 16;
                        const int ch = tid & 3, dir = (tid >> 2) & 1, lg = tid >> 3, c = cg0 + ch;
                        const float* wo = INP(I_FWOUT) + (size_t)e * 64 * 2048 + dir * 1024 + c;
                        float wreg[64];
#pragma unroll
                        for (int j = 0; j < 64; ++j) wreg[j] = wo[(size_t)j * 2048];
                        const float dstart = -15.350567286626973f, dstop = -3.0701134573253946f;
                        const float delta = fabsf(dstart + (float)c * ((dstop - dstart) / 1023.0f));
                        const float invL1 = 1.0f / (float)(Lf - 1);
                        float asum = 0.f;
                        for (int l = lg; l < Lf; l += 64) {
                            const f32x4* hp = (const f32x4*)(hd + (size_t)l * 64);
                            float f = 0.f;
#pragma unroll
                            for (int j4 = 0; j4 < 16; ++j4) { const f32x4 h4 = hp[j4]; f += h4.x * wreg[4 * j4] + h4.y * wreg[4 * j4 + 1] + h4.z * wreg[4 * j4 + 2] + h4.w * wreg[4 * j4 + 3]; }
                            f *= expf(-((float)l * invL1) * delta);
                            if (!(dir == 1 && l == 0)) asum += fabsf(f);
                        }
                        fred[tid] = asum;
                        __syncthreads();
                        if (tid < 4) { float s = 0.f; for (int q = 0; q < 128; ++q) s += fred[q * 4 + tid]; fred[512 + tid] = s; }
                        __syncthreads();
                        const float inv = 1.0f / fred[512 + ch];
                        bf16_t* grow = go + (size_t)c * grl;
                        for (int l = lg; l < Lf; l += 64) {
                            const f32x4* hp = (const f32x4*)(hd + (size_t)l * 64);
                            float f = 0.f;
#pragma unroll
                            for (int j4 = 0; j4 < 16; ++j4) { const f32x4 h4 = hp[j4]; f += h4.x * wreg[4 * j4] + h4.y * wreg[4 * j4 + 1] + h4.z * wreg[4 * j4 + 2] + h4.w * wreg[4 * j4 + 3]; }
                            f *= expf(-((float)l * invL1) * delta);
                            if (!(dir == 1 && l == 0)) grow[8 + Lf + (dir ? l : -l)] = (bf16_t)f2bf(f * inv);
                        }
                        if (tid < 4 * 17) { const int c2 = cg0 + (tid & 3), k = tid >> 2; bf16_t* g2 = go + (size_t)c2 * grl;
                            g2[(k < 9) ? k : (2 * Lf + 8 + (k - 9))] = 0; }
                        __syncthreads();
                    }
                }
            } else if (EN_E2 && even && step == 2) {
                const bf16_t* PDQ = (const bf16_t*)(BIG + EV_F);
                bf16_t* QLAT = (bf16_t*)(BIG + EV_E); bf16_t* KVLAT = (bf16_t*)(BIG + EV_E + UU / 4);
                const float* qan = INP(I_QAN) + e * 256; const float* kvan = INP(I_KVAN) + e * 128;
                for (int m = gw; m < MTOT; m += NGW) {
                    const bf16_t* pr = PDQ + (size_t)m * 512;
                    const u32x2 wq = *(const u32x2*)(pr + 4 * lane);
                    const float q0 = bflo(wq.x), q1 = bfhi(wq.x), q2 = bflo(wq.y), q3 = bfhi(wq.y);
                    const float rq = 1.0f / sqrtf(wave_sum(q0 * q0 + q1 * q1 + q2 * q2 + q3 * q3, lane) * (1.f / 256.f) + NORM_EPS);
                    const f32x4 gq = *(const f32x4*)(qan + 4 * lane);
                    u32x2 oq; oq.x = pk2(q0 * rq * gq.x, q1 * rq * gq.y); oq.y = pk2(q2 * rq * gq.z, q3 * rq * gq.w);
                    *(u32x2*)(QLAT + (size_t)m * 256 + 4 * lane) = oq;
                    const unsigned wk = *(const unsigned*)(pr + 256 + 2 * lane);
                    const float k0 = bflo(wk), k1 = bfhi(wk);
                    const float rk = 1.0f / sqrtf(wave_sum(k0 * k0 + k1 * k1, lane) * (1.f / 128.f) + NORM_EPS);
                    *(unsigned*)(KVLAT + (size_t)m * 256 + 2 * lane) = pk2(k0 * rk * kvan[2 * lane], k1 * rk * kvan[2 * lane + 1]);
                    *(unsigned*)(KVLAT + (size_t)m * 256 + 128 + 2 * lane) = 0u;
                }
            } else if (EN_E4 && even && step == 4) {
                bf16_t* Q = (bf16_t*)(BIG + EV_C); bf16_t* K = (bf16_t*)(BIG + EV_G);
                const bf16_t* KNOPE = (const bf16_t*)(BIG + EV_E + UU / 2); const bf16_t* PDQ = (const bf16_t*)(BIG + EV_F);
                const float* qn = INP(I_QN) + e * 96; const float* kn = INP(I_KN) + e * 96;
                const int hh = lane >> 3, d0 = (lane & 7) * 12;
                for (int m = gw; m < MTOT; m += NGW) {
                    const bool lat = m < NLAT; const int t = m & 2047;
                    const float frow = (float)(t >> 6), fcol = (float)(t & 63);
#pragma unroll
                    for (int which = 0; which < 2; ++which) {
                        float v[12];
                        if (which == 0) {
                            const bf16_t* src = Q + (size_t)m * 768 + lane * 12;
#pragma unroll
                            for (int j = 0; j < 6; ++j) { const unsigned w = *(const unsigned*)(src + 2 * j); v[2 * j] = bflo(w); v[2 * j + 1] = bfhi(w); }
                        } else {
#pragma unroll
                            for (int j = 0; j < 12; ++j) { const int d = d0 + j;
                                v[j] = (d < 64) ? bf2f(KNOPE[(size_t)m * 512 + hh * 64 + d]) : bf2f(PDQ[(size_t)m * 512 + 384 + (d - 64)]); }
                        }
                        float ss = 0.f;
#pragma unroll
                        for (int j = 0; j < 12; ++j) ss += v[j] * v[j];
                        const float rs = 1.0f / sqrtf(sum8(ss, lane) * (1.f / 96.f) + NORM_EPS);
                        const float* gn = which ? kn : qn;
#pragma unroll
                        for (int j = 0; j < 12; ++j) v[j] = v[j] * rs * gn[d0 + j];
                        if (lat) {
#pragma unroll
                            for (int j = 0; j < 12; j += 2) { const int d = d0 + j;
                                if (d >= 64) { const int pi = (d - 64) >> 1;
                                    const float inv = powf(10000.0f, -(float)(pi & 7) / 8.0f);
                                    const float ang = ((pi < 8) ? frow : fcol) * inv;
                                    const float cs = cosf(ang), sn = sinf(ang);
                                    const float aa = v[j], bb = v[j + 1];
                                    v[j] = aa * cs - bb * sn; v[j + 1] = aa * sn + bb * cs; } }
                        }
                        bf16_t* dst = (which ? K : Q) + (size_t)m * 768 + lane * 12;
#pragma unroll
                        for (int j = 0; j < 6; ++j) *(unsigned*)(dst + 2 * j) = pk2(v[2 * j], v[2 * j + 1]);
                    }
                }
            } else if (EN_E5 && even && step == 5) {
                const int nscan = (G >= 256) ? 128 : (G / 2);
                if (EN_SCAN && bid < nscan) {
                    const bf16_t* PRW = (const bf16_t*)(BIG + ((layer == 0) ? 0 : 0) + EV_A);
                    bf16_t* OUT = (bf16_t*)(BIG + EV_E);
                    constexpr int TC = 32;
                    LAS float* WUPs = (LAS float*)lds;
                    LAS float* AUPs = WUPs + 4096;
                    LAS float* SH = AUPs + 4096;
                    LAS float* ST = SH + TC * 320;
                    const float* mup = INP(I_MUP) + e * 1792; const float* mun = INP(I_MUN) + e * 1792;
                    for (int chain = bid; chain < 128; chain += nscan) {
                        const int b = chain >> 4, hh = (chain >> 1) & 7, dir = chain & 1;
                        __syncthreads();
                        for (int i = tid; i < 4096; i += NTHREADS) { const int j = i >> 6, c = i & 63;
                            WUPs[i] = INP(I_WUP)[(((size_t)e * 2 + dir) * 64 + j) * 512 + hh * 64 + c];
                            AUPs[i] = INP(I_AUP)[(((size_t)e * 2 + dir) * 64 + j) * 512 + hh * 64 + c]; }
                        float S[8];
#pragma unroll
                        for (int j = 0; j < 8; ++j) S[j] = 0.f;
                        const int vrow = tid >> 3, ks = tid & 7;
                        for (int ch = 0; ch < 2304 / TC; ++ch) {
                            const int j0 = ch * TC; const bool isctx = j0 < 256; const int seglen = isctx ? 256 : 2048;
                            const int rowbase = isctx ? (NLAT + b * 256) : (b * 2048);
                            __syncthreads();
                            for (int i = tid; i < TC * 320; i += NTHREADS) {
                                const int s = i / 320, rem = i - s * 320, grp = rem >> 6, c = rem & 63;
                                const int jj = j0 + s; const int tt = isctx ? (dir ? 255 - jj : jj) : (dir ? 2047 - (jj - 256) : (jj - 256));
                                const int col = (grp < 3) ? (grp * 512 + hh * 64 + c) : ((grp == 3 ? 1536 : 1664) + dir * 64 + c);
                                const bf16_t* pp = PRW + (size_t)(rowbase + tt) * 1792 + col;
                                const float p = bf2f(pp[0]);
                                const float pv = (tt > 0) ? bf2f(pp[-1792]) : 0.f;
                                const float nx = (tt < seglen - 1) ? bf2f(pp[1792]) : 0.f;
                                float v = p + (pv - p) * mup[col] + (nx - p) * mun[col];
                                if (grp == 3) v = tanhf(v);
                                SH[i] = v;
                            }
                            __syncthreads();
                            {
                                const int c = lane, tq = wave;
                                float wz[4], az[4];
                                const float w0v = INP(I_W0)[((size_t)e * 2 + dir) * 512 + hh * 64 + c], a0v = INP(I_A0)[((size_t)e * 2 + dir) * 512 + hh * 64 + c];
#pragma unroll
                                for (int q = 0; q < 4; ++q) { wz[q] = w0v; az[q] = a0v; }
                                for (int j = 0; j < 64; ++j) {
                                    const float wu = WUPs[j * 64 + c], au = AUPs[j * 64 + c];
#pragma unroll
                                    for (int q = 0; q < 4; ++q) { const int s = tq * 4 + q; wz[q] += SH[s * 320 + 3 * 64 + j] * wu; az[q] += SH[s * 320 + 4 * 64 + j] * au; }
                                }
                                const float kkw = INP(I_KK)[e * 512 + hh * 64 + c], kaw = INP(I_KA)[e * 512 + hh * 64 + c];
                                const float rkw = INP(I_RK)[(((size_t)e * 2 + dir) * 8 + hh) * 64 + c];
#pragma unroll
                                for (int q = 0; q < 4; ++q) {
                                    const int s = tq * 4 + q;
                                    const float x = -wz[q];
                                    const float sp = fmaxf(x, 0.f) + log1pf(expf(-fabsf(x)));
                                    const float wlog = -sp - 0.5f;
                                    const float dec = expf(-expf(wlog));
                                    const float av = 1.0f / (1.0f + expf(-az[q]));
                                    const float rv = SH[s * 320 + c], kv = SH[s * 320 + 64 + c];
                                    const float kr = kv * kkw;
                                    const float nrm = wave_sum(kr * kr, lane);
                                    const float kkn = kr * (1.0f / sqrtf(fmaxf(nrm, 1e-24f)));
                                    const float kd = kv * (1.0f + (av - 1.0f) * kaw);
                                    const float bon = wave_sum(rv * kd * rkw, lane);
                                    ST[s * 320 + c] = -kkn; ST[s * 320 + 64 + c] = dec; ST[s * 320 + 128 + c] = kkn * av; ST[s * 320 + 192 + c] = kd; ST[s * 320 + 256 + c] = rv;
                                    if (lane == 0) { const int jj = j0 + s; const int tt = isctx ? (dir ? 255 - jj : jj) : (dir ? 2047 - (jj - 256) : (jj - 256));
                                        BONUS[((size_t)(rowbase + tt) * 2 + dir) * 8 + hh] = bon; }
                                }
                            }
                            __syncthreads();
                            for (int s = 0; s < TC; ++s) {
                                const LAS float* st = ST + s * 320 + ks * 8;
                                const f32x4 n0 = *(const LAS f32x4*)(st), n1 = *(const LAS f32x4*)(st + 4);
                                const f32x4 w0 = *(const LAS f32x4*)(st + 64), w1 = *(const LAS f32x4*)(st + 68);
                                const f32x4 b0 = *(const LAS f32x4*)(st + 128), b1 = *(const LAS f32x4*)(st + 132);
                                const f32x4 k0 = *(const LAS f32x4*)(st + 192), k1 = *(const LAS f32x4*)(st + 196);
                                const f32x4 r0 = *(const LAS f32x4*)(st + 256), r1 = *(const LAS f32x4*)(st + 260);
                                const float vv = SH[s * 320 + 128 + vrow];
                                float sa = (S[0] * n0.x + S[1] * n0.y) + (S[2] * n0.z + S[3] * n0.w) + (S[4] * n1.x + S[5] * n1.y) + (S[6] * n1.z + S[7] * n1.w);
                                sa = sum8(sa, lane);
                                S[0] = S[0] * w0.x + sa * b0.x + vv * k0.x; S[1] = S[1] * w0.y + sa * b0.y + vv * k0.y;
                                S[2] = S[2] * w0.z + sa * b0.z + vv * k0.z; S[3] = S[3] * w0.w + sa * b0.w + vv * k0.w;
                                S[4] = S[4] * w1.x + sa * b1.x + vv * k1.x; S[5] = S[5] * w1.y + sa * b1.y + vv * k1.y;
                                S[6] = S[6] * w1.z + sa * b1.z + vv * k1.z; S[7] = S[7] * w1.w + sa * b1.w + vv * k1.w;
                                float o = (S[0] * r0.x + S[1] * r0.y) + (S[2] * r0.z + S[3] * r0.w) + (S[4] * r1.x + S[5] * r1.y) + (S[6] * r1.z + S[7] * r1.w);
                                o = sum8(o, lane);
                                if (ks == 0) { const int jj = j0 + s; const int tt = isctx ? (dir ? 255 - jj : jj) : (dir ? 2047 - (jj - 256) : (jj - 256));
                                    OUT[((size_t)(rowbase + tt) * 2 + dir) * 512 + hh * 64 + vrow] = (bf16_t)f2bf(o); }
                            }
                        }
                    }
                } else if (EN_ATTN && bid >= nscan) {
                    bf16_t* Q = (bf16_t*)(BIG + EV_C); const bf16_t* K = (const bf16_t*)(BIG + EV_G); const bf16_t* V = (const bf16_t*)(BIG + EV_D);
                    const int nunits = 512 + (ctx_out ? 64 : 0);
                    const int nab = G - nscan;
                    for (int unit = bid - nscan; unit < nunits; unit += nab) {
                        int b, hh, q0, nlat, NT;
                        if (unit < 512) { b = unit >> 6; hh = (unit >> 3) & 7; q0 = b * 2048 + (unit & 7) * 256; nlat = 32; NT = 36; }
                        else { const int u2 = unit - 512; b = u2 >> 3; hh = u2 & 7; q0 = NLAT + b * 256; nlat = 0; NT = 4; }
                        att::attn_body(Q + (size_t)q0 * 768 + hh * 96, K + hh * 96, V + hh * 64, Q + (size_t)q0 * 768 + hh * 96, b * 2048, NLAT + b * 256, nlat, NT, (LAS char*)lds, tid);
                    }
}
            } else if (EN_E6 && even && step == 6) {
                const bf16_t* O = (const bf16_t*)(BIG + EV_C); const bf16_t* PG = (const bf16_t*)(BIG + EV_B); const bf16_t* PRW = (const bf16_t*)(BIG + EV_A);
                const bf16_t* OUT = (const bf16_t*)(BIG + EV_E);
                bf16_t* U = (bf16_t*)(BIG + EV_D);
                const float* mup = INP(I_MUP) + e * 1792 + 1024; const float* mun = INP(I_MUN) + e * 1792 + 1024;
                const float* lnw = INP(I_LNW) + e * 512; const float* lnb = INP(I_LNB) + e * 512;
                for (int m = gw; m < Mout; m += NGW) {
                    const int hh = lane >> 3, ch0 = lane * 8;
                    {
                        const u32x4 ow = *(const u32x4*)(O + (size_t)m * 768 + hh * 96 + (lane & 7) * 8);
                        const u32x4 gwd = *(const u32x4*)(PG + (size_t)m * 1024 + ch0);
                        u32x4 r;
                        r.x = pk2(bflo(ow.x) * silu_f(bflo(gwd.x)), bfhi(ow.x) * silu_f(bfhi(gwd.x)));
                        r.y = pk2(bflo(ow.y) * silu_f(bflo(gwd.y)), bfhi(ow.y) * silu_f(bfhi(gwd.y)));
                        r.z = pk2(bflo(ow.z) * silu_f(bflo(gwd.z)), bfhi(ow.z) * silu_f(bfhi(gwd.z)));
                        r.w = pk2(bflo(ow.w) * silu_f(bflo(gwd.w)), bfhi(ow.w) * silu_f(bfhi(gwd.w)));
                        *(u32x4*)(U + (size_t)m * 1024 + ch0) = r;
                    }
                    {
                        const u32x4 o0 = *(const u32x4*)(OUT + ((size_t)m * 2 + 0) * 512 + ch0), o1 = *(const u32x4*)(OUT + ((size_t)m * 2 + 1) * 512 + ch0);
                        float ov[8];
                        ov[0] = bflo(o0.x) + bflo(o1.x); ov[1] = bfhi(o0.x) + bfhi(o1.x); ov[2] = bflo(o0.y) + bflo(o1.y); ov[3] = bfhi(o0.y) + bfhi(o1.y);
                        ov[4] = bflo(o0.z) + bflo(o1.z); ov[5] = bfhi(o0.z) + bfhi(o1.z); ov[6] = bflo(o0.w) + bflo(o1.w); ov[7] = bfhi(o0.w) + bfhi(o1.w);
                        float s = 0.f;
#pragma unroll
                        for (int j = 0; j < 8; ++j) s += ov[j];
                        const float mu = sum8(s, lane) * (1.f / 64.f);
                        float s2 = 0.f;
#pragma unroll
                        for (int j = 0; j < 8; ++j) { ov[j] -= mu; s2 += ov[j] * ov[j]; }
                        const float rstd = 1.0f / sqrtf(sum8(s2, lane) * (1.f / 64.f) + 64e-5f);
                        const float bon = BONUS[((size_t)m * 2 + 0) * 8 + hh] + BONUS[((size_t)m * 2 + 1) * 8 + hh];
                        const bool lat = m < NLAT; const int tt = lat ? (m & 2047) : ((m - NLAT) & 255); const int seglen = lat ? 2048 : 256;
                        const bf16_t* pp = PRW + (size_t)m * 1792 + 1024 + ch0;
                        const u32x4 pc = *(const u32x4*)pp;
                        u32x4 pv = (u32x4){0u, 0u, 0u, 0u}, pn = (u32x4){0u, 0u, 0u, 0u};
                        if (tt > 0) pv = *(const u32x4*)(pp - 1792);
                        if (tt < seglen - 1) pn = *(const u32x4*)(pp + 1792);
                        const u32x4 gwd = *(const u32x4*)(PG + (size_t)m * 1024 + 512 + ch0);
                        float res[8];
#pragma unroll
                        for (int j = 0; j < 8; ++j) {
                            const unsigned wc_ = (j < 2) ? pc.x : (j < 4) ? pc.y : (j < 6) ? pc.z : pc.w;
                            const unsigned wp_ = (j < 2) ? pv.x : (j < 4) ? pv.y : (j < 6) ? pv.z : pv.w;
                            const unsigned wn_ = (j < 2) ? pn.x : (j < 4) ? pn.y : (j < 6) ? pn.z : pn.w;
                            const unsigned wg_ = (j < 2) ? gwd.x : (j < 4) ? gwd.y : (j < 6) ? gwd.z : gwd.w;
                            const float p = (j & 1) ? bfhi(wc_) : bflo(wc_), pr = (j & 1) ? bfhi(wp_) : bflo(wp_), nx = (j & 1) ? bfhi(wn_) : bflo(wn_);
                            const float gg = (j & 1) ? bfhi(wg_) : bflo(wg_);
                            const float vs = p + (pr - p) * mup[ch0 + j] + (nx - p) * mun[ch0 + j];
                            const float on = ov[j] * rstd * lnw[ch0 + j] + lnb[ch0 + j] + bon * vs;
                            res[j] = on * silu_f(gg);
                        }
                        u32x4 r; r.x = pk2(res[0], res[1]); r.y = pk2(res[2], res[3]); r.z = pk2(res[4], res[5]); r.w = pk2(res[6], res[7]);
                        *(u32x4*)(U + (size_t)m * 1024 + 512 + ch0) = r;
                    }
                }
            } else if (EN_O2 && !even && step == 2) {
                const bf16_t* P0 = (const bf16_t*)(BIG + OD_P); const bf16_t* P1 = (const bf16_t*)(BIG + OD_P + UU); const bf16_t* P2 = (const bf16_t*)(BIG + OD_P + 2 * UU);
                bf16_t* P3 = (bf16_t*)(BIG + OD_P + 3 * UU); bf16_t* VXT = (bf16_t*)(BIG + OD_HV);
                const float* cw = INP(I_CONVW) + (size_t)e * 3 * 3072; const float* cb = INP(I_CONVB) + (size_t)e * 3072;
                LAS bf16_t* TT = (LAS bf16_t*)lds;
                for (int item = bid; item < (Mrows / 64) * 16; item += G) {
                    const int rt = item >> 4, ct = item & 15;
                    const int m0 = rt * 64; const bool lat = m0 < NLAT;
                    const int bsel = lat ? (m0 >> 11) : ((m0 - NLAT) >> 8); const int t0 = lat ? (m0 & 2047) : ((m0 - NLAT) & 255); const int seglen = lat ? 2048 : 256;
                    {
                        const int r = tid >> 3, c0 = ct * 64 + (tid & 7) * 8; const int m = m0 + r; const int tt = t0 + r;
                        const bool hp = tt > 0, hn = tt < seglen - 1;
                        float cv[3][8];
#pragma unroll
                        for (int part = 0; part < 3; ++part) {
                            const bf16_t* pp = ((part == 0) ? P0 : (part == 1) ? P1 : P2) + (size_t)m * 1024 + c0;
                            const u32x4 wc_ = *(const u32x4*)pp;
                            u32x4 wp_ = (u32x4){0u, 0u, 0u, 0u}, wn_ = (u32x4){0u, 0u, 0u, 0u};
                            if (hp) wp_ = *(const u32x4*)(pp - 1024);
                            if (hn) wn_ = *(const u32x4*)(pp + 1024);
                            const float* w0 = cw + part * 1024 + c0; const float* w1 = cw + 3072 + part * 1024 + c0; const float* w2 = cw + 6144 + part * 1024 + c0;
                            const float* bb = cb + part * 1024 + c0;
#pragma unroll
                            for (int q = 0; q < 8; ++q) {
                                const unsigned a_ = (q < 2) ? wc_.x : (q < 4) ? wc_.y : (q < 6) ? wc_.z : wc_.w;
                                const unsigned p_ = (q < 2) ? wp_.x : (q < 4) ? wp_.y : (q < 6) ? wp_.z : wp_.w;
                                const unsigned n_ = (q < 2) ? wn_.x : (q < 4) ? wn_.y : (q < 6) ? wn_.z : wn_.w;
                                const float cc = (q & 1) ? bfhi(a_) : bflo(a_), pr = (q & 1) ? bfhi(p_) : bflo(p_), nx = (q & 1) ? bfhi(n_) : bflo(n_);
                                cv[part][q] = pr * w0[q] + cc * w1[q] + nx * w2[q] + bb[q];
                            }
                        }
                        const u32x4 gw_ = *(const u32x4*)(P3 + (size_t)m * 1024 + c0);
                        float vx[8], zz[8];
#pragma unroll
                        for (int q = 0; q < 8; ++q) {
                            const unsigned g_ = (q < 2) ? gw_.x : (q < 4) ? gw_.y : (q < 6) ? gw_.z : gw_.w;
                            const float gg = (q & 1) ? bfhi(g_) : bflo(g_);
                            vx[q] = cv[2][q] * cv[1][q]; zz[q] = cv[0][q] * silu_f(gg);
                        }
                        u32x4 rr; rr.x = pk2(vx[0], vx[1]); rr.y = pk2(vx[2], vx[3]); rr.z = pk2(vx[4], vx[5]); rr.w = pk2(vx[6], vx[7]);
                        *(LAS u32x4*)(TT + r * 72 + (tid & 7) * 8) = rr;
                        u32x4 r2; r2.x = pk2(zz[0], zz[1]); r2.y = pk2(zz[2], zz[3]); r2.z = pk2(zz[4], zz[5]); r2.w = pk2(zz[6], zz[7]);
                        *(u32x4*)(P3 + (size_t)m * 1024 + c0) = r2;
                    }
                    __syncthreads();
                    {
                        const int cc = tid >> 3, tq = tid & 7;
                        unsigned short hv[8];
#pragma unroll
                        for (int i = 0; i < 8; ++i) hv[i] = TT[(8 * tq + i) * 72 + cc];
                        u32x4 w; w.x = hv[0] | ((unsigned)hv[1] << 16); w.y = hv[2] | ((unsigned)hv[3] << 16); w.z = hv[4] | ((unsigned)hv[5] << 16); w.w = hv[6] | ((unsigned)hv[7] << 16);
                        bf16_t* dst = VXT + (lat ? (size_t)0 : (size_t)1024 * 8 * 2048) + ((size_t)(ct * 64 + cc) * 8 + bsel) * seglen + t0 + 8 * tq;
                        *(u32x4*)dst = w;
                    }
                    __syncthreads();
                }
            } else if (EN_O3 && !even && step == 3) {
                const bf16_t* VXT = (const bf16_t*)(BIG + OD_HV); bf16_t* YT = (bf16_t*)(BIG + OD_P + UU);
                const bf16_t* GR = (const bf16_t*)(BIG + OD_FILT); const bf16_t* GRC = GR + (size_t)1024 * 4112;
                const float* bd = INP(I_BIASD) + e * 1024;
                constexpr int TL = 2312;
                LAS unsigned char* Vl = lds; LAS unsigned char* Gl = lds + 36992;
                for (int i = tid; i < 36992 / 16; i += NTHREADS) *(LAS u32x4*)(Vl + 16 * i) = (u32x4){0u, 0u, 0u, 0u};
                __syncthreads();
                const int nmode = (layer == 1) ? 2 : 1;
                for (int mode = nmode - 1; mode >= 0; --mode) {
                    const int Lf = mode ? 256 : 2048; const int CS = mode ? 1088 : 8256; const int grl = 2 * Lf + 16;
                    const size_t seg_off = mode ? (size_t)1024 * 8 * 2048 : 0;
                    for (int c = bid; c < 1024; c += G) {
                        const bf16_t* vsrc = VXT + seg_off + (size_t)c * 8 * Lf;
                        for (int id = tid; id < Lf; id += NTHREADS) {
                            const int b = id / (Lf >> 3), t8 = id - b * (Lf >> 3);
                            *(LAS u32x4*)(Vl + ((b * TL + 128 + 8 * t8) * 2)) = *(const u32x4*)(vsrc + (size_t)b * Lf + 8 * t8);
                        }
                        if (tid < (Lf >> 2)) {
                            const unsigned* gsrc = (const unsigned*)((mode ? GRC : GR) + (size_t)c * grl) + 4 * tid;
                            const u32x4 lo = *(const u32x4*)gsrc, hi4 = *(const u32x4*)(gsrc + 4);
                            const unsigned d0 = lo.x, d1 = lo.y, d2 = lo.z, d3 = lo.w, d4 = hi4.x, d5 = hi4.y, d6 = hi4.z, d7 = hi4.w;
#define AB(h, l) __builtin_amdgcn_alignbit((h), (l), 16)
                            LAS unsigned char* gd = Gl + 16 * tid;
                            *(LAS u32x4*)(gd + 0 * CS) = (u32x4){d4, d5, d6, d7};
                            *(LAS u32x4*)(gd + 1 * CS) = (u32x4){AB(d4, d3), AB(d5, d4), AB(d6, d5), AB(d7, d6)};
                            *(LAS u32x4*)(gd + 2 * CS) = (u32x4){d3, d4, d5, d6};
                            *(LAS u32x4*)(gd + 3 * CS) = (u32x4){AB(d3, d2), AB(d4, d3), AB(d5, d4), AB(d6, d5)};
                            *(LAS u32x4*)(gd + 4 * CS) = (u32x4){d2, d3, d4, d5};
                            *(LAS u32x4*)(gd + 5 * CS) = (u32x4){AB(d2, d1), AB(d3, d2), AB(d4, d3), AB(d5, d4)};
                            *(LAS u32x4*)(gd + 6 * CS) = (u32x4){d1, d2, d3, d4};
                            *(LAS u32x4*)(gd + 7 * CS) = (u32x4){AB(d1, d0), AB(d2, d1), AB(d3, d2), AB(d4, d3)};
#undef AB
                        }
                        __syncthreads();
                        const bool active = mode ? (wave == 0) : true;
                        if (active) {
                            const int r = lane & 31, hh = lane >> 5, q = r & 7, rho = r >> 3, bb = r >> 2, nn = r & 3;
                            att::f32x16 accA = {}, accB = {};
                            const int T0a = mode ? 0 : wave * 8, T0b = T0a + 4;
                            const int nS = Lf >> 5;
                            const LAS unsigned char* vbase = Vl + ((bb * TL + 128 + 32 * nn + 8 * hh) * 2);
                            const LAS unsigned char* gbase = Gl + q * CS + ((Lf - 8 * rho + 8 * hh) * 2);
                            for (int S0 = -3; S0 < nS; ++S0) {
                                const int da = T0a - S0;
#pragma unroll
                                for (int kp = 0; kp < 2; ++kp) {
                                    const bf16x8 Bf = *(const LAS bf16x8*)(vbase + (32 * S0 + 16 * kp) * 2);
                                    const bf16x8 Aa = *(const LAS bf16x8*)(gbase + (-32 * da + 16 * kp) * 2);
                                    const bf16x8 Ab = *(const LAS bf16x8*)(gbase + (-32 * (da + 4) + 16 * kp) * 2);
                                    accA = __builtin_amdgcn_mfma_f32_32x32x16_bf16(Aa, Bf, accA, 0, 0, 0);
                                    accB = __builtin_amdgcn_mfma_f32_32x32x16_bf16(Ab, Bf, accB, 0, 0, 0);
                                }
                            }
                            const float bias = bd[c];
                            bf16_t* ydst = YT + seg_off + ((size_t)c * 8 + bb) * Lf;
#pragma unroll
                            for (int g = 0; g < 4; ++g) {
                                { const int t = 32 * (T0a + nn) + 8 * g + 4 * hh;
                                  const u32x2 vw = *(const LAS u32x2*)(Vl + ((bb * TL + 128 + t) * 2));
                                  u32x2 o; o.x = pk2(accA[4 * g] + bflo(vw.x) * bias, accA[4 * g + 1] + bfhi(vw.x) * bias); o.y = pk2(accA[4 * g + 2] + bflo(vw.y) * bias, accA[4 * g + 3] + bfhi(vw.y) * bias);
                                  *(u32x2*)(ydst + t) = o; }
                                { const int t = 32 * (T0b + nn) + 8 * g + 4 * hh;
                                  const u32x2 vw = *(const LAS u32x2*)(Vl + ((bb * TL + 128 + t) * 2));
                                  u32x2 o; o.x = pk2(accB[4 * g] + bflo(vw.x) * bias, accB[4 * g + 1] + bfhi(vw.x) * bias); o.y = pk2(accB[4 * g + 2] + bflo(vw.y) * bias, accB[4 * g + 3] + bfhi(vw.y) * bias);
                                  *(u32x2*)(ydst + t) = o; }
                            }
                        }
                        __syncthreads();
                    }
                }
            } else if (EN_O3 && !even && step == 4) {
                const bf16_t* YT = (const bf16_t*)(BIG + OD_P + UU); const bf16_t* Z = (const bf16_t*)(BIG + OD_P + 3 * UU); bf16_t* U2 = (bf16_t*)(BIG + OD_P);
                LAS bf16_t* TT = (LAS bf16_t*)lds;
                for (int item = bid; item < (Mrows / 64) * 16; item += G) {
                    const int rt = item >> 4, ct = item & 15;
                    const int m0 = rt * 64; const bool lat = m0 < NLAT;
                    const int bsel = lat ? (m0 >> 11) : ((m0 - NLAT) >> 8); const int t0 = lat ? (m0 & 2047) : ((m0 - NLAT) & 255); const int seglen = lat ? 2048 : 256;
                    {
                        const int cc = tid >> 3, tq = tid & 7;
                        const bf16_t* s = YT + (lat ? (size_t)0 : (size_t)1024 * 8 * 2048) + ((size_t)(ct * 64 + cc) * 8 + bsel) * seglen + t0 + 8 * tq;
                        *(LAS u32x4*)(TT + cc * 72 + 8 * tq) = *(const u32x4*)s;
                    }
                    __syncthreads();
                    {
                        const int r = tid >> 3, cg = tid & 7; const int m = m0 + r, c0 = ct * 64 + cg * 8;
                        const u32x4 zw = *(const u32x4*)(Z + (size_t)m * 1024 + c0);
                        float yv[8];
#pragma unroll
                        for (int j = 0; j < 8; ++j) yv[j] = bf2f(TT[(8 * cg + j) * 72 + r]);
                        u32x4 o; o.x = pk2(yv[0] * bflo(zw.x), yv[1] * bfhi(zw.x)); o.y = pk2(yv[2] * bflo(zw.y), yv[3] * bfhi(zw.y));
                        o.z = pk2(yv[4] * bflo(zw.z), yv[5] * bfhi(zw.z)); o.w = pk2(yv[6] * bflo(zw.w), yv[7] * bfhi(zw.w));
                        *(u32x4*)(U2 + (size_t)m * 1024 + c0) = o;
                    }
                    __syncthreads();
                }
            }

            for (int jb = 0; EN_GR && jb < nroute; ++jb) {
                pg8::Gemm g; pg8::EpiRoute E;
                if (even && step == 1) {
                    g = pg8::Gemm{(const bf16_t*)(BIG + EV_E), WIN, MTOT, 3328, 1024};
                    E.base[0] = (bf16_t*)(BIG + EV_A); E.ld[0] = 1792; E.base[1] = (bf16_t*)(BIG + EV_B); E.ld[1] = 1024; E.base[2] = (bf16_t*)(BIG + EV_F); E.ld[2] = 512;
                    E.base[3] = E.base[2]; E.ld[3] = 512; E.t0 = 7; E.t1 = 11; E.t2 = 64;
                } else if (even && jb == 0) {
                    g = pg8::Gemm{(const bf16_t*)(BIG + EV_E), WUQ, MTOT, 768, 256};
                    E.base[0] = (bf16_t*)(BIG + EV_C); E.ld[0] = 768; E.base[1] = E.base[0]; E.ld[1] = 768; E.base[2] = E.base[0]; E.ld[2] = 768; E.base[3] = E.base[0]; E.ld[3] = 768;
                    E.t0 = 64; E.t1 = 64; E.t2 = 64;
                } else if (even) {
                    g = pg8::Gemm{(const bf16_t*)(BIG + EV_E + UU / 4), WUKV, MTOT, 1024, 256};
                    E.base[0] = (bf16_t*)(BIG + EV_E + UU / 2); E.ld[0] = 512; E.base[1] = (bf16_t*)(BIG + EV_D); E.ld[1] = 512; E.base[2] = E.base[1]; E.ld[2] = 512; E.base[3] = E.base[1]; E.ld[3] = 512;
                    E.t0 = 2; E.t1 = 64; E.t2 = 64;
                } else {
                    g = pg8::Gemm{(const bf16_t*)(BIG + OD_HV), WIN, Mrows, 4096, 1024};
                    E.base[0] = (bf16_t*)(BIG + OD_P); E.base[1] = (bf16_t*)(BIG + OD_P + UU); E.base[2] = (bf16_t*)(BIG + OD_P + 2 * UU); E.base[3] = (bf16_t*)(BIG + OD_P + 3 * UU);
                    E.ld[0] = E.ld[1] = E.ld[2] = E.ld[3] = 1024; E.t0 = 4; E.t1 = 8; E.t2 = 12;
                }
                pg8::StaticOrder S; S.init(g.M, g.N, G, bid);
                pg8::gemm_phase<pg8::EpiRoute, pg8::StaticOrder, true, true>(lds, g, S, E, tid);
            }
            if (EN_GS && resid) {
                pg8::Gemm g{(const bf16_t*)(BIG + (even ? EV_D : OD_P)), WOUT, Mout, 1024, 1024};
                pg8::EpiResid E{xsrc, a.out, xcsrc, XC, mods};
                pg8::StaticOrder S; S.init(g.M, g.N, G, bid);
                pg8::gemm_phase<pg8::EpiResid, pg8::StaticOrder, true, true>(lds, g, S, E, tid);
            }
            grid.sync();
        }
    }
}

extern "C" void kernel_launch(void* const* d_in, const int* in_sizes, int n_in, void* d_out, int out_size,
                              void* d_ws, size_t ws_size, hipStream_t stream) {
    static int grid_blocks = 0;
    if (!grid_blocks) {
        int dev = 0, cus = 0, per_cu = 0;
        (void)hipGetDevice(&dev);
        (void)hipDeviceGetAttribute(&cus, hipDeviceAttributeMultiprocessorCount, dev);
        (void)hipFuncSetAttribute((const void*)mega_fwd, hipFuncAttributeMaxDynamicSharedMemorySize, LDS_BYTES);
        (void)hipOccupancyMaxActiveBlocksPerMultiprocessor(&per_cu, (const void*)mega_fwd, NTHREADS, LDS_BYTES);
        if (per_cu < 1) per_cu = 1;
        if (per_cu > 1) per_cu = 1;
        grid_blocks = cus * per_cu;
        if (n_in != 37 || ws_size < 268435456) fprintf(stderr, "kernel_launch: unexpected n_in %d / ws %zu\n", n_in, ws_size);
    }
    Args a{};
    for (int i = 0; i < 37 && i < n_in; ++i) a.in[i] = (const float*)d_in[i];
    a.out = (float*)d_out; a.ws = (unsigned char*)d_ws;
    void* args[] = {&a};
    hipError_t e = hipLaunchCooperativeKernel((const void*)mega_fwd, dim3(grid_blocks), dim3(NTHREADS), args, LDS_BYTES, stream);
    if (e != hipSuccess) fprintf(stderr, "cooperative launch failed: %s (grid %d)\n", hipGetErrorString(e), grid_blocks);
}
```

```cpp
#include <hip/hip_runtime.h>
#include <hip/hip_cooperative_groups.h>
#include <cstdio>
#include <cstdint>
namespace cg = cooperative_groups;

#define LAS __attribute__((address_space(3)))
#define GAS __attribute__((address_space(1)))
typedef unsigned short bf16_t;
typedef short bf16x8 __attribute__((ext_vector_type(8)));
typedef float f32x4 __attribute__((ext_vector_type(4)));
typedef unsigned u32x4 __attribute__((ext_vector_type(4)));
typedef unsigned u32x2 __attribute__((ext_vector_type(2)));
typedef float f32x2 __attribute__((ext_vector_type(2)));

#ifndef EN_P0
#define EN_P0 1
#endif
#ifndef EN_NORM
#define EN_NORM 1
#endif
#ifndef EN_E2
#define EN_E2 1
#endif
#ifndef EN_E4
#define EN_E4 1
#endif
#ifndef EN_E5
#define EN_E5 1
#endif
#ifndef EN_SCAN
#define EN_SCAN 1
#endif
#ifndef EN_ATTN
#define EN_ATTN 1
#endif
#ifndef EN_E6
#define EN_E6 1
#endif
#ifndef EN_O2
#define EN_O2 1
#endif
#ifndef EN_O3
#define EN_O3 1
#endif
#ifndef EN_GR
#define EN_GR 1
#endif
#ifndef EN_GS
#define EN_GS 1
#endif
constexpr int NB = 8, SEQ = 2048, DM = 1024, CTXL = 256;
constexpr int NLAT = NB * SEQ;
constexpr int NCTX = NB * CTXL;
constexpr int MTOT = NLAT + NCTX;
constexpr int NTHREADS = 512, NWAVES = 8;
constexpr int LDS_BYTES = 147456;
constexpr float NORM_EPS = 1e-6f;
constexpr int NPHASES = 25;

constexpr size_t UU = (size_t)MTOT * 1024 * 2;
constexpr size_t MiB = 1u << 20;
constexpr size_t OFF_MODS = 0;
constexpr size_t OFF_BONUS = MiB / 2;
constexpr size_t OFF_HDN = 2 * MiB;
constexpr size_t OFF_BAR = 3 * MiB + MiB / 4;
constexpr size_t OFF_PSTAMP = OFF_BAR + 65536;
constexpr size_t OFF_WTS = 3 * MiB + MiB / 2;
constexpr size_t OFF_XC = 14 * MiB + MiB / 2;
constexpr size_t OFF_BIG = 22 * MiB + MiB / 2;
constexpr size_t EV_A = 0;
constexpr size_t EV_B = EV_A + UU * 7 / 4;
constexpr size_t EV_C = EV_B + UU;
constexpr size_t EV_D = EV_C + UU * 3 / 4;
constexpr size_t EV_F = EV_D + UU / 2;
constexpr size_t EV_E = EV_F + UU / 2;
constexpr size_t EV_G = EV_E + UU;
constexpr size_t EV_END = EV_G + UU * 3 / 4;
constexpr size_t OD_P = 0;
constexpr size_t OD_HV = 4 * UU;
constexpr size_t OD_GRC = 5 * UU;
constexpr size_t OD_END = OD_GRC + (size_t)1024 * 528 * 2;
constexpr size_t OD_H2 = UU * 21 / 4;
constexpr size_t OFF_BIAS = MiB + 3 * MiB / 4;
static_assert(OFF_BONUS + (size_t)MTOT * 16 * 4 <= OFF_BIAS && OFF_BIAS + (size_t)9 * 4096 * 4 <= OFF_HDN, "small regions");
constexpr size_t OFF_GR = OFF_BIG + EV_END;
static_assert(OFF_GR + (size_t)1024 * 4112 * 2 <= 268435456 && OFF_BIG + OD_END <= OFF_GR, "ws map");
constexpr size_t W_IN = 0;
constexpr size_t W_OUT = (size_t)4096 * 1024 * 2;
constexpr size_t W_UQ = W_OUT + (size_t)1024 * 1024 * 2;
constexpr size_t W_UKV = W_UQ + (size_t)768 * 256 * 2;
static_assert(W_UKV + (size_t)1024 * 256 * 2 <= 11 * MiB, "weights region");

#ifdef OLD_CVT
__device__ __forceinline__ unsigned f2bf(float f) { unsigned u = __builtin_bit_cast(unsigned, f); return (u + 0x7fffu + ((u >> 16) & 1u)) >> 16; }
__device__ __forceinline__ unsigned pk2(float lo, float hi) { return f2bf(lo) | (f2bf(hi) << 16); }
#else
typedef __bf16 hwbf16x2 __attribute__((ext_vector_type(2)));
__device__ __forceinline__ unsigned pk2(float lo, float hi) { const f32x2 v = {lo, hi}; return __builtin_bit_cast(unsigned, __builtin_convertvector(v, hwbf16x2)); }
__device__ __forceinline__ unsigned f2bf(float f) { return pk2(f, 0.f) & 0xffffu; }
#endif
__device__ __forceinline__ float bf2f(unsigned h) { return __builtin_bit_cast(float, (h & 0xffffu) << 16); }
__device__ __forceinline__ float bflo(unsigned w) { return __builtin_bit_cast(float, w << 16); }
__device__ __forceinline__ float bfhi(unsigned w) { return __builtin_bit_cast(float, w & 0xffff0000u); }
__device__ __forceinline__ float shx(float v, int m, int lane) { return __builtin_bit_cast(float, __builtin_amdgcn_ds_bpermute((lane ^ m) << 2, __builtin_bit_cast(int, v))); }
__device__ __forceinline__ float bcast(float v, int src) { return __builtin_bit_cast(float, __builtin_amdgcn_readlane(__builtin_bit_cast(int, v), src)); }
__device__ __forceinline__ float wave_sum(float v, int lane) {
#pragma unroll
    for (int o = 1; o < 64; o <<= 1) v += shx(v, o, lane);
    return v;
}
__device__ __forceinline__ float sum8(float v, int lane) { v += shx(v, 1, lane); v += shx(v, 2, lane); v += shx(v, 4, lane); return v; }
__device__ __forceinline__ float silu_f(float x) { return x / (1.0f + __expf(-x)); }
template <int CTRL> __device__ __forceinline__ float dpp_f(float v) { return __builtin_bit_cast(float, __builtin_amdgcn_update_dpp(0, __builtin_bit_cast(int, v), CTRL, 0xF, 0xF, true)); }
__device__ __forceinline__ float red16(float x) { x += dpp_f<0xB1>(x); x += dpp_f<0x4E>(x); x += dpp_f<0x141>(x); x += dpp_f<0x140>(x); return x; }
__device__ __forceinline__ float red64(float x) { x = red16(x);
    const float s0 = bcast(x, 0), s1 = bcast(x, 16), s2 = bcast(x, 32), s3 = bcast(x, 48); return (s0 + s1) + (s2 + s3); }

__device__ __forceinline__ float sigmoid_f(float x) { return 1.0f / (1.0f + __expf(-x)); }

namespace pg8 {
constexpr int BM = 256, BK = 64, HALF = 128, HTB = HALF * BK * 2, STAGE_BYTES = 8 * HTB, NXCD = 8, WGM = 8;
__host__ __device__ __forceinline__ int lds_byte(int r, int c) { const int st = (r >> 4) * 2 + (c >> 5), rr = r & 15, cc = c & 31, ob = rr * 64 + cc * 2; return st * 1024 + (ob ^ (((ob >> 9) & 1) << 5)); }
__host__ __device__ __forceinline__ void stage_rc(int b, int& R, int& C) { const int st = b / 1024, sb = b % 1024, swz = sb ^ (((sb >> 9) & 1) << 5); R = (st >> 1) * 16 + swz / 64; C = (st & 1) * 32 + (swz % 64) / 2; }
__host__ __device__ __forceinline__ int perm32(int rho) { const int n = rho >> 4, i = rho & 15; return 8 * (i >> 2) + 4 * n + (i & 3); }
struct Unit { int pm, pn; };
struct Gemm { const bf16_t* A; const bf16_t* Bt; int M, N, K, lda; };
struct StaticOrder {
    int nM, nN, nwg, G, c;
    __host__ __device__ void init(int M, int N, int G_, int c_) { nM = M / BM; nN = N / BM; nwg = nM * nN; G = G_; c = c_; }
    __host__ __device__ bool next(int i, Unit& u) const {
        const long L = (long)i * G + c; if (L >= nwg) return false;
        int wgid = (int)L; { const int q = nwg / NXCD, r = nwg % NXCD, xcd = wgid % NXCD, off = wgid / NXCD; wgid = (xcd < r ? xcd * (q + 1) : r * (q + 1) + (xcd - r) * q) + off; }
        const int nig = WGM * nN, gid = wgid / nig, fm = gid * WGM, gsz = (nM - fm) < WGM ? (nM - fm) : WGM;
        u.pm = fm + ((wgid % nig) % gsz); u.pn = (wgid % nig) / gsz; return true;
    }
    __device__ __forceinline__ void a_ready(const Unit&) const {}
    __device__ __forceinline__ void done(const Unit&) const {}
};

struct EpiRoute {
    static constexpr bool PERM = true, AFTER_DRAIN = false;
    bf16_t* base[4]; int ld[4]; int t0, t1, t2;
    int remap96;
    const float* ssq; const float* bias;
    __device__ __forceinline__ void operator()(const f32x4 (&acc)[2][2][4][2], const Unit& u, int wr, int wc, int fr_, int fq_) const {
        int fr = fr_, fq = fq_; asm volatile("" : "+v"(fr), "+v"(fq));
        const int row0 = u.pm * BM + wr * 64 + fr;
        f32x4 bv[2][2];
#pragma unroll
        for (int bj = 0; bj < 2; ++bj)
#pragma unroll
            for (int n = 0; n < 2; ++n) bv[bj][n] = (f32x4){0.f, 0.f, 0.f, 0.f};
        if (ssq) {
            const int rb = u.pm * BM; const int b = (rb < NLAT) ? (rb >> 11) : 8;
            const float* bp = bias + (size_t)b * 4096 + u.pn * BM + wc * 32 + 8 * fq;
#pragma unroll
            for (int bj = 0; bj < 2; ++bj)
#pragma unroll
                for (int n = 0; n < 2; ++n) bv[bj][n] = *(const f32x4*)(bp + bj * HALF + 4 * n);
        }
        bf16_t* b; int ldc, colt;
        if (u.pn < t0) { b = base[0]; ldc = ld[0]; colt = u.pn * BM; }
        else if (u.pn < t1) { b = base[1]; ldc = ld[1]; colt = (u.pn - t0) * BM; }
        else if (u.pn < t2) { b = base[2]; ldc = ld[2]; colt = (u.pn - t1) * BM; }
        else { b = base[3]; ldc = ld[3]; colt = (u.pn - t2) * BM; }
        const int col0 = colt + wc * 32 + 8 * fq;
#pragma unroll
        for (int ai = 0; ai < 2; ++ai)
#pragma unroll
            for (int m = 0; m < 4; ++m) {
                const int row = row0 + ai * HALF + m * 16;
                {
                    float rs = 1.0f;
                    if (ssq) { const f32x4* sp = (const f32x4*)(ssq + (size_t)row * 16); const f32x4 s4 = (sp[0] + sp[1]) + (sp[2] + sp[3]);
                        rs = 1.0f / sqrtf(((s4.x + s4.y) + (s4.z + s4.w)) * (1.f / DM) + NORM_EPS); }
                    bf16_t* rowp = b + (size_t)row * ldc + col0;
#pragma unroll
                    for (int bj = 0; bj < 2; ++bj) {
                        const f32x4 v0 = acc[ai][bj][m][0] * rs + bv[bj][0], v1 = acc[ai][bj][m][1] * rs + bv[bj][1];
                        u32x4 w; w.x = pk2(v0[0], v0[1]); w.y = pk2(v0[2], v0[3]); w.z = pk2(v1[0], v1[1]); w.w = pk2(v1[2], v1[3]);
                        int coff = bj * HALF;
                        if (remap96 && u.pn < t0) { const int n = col0 + bj * HALF; coff = (n >> 6) * 96 + (n & 63) - col0; }
                        *(u32x4*)(rowp + coff) = w;
                    }
                }
            }
    }
};
struct EpiResid {
    static constexpr bool PERM = true, AFTER_DRAIN = false;
    const float* xsrc; float* xdst; const float* xcsrc; float* xcdst; const float* mods;
    int rowoff;
    bf16_t* hn; const float* gn; const float* modsn; float* ssq;
    __device__ __forceinline__ void operator()(const f32x4 (&acc)[2][2][4][2], const Unit& u, int wr, int wc, int fr_, int fq_) const {
        int fr = fr_, fq = fq_; asm volatile("" : "+v"(fr), "+v"(fq));
        const int rbase = rowoff + u.pm * BM;
        const bool lat = rbase < NLAT; const int b = lat ? (rbase >> 11) : 8;
        const int col0 = u.pn * BM + wc * 32 + 8 * fq, lane = fr + 16 * fq;
        const float* gt = mods + b * 3072 + 2048 + col0;
        const float* src0 = (lat ? xsrc + (size_t)rbase * DM : xcsrc + (size_t)(rbase - NLAT) * DM) + col0;
        float* dst0 = (lat ? xdst + (size_t)rbase * DM : xcdst + (size_t)(rbase - NLAT) * DM) + col0;
        f32x4 gsn[2][2];
#pragma unroll
        for (int bj = 0; bj < 2; ++bj)
#pragma unroll
            for (int n = 0; n < 2; ++n) {
                gsn[bj][n] = (f32x4){0.f, 0.f, 0.f, 0.f};
                if (hn) { const f32x4 g4 = *(const f32x4*)(gn + col0 + bj * HALF + 4 * n), s4 = *(const f32x4*)(modsn + b * 3072 + 1024 + col0 + bj * HALF + 4 * n); gsn[bj][n] = g4 * (s4 + 1.0f); }
            }
#pragma unroll
        for (int ai = 0; ai < 2; ++ai)
#pragma unroll
            for (int m = 0; m < 4; ++m) {
                const int rl = wr * 64 + fr + ai * HALF + m * 16;
                const float* src = src0 + (size_t)rl * DM; float* dst = dst0 + (size_t)rl * DM;
                float ss = 0.f;
#pragma unroll
                for (int bj = 0; bj < 2; ++bj) {
                    const f32x4 x0 = *(const f32x4*)(src + bj * HALF), x1 = *(const f32x4*)(src + bj * HALF + 4);
                    const f32x4 g0 = *(const f32x4*)(gt + bj * HALF), g1 = *(const f32x4*)(gt + bj * HALF + 4);
                    const f32x4 y0 = x0 + g0 * acc[ai][bj][m][0], y1 = x1 + g1 * acc[ai][bj][m][1];
                    *(f32x4*)(dst + bj * HALF) = y0; *(f32x4*)(dst + bj * HALF + 4) = y1;
                    if (hn) {
                        ss += ((y0.x * y0.x + y0.y * y0.y) + (y0.z * y0.z + y0.w * y0.w)) + ((y1.x * y1.x + y1.y * y1.y) + (y1.z * y1.z + y1.w * y1.w));
                        const f32x4 h0 = y0 * gsn[bj][0], h1 = y1 * gsn[bj][1];
                        u32x4 w; w.x = pk2(h0.x, h0.y); w.y = pk2(h0.z, h0.w); w.z = pk2(h1.x, h1.y); w.w = pk2(h1.z, h1.w);
                        *(u32x4*)(hn + (size_t)(rbase + rl) * DM + col0 + bj * HALF) = w;
                    }
                }
                if (hn) { ss += shx(ss, 16, lane); ss += shx(ss, 32, lane); if (fq == 0) ssq[(size_t)(rbase + rl) * 16 + u.pn * 4 + wc] = ss; }
            }
    }
};

template <class Epi, class Sched, bool ALIGN_EPI = false, bool SP2 = false>
__device__ __forceinline__ void gemm_phase(LAS unsigned char* lds, const Gemm g, const Sched& S, const Epi& E, const int tid) {
    const int wid = __builtin_amdgcn_readfirstlane(tid >> 6), lane = tid & 63, wr = wid >> 2, wc = wid & 3, fr = lane & 15, fq = lane >> 4;
    const int K = g.K, nt = K / BK;
    unsigned voffA[2], voffB[2];
#pragma unroll
    for (int i = 0; i < 2; ++i) { int R, C; stage_rc(tid * 16 + i * 8192, R, C); const int Rb = Epi::PERM ? ((R & ~31) + perm32(R & 31)) : R;
        voffA[i] = (unsigned)(R * g.lda + C) * 2u; voffB[i] = (unsigned)(Rb * K + C) * 2u; }
    const size_t kstep = (size_t)(BK * 2);
    const size_t hstepB = (size_t)HALF * K * 2, hstepA = (size_t)HALF * g.lda * 2;
    const size_t tstepB = 2 * hstepB, tstepA = 2 * hstepA;
    const unsigned ldsw = (unsigned)wid * 1024u;
    const int aoff = lds_byte(wr * 64 + fr, fq * 8), boff = lds_byte(wc * 32 + fr, fq * 8);
#define PG8_SA(b, h) (((b) * 2 + (h)) * HTB)
#define PG8_SB(b, h) ((4 + (b) * 2 + (h)) * HTB)
#define PG8_STAGE(bufoff, gbase, voff) do { _Pragma("unroll") for (int _i = 0; _i < 2; ++_i) \
        __builtin_amdgcn_global_load_lds((const unsigned*)((const char*)(gbase) + (voff)[_i]), (LAS unsigned*)(lds + (bufoff) + ldsw + _i * 8192), 16, 0, 0); } while (0)
#define PG8_LDA(dst, b, h) do { _Pragma("unroll") for (int m = 0; m < 4; ++m) _Pragma("unroll") for (int k = 0; k < 2; ++k) dst[m][k] = *(const LAS bf16x8*)(lds + PG8_SA(b, h) + aoff + m * 2048 + k * 1024); } while (0)
#define PG8_LDB(dst, b, h) do { _Pragma("unroll") for (int n = 0; n < 2; ++n) _Pragma("unroll") for (int k = 0; k < 2; ++k) dst[n][k] = *(const LAS bf16x8*)(lds + PG8_SB(b, h) + boff + n * 2048 + k * 1024); } while (0)
#define PG8_MMA(ai, bj, At, Bt) do { __builtin_amdgcn_s_setprio(1); _Pragma("unroll") for (int m = 0; m < 4; ++m) _Pragma("unroll") for (int n = 0; n < 2; ++n) _Pragma("unroll") for (int k = 0; k < 2; ++k) \
        acc[ai][bj][m][n] = __builtin_amdgcn_mfma_f32_16x16x32_bf16(Bt[n][k], At[m][k], acc[ai][bj][m][n], 0, 0, 0); __builtin_amdgcn_s_setprio(0); } while (0)
#define PG8_WAIT_V(n) asm volatile("s_waitcnt vmcnt(" #n ")" ::: "memory")
#define PG8_WAIT_L(n) asm volatile("s_waitcnt lgkmcnt(" #n ")" ::: "memory")
#define PG8_BAR __builtin_amdgcn_s_barrier()
#define PG8_SCHED __builtin_amdgcn_sched_barrier(0)
    Unit cur, nxt; int ui = 0;
    if (!S.next(0, cur)) return;
    f32x4 acc[2][2][4][2];
#pragma unroll
    for (int a = 0; a < 2; ++a)
#pragma unroll
        for (int b = 0; b < 2; ++b)
#pragma unroll
            for (int m = 0; m < 4; ++m)
#pragma unroll
                for (int n = 0; n < 2; ++n) acc[a][b][m][n] = (f32x4){0.f, 0.f, 0.f, 0.f};
    bf16x8 At[4][2], B0[2][2], B1[2][2];
    const char* cA = (const char*)g.A + (size_t)cur.pm * tstepA; const char* cB = (const char*)g.Bt + (size_t)cur.pn * tstepB;
    S.a_ready(cur);
    if constexpr (SP2) {
        PG8_STAGE(PG8_SB(0, 0), cB, voffB); PG8_STAGE(PG8_SB(0, 1), cB + hstepB, voffB); PG8_STAGE(PG8_SA(0, 0), cA, voffA); PG8_STAGE(PG8_SA(0, 1), cA + hstepA, voffA);
        if (wr == 1) PG8_BAR;
        PG8_WAIT_V(2); PG8_BAR;
        PG8_STAGE(PG8_SB(1, 0), cB + kstep, voffB); PG8_STAGE(PG8_SA(1, 0), cA + kstep, voffA); PG8_STAGE(PG8_SB(1, 1), cB + hstepB + kstep, voffB);
        PG8_WAIT_V(6); PG8_BAR;
    } else {
        PG8_STAGE(PG8_SB(0, 0), cB, voffB); PG8_STAGE(PG8_SA(0, 0), cA, voffA); PG8_STAGE(PG8_SB(0, 1), cB + hstepB, voffB); PG8_STAGE(PG8_SA(0, 1), cA + hstepA, voffA);
        if (wr == 1) PG8_BAR;
        PG8_WAIT_V(4); PG8_BAR;
        PG8_STAGE(PG8_SB(1, 0), cB + kstep, voffB); PG8_STAGE(PG8_SA(1, 0), cA + kstep, voffA); PG8_STAGE(PG8_SB(1, 1), cB + hstepB + kstep, voffB);
        PG8_WAIT_V(6); PG8_BAR;
    }
    for (;;) {
        const bool has_next = S.next(ui + 1, nxt);
        const char* nA = has_next ? (const char*)g.A + (size_t)nxt.pm * tstepA : cA; const char* nB = has_next ? (const char*)g.Bt + (size_t)nxt.pn * tstepB : cB;
        for (int t = 0; t < nt; t += 2) {
            const bool last = (t == nt - 2);
            const char* a1 = cA + (size_t)(t + 1) * kstep;
            const char* a2 = last ? nA : cA + (size_t)(t + 2) * kstep; const char* b2 = last ? nB : cB + (size_t)(t + 2) * kstep;
            const char* a3 = a2 + kstep; const char* b3 = b2 + kstep;
            if (last && has_next) S.a_ready(nxt);
            if constexpr (SP2) {
            PG8_LDB(B0, 0, 0); PG8_LDB(B1, 0, 1); PG8_SCHED; PG8_LDA(At, 0, 0); PG8_STAGE(PG8_SA(1, 1), a1 + hstepA, voffA);
            PG8_WAIT_V(8); PG8_WAIT_L(0); PG8_BAR; PG8_MMA(0, 0, At, B0); PG8_MMA(0, 1, At, B1); PG8_BAR; PG8_SCHED;
            PG8_LDA(At, 0, 1); PG8_STAGE(PG8_SB(0, 0), b2, voffB); PG8_STAGE(PG8_SB(0, 1), b2 + hstepB, voffB); PG8_STAGE(PG8_SA(0, 0), a2, voffA);
            PG8_WAIT_V(8); PG8_WAIT_L(0); PG8_BAR; PG8_MMA(1, 0, At, B0); PG8_MMA(1, 1, At, B1); PG8_BAR; PG8_SCHED;
            PG8_LDB(B0, 1, 0); PG8_LDB(B1, 1, 1); PG8_SCHED; PG8_LDA(At, 1, 0); PG8_STAGE(PG8_SA(0, 1), a2 + hstepA, voffA);
            PG8_WAIT_V(8); PG8_WAIT_L(0); PG8_BAR; PG8_MMA(0, 0, At, B0); PG8_MMA(0, 1, At, B1); PG8_BAR; PG8_SCHED;
            PG8_LDA(At, 1, 1); PG8_STAGE(PG8_SB(1, 0), b3, voffB); PG8_STAGE(PG8_SB(1, 1), b3 + hstepB, voffB); PG8_STAGE(PG8_SA(1, 0), a3, voffA);
            PG8_WAIT_V(8); PG8_WAIT_L(0); PG8_BAR; PG8_MMA(1, 0, At, B0); PG8_MMA(1, 1, At, B1); PG8_BAR; PG8_SCHED;
            } else {
            PG8_LDB(B0, 0, 0); PG8_SCHED; PG8_LDA(At, 0, 0); PG8_STAGE(PG8_SA(1, 1), a1 + hstepA, voffA);
            PG8_WAIT_L(8); PG8_BAR; PG8_WAIT_L(0); PG8_MMA(0, 0, At, B0); PG8_BAR; PG8_SCHED;
            PG8_LDB(B1, 0, 1); PG8_STAGE(PG8_SB(0, 0), b2, voffB);
            PG8_BAR; PG8_WAIT_L(0); PG8_MMA(0, 1, At, B1); PG8_BAR;
            PG8_LDA(At, 0, 1); PG8_STAGE(PG8_SA(0, 0), a2, voffA);
            PG8_BAR; PG8_WAIT_L(0); PG8_MMA(1, 0, At, B0); PG8_BAR; PG8_SCHED;
            PG8_STAGE(PG8_SB(0, 1), b2 + hstepB, voffB);
            PG8_WAIT_V(6); PG8_BAR; PG8_MMA(1, 1, At, B1); PG8_BAR;
            PG8_LDB(B0, 1, 0); PG8_SCHED; PG8_LDA(At, 1, 0); PG8_STAGE(PG8_SA(0, 1), a2 + hstepA, voffA);
            PG8_WAIT_L(8); PG8_BAR; PG8_WAIT_L(0); PG8_MMA(0, 0, At, B0); PG8_BAR; PG8_SCHED;
            PG8_LDB(B1, 1, 1); PG8_STAGE(PG8_SB(1, 0), b3, voffB);
            PG8_BAR; PG8_WAIT_L(0); PG8_MMA(0, 1, At, B1); PG8_BAR;
            PG8_LDA(At, 1, 1); PG8_STAGE(PG8_SA(1, 0), a3, voffA);
            PG8_BAR; PG8_WAIT_L(0); PG8_MMA(1, 0, At, B0); PG8_BAR; PG8_SCHED;
            PG8_STAGE(PG8_SB(1, 1), b3 + hstepB, voffB);
            PG8_WAIT_V(6); PG8_BAR; PG8_MMA(1, 1, At, B1); PG8_BAR;
            }
        }
        if constexpr (ALIGN_EPI) { if (wr == 0) PG8_BAR; }
        if constexpr (!Epi::AFTER_DRAIN) { E(acc, cur, wr, wc, fr, fq); S.done(cur); }
        if (!has_next) break;
#pragma unroll
        for (int a = 0; a < 2; ++a)
#pragma unroll
            for (int b = 0; b < 2; ++b)
#pragma unroll
                for (int m = 0; m < 4; ++m)
#pragma unroll
                    for (int n = 0; n < 2; ++n) acc[a][b][m][n] = (f32x4){0.f, 0.f, 0.f, 0.f};
        cur = nxt; cA = nA; cB = nB; ++ui;
        if constexpr (ALIGN_EPI) { if (wr == 1) PG8_BAR; }
    }
    PG8_WAIT_V(0);
    if constexpr (!ALIGN_EPI) { if (wr == 0) PG8_BAR; }
    PG8_BAR;
#undef PG8_SA
#undef PG8_SB
#undef PG8_STAGE
#undef PG8_LDA
#undef PG8_LDB
#undef PG8_MMA
#undef PG8_WAIT_V
#undef PG8_WAIT_L
#undef PG8_BAR
#undef PG8_SCHED
}
}


namespace att {
using f32x16 = __attribute__((ext_vector_type(16))) float;
using s16x4 = __attribute__((ext_vector_type(4))) short;
constexpr int NW = 8, QBLK = 32, KVBLK = 64, LDQ = 768, LDK = 768, LDV = 512;
constexpr float SCALE = 0.10206207261596575f;
constexpr float THR = 8.f;
constexpr int SHM_V = 16384, SHM_K = 16384, SHM_ATTN = 2 * SHM_V + 2 * SHM_K + NW * 64 * 4;
#define KSWZ(row, colB) ((row) * 256 + ((colB) ^ (((row) & 7) << 4)))
#define SBAR() __builtin_amdgcn_sched_barrier(0)
__device__ __forceinline__ int crow(int r, int hi) { return (r & 3) + 8 * (r >> 2) + 4 * hi; }
__device__ __forceinline__ unsigned cvtpk(float lo, float hi) { unsigned r; asm volatile("v_cvt_pk_bf16_f32 %0, %1, %2" : "=v"(r) : "v"(lo), "v"(hi)); return r; }
__device__ __forceinline__ void partialSM(f32x16& p0, f32x16& p1, float& m_reg, float& mn, float& alpha) {
  constexpr float C = SCALE * 1.4426950408889634f;
  float pmax = p0[0];
#pragma unroll
  for (int r = 1; r < 16; ++r) pmax = fmaxf(pmax, p0[r]);
#pragma unroll
  for (int r = 0; r < 16; ++r) pmax = fmaxf(pmax, p1[r]);
  { auto rr = __builtin_amdgcn_permlane32_swap(__float_as_uint(pmax), __float_as_uint(pmax), false, false);
    pmax = fmaxf(__uint_as_float(rr[0]), __uint_as_float(rr[1])); }
  if (__builtin_expect(__all(pmax - m_reg <= THR / SCALE), 1)) { mn = m_reg; alpha = 1.f; }
  else { mn = fmaxf(m_reg, pmax); alpha = __builtin_amdgcn_exp2f((m_reg - mn) * C); m_reg = mn; }
  float mnC = -mn * C;
#pragma unroll
  for (int r = 0; r < 16; ++r) p0[r] = fmaf(p0[r], C, mnC);
#pragma unroll
  for (int r = 0; r < 16; ++r) p1[r] = fmaf(p1[r], C, mnC);
#pragma unroll
  for (int r = 0; r < 16; ++r) p0[r] = __builtin_amdgcn_exp2f(p0[r]);
}
__device__ __forceinline__ void finishSM(f32x16& p0, f32x16& p1, float alpha, float& l_reg, bf16x8& pa0, bf16x8& pa1, bf16x8& pa2, bf16x8& pa3) {
#pragma unroll
  for (int r = 0; r < 16; ++r) p1[r] = __builtin_amdgcn_exp2f(p1[r]);
  float ps = 0;
#pragma unroll
  for (int r = 0; r < 16; ++r) ps += p0[r];
#pragma unroll
  for (int r = 0; r < 16; ++r) ps += p1[r];
  { auto rr = __builtin_amdgcn_permlane32_swap(__float_as_uint(ps), __float_as_uint(ps), false, false);
    ps = __uint_as_float(rr[0]) + __uint_as_float(rr[1]); }
  l_reg = l_reg * alpha + ps;
#define PK4(P, BASE, OUT) do { unsigned a0 = cvtpk(P[BASE + 0], P[BASE + 1]), a1 = cvtpk(P[BASE + 2], P[BASE + 3]);   \
    unsigned b0 = cvtpk(P[BASE + 4], P[BASE + 5]), b1 = cvtpk(P[BASE + 6], P[BASE + 7]);                              \
    auto r0 = __builtin_amdgcn_permlane32_swap(a0, b0, false, false); auto r1 = __builtin_amdgcn_permlane32_swap(a1, b1, false, false); \
    u32x4 w = {r0[0], r1[0], r0[1], r1[1]}; OUT = __builtin_bit_cast(bf16x8, w); } while (0)
  PK4(p0, 0, pa0); PK4(p0, 8, pa1); PK4(p1, 0, pa2); PK4(p1, 8, pa3);
#undef PK4
}
__device__ __forceinline__ void qkt(f32x16& p0, f32x16& p1, const LAS char* Ks, const bf16x8* qr, int r32, int hi) {
  p0 = f32x16{}; p1 = f32x16{};
#pragma unroll
  for (int d0 = 0; d0 < 6; ++d0) { const int cb = (d0 * 16 + hi * 8) * 2;
    const bf16x8 b0 = *(const LAS bf16x8*)(Ks + KSWZ(r32, cb));
    const bf16x8 b1 = *(const LAS bf16x8*)(Ks + KSWZ(32 + r32, cb));
    p0 = __builtin_amdgcn_mfma_f32_32x32x16_bf16(b0, qr[d0], p0, 0, 0, 0);
    p1 = __builtin_amdgcn_mfma_f32_32x32x16_bf16(b1, qr[d0], p1, 0, 0, 0); }
}
__device__ __forceinline__ int v_st(int k, int c) { const int kk = (k & ~0xC) | ((k & 4) << 1) | ((k & 8) >> 1); return ((kk >> 3) * 4 + (c >> 5)) * 512 + ((kk & 7) * 32 + (c & 31)) * 2; }
__device__ __forceinline__ int v_rd_base(int lane) { return ((lane & 3) << 3) | (((lane >> 2) & 3) << 6) | (((lane >> 4) & 1) << 5) | (((lane >> 5) & 1) << 8); }
constexpr int v_rd_off(int d0, int ks, int half) { return d0 * 512 + ks * 4096 + half * 2048; }
template <int OFF> __device__ __forceinline__ s16x4 tr_read(int vb) {
  s16x4 r; asm volatile("ds_read_b64_tr_b16 %0, %1 offset:%2" : "=&v"(r) : "v"(vb), "i"(OFF) : "memory"); return r;
}
template <int D0> __device__ __forceinline__ void pv_one(f32x16& od, int vb, bf16x8 pa0, bf16x8 pa1, bf16x8 pa2, bf16x8 pa3) {
  const s16x4 l0 = tr_read<v_rd_off(D0, 0, 0)>(vb), h0 = tr_read<v_rd_off(D0, 0, 1)>(vb), l1 = tr_read<v_rd_off(D0, 1, 0)>(vb), h1 = tr_read<v_rd_off(D0, 1, 1)>(vb);
  const s16x4 l2 = tr_read<v_rd_off(D0, 2, 0)>(vb), h2 = tr_read<v_rd_off(D0, 2, 1)>(vb), l3 = tr_read<v_rd_off(D0, 3, 0)>(vb), h3 = tr_read<v_rd_off(D0, 3, 1)>(vb);
  asm volatile("s_waitcnt lgkmcnt(0)" ::: "memory"); SBAR();
#define PK(L, H) (bf16x8){L[0], L[1], L[2], L[3], H[0], H[1], H[2], H[3]}
  od = __builtin_amdgcn_mfma_f32_32x32x16_bf16(pa0, PK(l0, h0), od, 0, 0, 0);
  od = __builtin_amdgcn_mfma_f32_32x32x16_bf16(pa1, PK(l1, h1), od, 0, 0, 0);
  od = __builtin_amdgcn_mfma_f32_32x32x16_bf16(pa2, PK(l2, h2), od, 0, 0, 0);
  od = __builtin_amdgcn_mfma_f32_32x32x16_bf16(pa3, PK(l3, h3), od, 0, 0, 0);
#undef PK
}
__device__ __forceinline__ void pv_d0(f32x16* o, int vb, bf16x8 pa0, bf16x8 pa1, bf16x8 pa2, bf16x8 pa3) {
  pv_one<0>(o[0], vb, pa0, pa1, pa2, pa3); pv_one<1>(o[1], vb, pa0, pa1, pa2, pa3);
}
__device__ __forceinline__ void attn_body(const bf16_t* Qb, const bf16_t* Kh, const bf16_t* Vh, bf16_t* Ob, int rlat, int rctx, int nlat, int NT, LAS char* lds, int tid) {
  const int wid = tid >> 6, lane = tid & 63, r32 = lane & 31, hi = lane >> 5;
  LAS char* V_lds = lds; LAS char* K_lds = lds + 2 * SHM_V;
  LAS float* wsl = (LAS float*)(lds + 2 * SHM_V + 2 * SHM_K) + wid * 64; LAS float* li_l = wsl; LAS float* al_l = wsl + 32;
  float m_reg = -1e30f, l_reg = 0; f32x16 o[2] = {}; bf16x8 qr[6];
  const bf16_t* Qw = Qb + (long)(wid * QBLK + r32) * LDQ + hi * 8;
#pragma unroll
  for (int d0 = 0; d0 < 6; ++d0) qr[d0] = *(const bf16x8*)(Qw + d0 * 16);
  const int cid1 = 512 + (tid & 255);
  const int kr0 = tid / 12, kc0 = (tid % 12) * 8, kr1 = cid1 / 12, kc1 = (cid1 % 12) * 8, vr = tid >> 3, vc = (tid & 7) * 8;
  const int vst0 = v_st(vr, vc), kst0 = KSWZ(kr0, kc0 * 2), kst1 = KSWZ(kr1, kc1 * 2);
  const int vb0 = (int)(unsigned)(unsigned long)V_lds + v_rd_base(lane);
  struct { bf16x8 vs0, ks0, ks1; } sr_[2];
#define TROW(j) ((j) < nlat ? rlat + 64 * (j) : rctx + 64 * ((j) - nlat))
#define SLOAD(i, j) do { const long rb_ = TROW(j); sr_[i].vs0 = *(const bf16x8*)(Vh + (rb_ + vr) * LDV + vc); \
    sr_[i].ks0 = *(const bf16x8*)(Kh + (rb_ + kr0) * LDK + kc0); sr_[i].ks1 = *(const bf16x8*)(Kh + (rb_ + kr1) * LDK + kc1); } while (0)
#define SWRITE(b, i) do { *(LAS bf16x8*)(V_lds + (b) * SHM_V + vst0) = sr_[i].vs0; \
    *(LAS bf16x8*)(K_lds + (b) * SHM_K + kst0) = sr_[i].ks0; *(LAS bf16x8*)(K_lds + (b) * SHM_K + kst1) = sr_[i].ks1; } while (0)
#define SWAIT() asm volatile("s_waitcnt vmcnt(3)" ::: "memory")
#define RESC(a) do { if (__any((a) < 1.f)) { if (hi == 0) al_l[r32] = (a); asm volatile("s_waitcnt lgkmcnt(0)" ::: "memory"); \
    _Pragma("unroll") for (int d = 0; d < 2; ++d) _Pragma("unroll") for (int r = 0; r < 16; ++r) o[d][r] *= al_l[crow(r, hi)]; } } while (0)
  f32x16 pA0, pA1, pB0, pB1; float mnA, mnB, alA, alB; bf16x8 pa0, pa1, pa2, pa3;
  constexpr int SE = 0, SO = 1;
  SLOAD(SE, 0); asm volatile("s_waitcnt vmcnt(0)" ::: "memory"); SWRITE(0, SE); __syncthreads();
  qkt(pA0, pA1, K_lds, qr, r32, hi); partialSM(pA0, pA1, m_reg, mnA, alA);
  SLOAD(SO, 1); if (2 < NT) SLOAD(SE, 2);
  SWAIT(); SWRITE(1, SO); __syncthreads();
  for (int j = 1; j + 1 < NT; j += 2) {
    SBAR(); qkt(pB0, pB1, K_lds + SHM_K, qr, r32, hi);
    finishSM(pA0, pA1, alA, l_reg, pa0, pa1, pa2, pa3); SBAR();
    SLOAD(SO, j + 2); SBAR();
    pv_d0(o, vb0, pa0, pa1, pa2, pa3); partialSM(pB0, pB1, m_reg, mnB, alB);
    __syncthreads(); SWAIT(); SWRITE(0, SE);
    RESC(alB); __syncthreads();
    SBAR(); qkt(pA0, pA1, K_lds, qr, r32, hi);
    finishSM(pB0, pB1, alB, l_reg, pa0, pa1, pa2, pa3); SBAR();
    if (j + 3 < NT) SLOAD(SE, j + 3); SBAR();
    pv_d0(o, vb0 + SHM_V, pa0, pa1, pa2, pa3); partialSM(pA0, pA1, m_reg, mnA, alA);
    __syncthreads(); SWAIT(); SWRITE(1, SO);
    RESC(alA); __syncthreads();
  }
  SBAR(); qkt(pB0, pB1, K_lds + SHM_K, qr, r32, hi);
  finishSM(pA0, pA1, alA, l_reg, pa0, pa1, pa2, pa3); SBAR();
  pv_d0(o, vb0, pa0, pa1, pa2, pa3); partialSM(pB0, pB1, m_reg, mnB, alB);
  __syncthreads(); RESC(alB);
  finishSM(pB0, pB1, alB, l_reg, pa0, pa1, pa2, pa3); SBAR();
  pv_d0(o, vb0 + SHM_V, pa0, pa1, pa2, pa3);
  if (hi == 0) li_l[r32] = l_reg; asm volatile("s_waitcnt lgkmcnt(0)" ::: "memory");
  float rli[16];
#pragma unroll
  for (int r = 0; r < 16; ++r) rli[r] = __builtin_amdgcn_rcpf(li_l[crow(r, hi)]);
  bf16_t* Ow = Ob + (long)(wid * QBLK) * LDQ;
#pragma unroll
  for (int r = 0; r < 16; ++r) { const int orow = crow(r, hi);
#pragma unroll
    for (int d0 = 0; d0 < 2; ++d0) Ow[(long)orow * LDQ + d0 * 32 + r32] = (bf16_t)f2bf(o[d0][r] * rli[r]); }
  __syncthreads();
#undef TROW
#undef SLOAD
#undef SWRITE
#undef SWAIT
#undef RESC
}
}


#define XB_TMO      128
#define XB_XCNT(j)  (256  + 64 * (j))
#define XB_XSUB(j)  (1280 + 64 * (j))
#define XB_XGEN(j)  (2304 + 64 * (j))
#define XB_TOP      3328
#define XB_TOPGEN   3392
#define XCD_BAR_WORDS 3456
#define XB_SPIN_CAP (1u << 22)
__device__ __forceinline__ unsigned xb_ld(unsigned* p)              { return __hip_atomic_load(p, __ATOMIC_RELAXED, __HIP_MEMORY_SCOPE_AGENT); }
__device__ __forceinline__ unsigned xb_add(unsigned* p, unsigned v) { return __hip_atomic_fetch_add(p, v, __ATOMIC_RELAXED, __HIP_MEMORY_SCOPE_AGENT); }
__device__ __forceinline__ unsigned xb_xcc_id() { return (unsigned)__builtin_amdgcn_s_getreg((3 << 11) | 20) & 0xFu; }
#define XB_SPIN(cond, bar) do { unsigned _sp = 0; while (cond) { __builtin_amdgcn_s_sleep(1); \
    if ((++_sp & 255u) == 0u) { if (xb_ld(&(bar)[XB_TMO])) break; if (_sp > XB_SPIN_CAP) { atomicAdd(&(bar)[XB_TMO], 1u); break; } } } } while (0)
struct XcdBarrier { unsigned* bar; unsigned x; volatile LAS unsigned* st; unsigned nmemb; };
__device__ __forceinline__ XcdBarrier xcd_barrier_post(unsigned* bar, volatile LAS unsigned* st, int tid, unsigned nmemb) {
    XcdBarrier b; b.bar = bar; b.x = xb_xcc_id(); b.st = st; b.nmemb = nmemb;
    if (tid == 0) (void)xb_add(&bar[XB_XCNT(b.x)], 1u);
    return b;
}
__device__ __forceinline__ void xcd_barrier_complete(unsigned* bar, unsigned x, unsigned& nloc, unsigned& nx, unsigned G) {
    unsigned sum, cnt, mine, sp = 0u;
    for (;;) {
        sum = 0u; cnt = 0u; mine = 0u;
#pragma unroll
        for (unsigned j = 0; j < 16; ++j) { const unsigned c = xb_ld(&bar[XB_XCNT(j)]); sum += c; cnt += (c > 0u) ? 1u : 0u; mine = (j == x) ? c : mine; }
        if (sum == G) break;
        __builtin_amdgcn_s_sleep(1);
        if ((++sp & 255u) == 0u) { if (xb_ld(&bar[XB_TMO])) break; if (sp > XB_SPIN_CAP) { atomicAdd(&bar[XB_TMO], 1u); break; } }
    }
    nloc = mine > 0u ? mine : 1u; nx = cnt > 0u ? cnt : 1u;
}
__device__ __forceinline__ void xcd_barrier(const XcdBarrier& b, int tid) {
    asm volatile("s_waitcnt vmcnt(0)" ::: "memory");
    __syncthreads();
    if (tid == 0) {
        unsigned* bar = b.bar;
        __builtin_amdgcn_s_waitcnt(0);
        unsigned nloc = b.st[0], nx = b.st[1];
        if (nloc == 0u) { xcd_barrier_complete(bar, b.x, nloc, nx, b.nmemb); b.st[0] = nloc; b.st[1] = nx; }
        const unsigned old = xb_add(&bar[XB_XSUB(b.x)], 1u);
        const unsigned gen = old / nloc;
        if (old + 1u == (gen + 1u) * nloc) {
            __builtin_amdgcn_fence(__ATOMIC_RELEASE, "agent");
            asm volatile("s_waitcnt vmcnt(0)" ::: "memory");
            const unsigned og = xb_add(&bar[XB_TOP], 1u);
            const unsigned tg = og / nx;
            if (og + 1u == (tg + 1u) * nx) xb_add(&bar[XB_TOPGEN], 1u);
            else XB_SPIN(xb_ld(&bar[XB_TOPGEN]) == tg, bar);
            __builtin_amdgcn_fence(__ATOMIC_ACQUIRE, "agent");
            xb_add(&bar[XB_XGEN(b.x)], 1u);
            asm volatile("s_waitcnt vmcnt(0)" ::: "memory");
        } else {
            XB_SPIN(xb_ld(&bar[XB_XGEN(b.x)]) == gen, bar);
            __builtin_amdgcn_fence(__ATOMIC_ACQUIRE, "agent");
            asm volatile("s_waitcnt vmcnt(0)" ::: "memory");
        }
    }
    __syncthreads();
}

struct Args { const float* in[37]; float* out; unsigned char* ws; };

enum { I_X = 0, I_C, I_CTX, I_CCTX, I_MODW, I_MODB, I_NORMG, I_EVWIN, I_EVWOUT, I_QAN, I_WUQ, I_KVAN, I_WUKV, I_QN, I_KN,
       I_MUP, I_MUN, I_W0, I_WUP, I_A0, I_AUP, I_KK, I_KA, I_RK, I_LNW, I_LNB, I_ODWIN, I_ODWOUT, I_CONVW, I_CONVB, I_BIASD,
       I_FW1, I_FB1, I_FW2, I_FB2, I_FWOUT, I_FREQ };

#define INP(i) (a.in[(i) + opq0])
__device__ __forceinline__ void transpose_item(const float* W, int ldw, int src_col0, bool valid, bf16_t* WT, int Kd, int dst_row0, int k0, LAS float* scr, int lane, const float* kscale = nullptr) {
    if (valid) {
#pragma unroll 8
        for (int i = 0; i < 32; ++i) { const int kk = 2 * i + (lane >> 5); const float ks = kscale ? kscale[k0 + kk] : 1.0f; scr[kk * 33 + (lane & 31)] = W[(size_t)(k0 + kk) * ldw + src_col0 + (lane & 31)] * ks; }
    } else {
#pragma unroll 8
        for (int i = 0; i < 32; ++i) { const int kk = 2 * i + (lane >> 5); scr[kk * 33 + (lane & 31)] = 0.f; }
    }
    asm volatile("s_waitcnt vmcnt(0) lgkmcnt(0)" ::: "memory");
    const int c = lane & 7;
#pragma unroll
    for (int j = 0; j < 4; ++j) { const int n = (lane >> 3) + 8 * j; const LAS float* s = scr + (8 * c) * 33 + n;
        u32x4 o; o.x = pk2(s[0 * 33], s[1 * 33]); o.y = pk2(s[2 * 33], s[3 * 33]); o.z = pk2(s[4 * 33], s[5 * 33]); o.w = pk2(s[6 * 33], s[7 * 33]);
        *(u32x4*)(WT + (size_t)(dst_row0 + n) * Kd + k0 + 8 * c) = o; }
    asm volatile("s_waitcnt lgkmcnt(0)" ::: "memory");
}

__device__ __forceinline__ void norm_row(const float* xrow, const float* g, const float* md, bf16_t* orow, int lane) {
    const f32x4* xr = (const f32x4*)xrow + lane;
    f32x4 v[4]; float s = 0.f;
#pragma unroll
    for (int j = 0; j < 4; ++j) { v[j] = xr[64 * j]; s += (v[j].x * v[j].x + v[j].y * v[j].y) + (v[j].z * v[j].z + v[j].w * v[j].w); }
    const float rstd = 1.0f / sqrtf(wave_sum(s, lane) * (1.f / DM) + NORM_EPS);
    u32x2* o8 = (u32x2*)orow + lane;
#pragma unroll
    for (int j = 0; j < 4; ++j) {
        const f32x4 gg = ((const f32x4*)g)[lane + 64 * j], sh = ((const f32x4*)md)[lane + 64 * j], sc = ((const f32x4*)(md + 1024))[lane + 64 * j];
        const f32x4 y = (v[j] * rstd) * gg * (sc + 1.0f) + sh;
        u32x2 w; w.x = pk2(y.x, y.y); w.y = pk2(y.z, y.w); o8[64 * j] = w;
    }
}


__device__ __forceinline__ void filter_items(const float* hd, const float* fwout_e, bf16_t* go, int Lf, int it0, int itstep, LAS float* fred, LAS float* fcache  , int tid) {
    for (int it = it0; it < 256; it += itstep) {
        const int cg0 = it * 4;
        const int grl = 2 * Lf + 16;
        const int ch = tid & 3, dir = (tid >> 2) & 1, lg = tid >> 3, c = cg0 + ch;
        const float* wo = fwout_e + dir * 1024 + c;
        float wreg[64];
#pragma unroll
        for (int j = 0; j < 64; ++j) wreg[j] = wo[(size_t)j * 2048];
        const float dstart = -15.350567286626973f, dstop = -3.0701134573253946f;
        const float delta = fabsf(dstart + (float)c * ((dstop - dstart) / 1023.0f));
        const float invL1 = 1.0f / (float)(Lf - 1);
        float asum = 0.f;
        for (int l = lg; l < Lf; l += 64) {
            const f32x4* hp = (const f32x4*)(hd + (size_t)l * 64);
            float f = 0.f;
#pragma unroll
            for (int j4 = 0; j4 < 16; ++j4) { const f32x4 h4 = hp[j4]; f += h4.x * wreg[4 * j4] + h4.y * wreg[4 * j4 + 1] + h4.z * wreg[4 * j4 + 2] + h4.w * wreg[4 * j4 + 3]; }
            f *= expf(-((float)l * invL1) * delta);
            fcache[(dir * 4 + ch) * Lf + l] = f;
            if (!(dir == 1 && l == 0)) asum += fabsf(f);
        }
        fred[tid] = asum;
        __syncthreads();
        if (tid < 4) { float s = 0.f; for (int q = 0; q < 128; ++q) s += fred[q * 4 + tid]; fred[512 + tid] = s; }
        __syncthreads();
        const float inv = 1.0f / fred[512 + ch];
        bf16_t* grow = go + (size_t)c * grl;
        for (int l = lg; l < Lf; l += 64) {
            const float f = fcache[(dir * 4 + ch) * Lf + l];
            if (!(dir == 1 && l == 0)) grow[8 + Lf + (dir ? l : -l)] = (bf16_t)f2bf(f * inv);
        }
        if (tid < 4 * 17) { const int c2 = cg0 + (tid & 3), k = tid >> 2; bf16_t* g2 = go + (size_t)c2 * grl;
            g2[(k < 9) ? k : (2 * Lf + 8 + (k - 9))] = 0; }
        __syncthreads();
    }
}

__device__ __forceinline__ void even_wconv(const float* win, const float* wout, const float* wuq, const float* wukv, const float* qan, const float* kvan,
                                           bf16_t* WIN_, bf16_t* WOUT_, bf16_t* WUQ_, bf16_t* WUKV_, int it0, int itstep, LAS float* scr, int lane) {
    constexpr int N1 = 104 * 16, N2f = 32 * 16, N3 = 24 * 4, N4 = 32 * 4;
    const int N2 = wout ? N2f : 0;
    for (int it = it0; it < N1 + N2 + N3 + N4; it += itstep) {
        int r = it;
        if (r < N1) { const int nb = r / 16, kb = r % 16; const int d0 = nb * 32; int s0;
            if (d0 < 1792) s0 = 416 + d0; else if (d0 < 2816) s0 = 2208 + (d0 - 1792); else if (d0 < 3072) s0 = d0 - 2816; else if (d0 < 3232) s0 = 256 + (d0 - 3072); else s0 = -1;
            transpose_item(win, 3232, s0, s0 >= 0, WIN_, 1024, d0, kb * 64, scr, lane); continue; }
        r -= N1;
        if (r < N2) { const int nb = r / 16, kb = r % 16; transpose_item(wout, 1024, nb * 32, true, WOUT_, 1024, nb * 32, kb * 64, scr, lane); continue; }
        r -= N2;
        if (r < N3) { const int nb = r / 4, kb = r % 4; transpose_item(wuq, 768, nb * 32, true, WUQ_, 256, nb * 32, kb * 64, scr, lane, qan); continue; }
        r -= N3;
        { const int nb = r / 4, kb = r % 4; const int d0 = nb * 32; const int hh = (d0 & 511) >> 6, dd = d0 & 63; const int s0 = hh * 128 + dd + ((d0 >= 512) ? 64 : 0);
          transpose_item(wukv, 1024, s0, kb < 2, WUKV_, 256, d0, kb * 64, scr, lane, kvan); }
    }
}

__device__ __forceinline__ void norm_row2(const float* xrow0, const float* xrow1, const float* g, const float* md, bf16_t* orow, int lane) {
    const f32x4* xr0 = (const f32x4*)xrow0 + lane; const f32x4* xr1 = (const f32x4*)xrow1 + lane;
    f32x4 v0[4], v1[4]; float s0 = 0.f, s1 = 0.f;
#pragma unroll
    for (int j = 0; j < 4; ++j) { v0[j] = xr0[64 * j]; v1[j] = xr1[64 * j]; }
#pragma unroll
    for (int j = 0; j < 4; ++j) { s0 += (v0[j].x * v0[j].x + v0[j].y * v0[j].y) + (v0[j].z * v0[j].z + v0[j].w * v0[j].w); s1 += (v1[j].x * v1[j].x + v1[j].y * v1[j].y) + (v1[j].z * v1[j].z + v1[j].w * v1[j].w); }
    const float r0 = 1.0f / sqrtf(wave_sum(s0, lane) * (1.f / DM) + NORM_EPS), r1 = 1.0f / sqrtf(wave_sum(s1, lane) * (1.f / DM) + NORM_EPS);
    u32x2* o0 = (u32x2*)orow + lane; u32x2* o1 = (u32x2*)(orow + DM) + lane;
#pragma unroll
    for (int j = 0; j < 4; ++j) {
        const f32x4 gg = ((const f32x4*)g)[lane + 64 * j], sh = ((const f32x4*)md)[lane + 64 * j], sc = ((const f32x4*)(md + 1024))[lane + 64 * j];
        const f32x4 gs = gg * (sc + 1.0f);
        const f32x4 y0 = (v0[j] * r0) * gs + sh, y1 = (v1[j] * r1) * gs + sh;
        u32x2 w; w.x = pk2(y0.x, y0.y); w.y = pk2(y0.z, y0.w); o0[64 * j] = w;
        w.x = pk2(y1.x, y1.y); w.y = pk2(y1.z, y1.w); o1[64 * j] = w;
    }
}

__global__ void __launch_bounds__(NTHREADS, 2) mega_fwd(Args a) {
    extern __shared__ __attribute__((aligned(16))) unsigned char lds_raw[];
    cg::grid_group grid = cg::this_grid();
    LAS unsigned char* lds = (LAS unsigned char*)lds_raw;
    const int G = gridDim.x, bid = blockIdx.x;
    const int NGW = G * NWAVES;
    XcdBarrier xb, xb2;
    {
        int tid0 = threadIdx.x; asm volatile("" : "+v"(tid0));
        volatile LAS unsigned* stw = (volatile LAS unsigned*)(lds + LDS_BYTES - 16);
        if (tid0 < 4) stw[tid0] = 0u;
        __syncthreads();
        xb = xcd_barrier_post((unsigned*)(a.ws + OFF_BAR), stw, tid0, (unsigned)G);
        const int nscan0 = (G >= 256) ? 128 : (G / 2);
        if (bid >= nscan0) xb2 = xcd_barrier_post((unsigned*)(a.ws + OFF_BAR + 16384), stw + 2, tid0, (unsigned)(G - nscan0));
        else { xb2.bar = (unsigned*)(a.ws + OFF_BAR + 16384); xb2.x = 0; xb2.st = stw + 2; xb2.nmemb = 1; }
    }
#define PHASE_LOCALS \
    int tid = threadIdx.x; asm volatile("" : "+v"(tid)); \
    const int lane = tid & 63, wave = __builtin_amdgcn_readfirstlane(tid >> 6); \
    const int gw = bid * NWAVES + wave; \
    int opq0 = 0; asm volatile("" : "+s"(opq0)); \
    unsigned char* ws = a.ws + opq0; \
    (void)lane; (void)wave; (void)gw; (void)ws; (void)opq0;
#define MODS ((float*)(ws + OFF_MODS))
#define BONUS ((float*)(ws + OFF_BONUS))
#define HDN ((float*)(ws + OFF_HDN))
#define XC ((float*)(ws + OFF_XC))
#define BIG (ws + OFF_BIG)
#define WIN ((bf16_t*)(ws + OFF_WTS + W_IN))
#define WOUT ((bf16_t*)(ws + OFF_WTS + W_OUT))
#define WUQ ((bf16_t*)(ws + OFF_WTS + W_UQ))
#define WUKV ((bf16_t*)(ws + OFF_WTS + W_UKV))

#ifdef PROBE_LO
#define PSTAMP(k) do { if (bid == 0) ((volatile unsigned long long*)(a.ws + OFF_PSTAMP))[k] = __builtin_amdgcn_s_memrealtime(); } while (0)
    if (PROBE_LO < 0) PSTAMP(1);
#else
#define PSTAMP(k) do {} while (0)
#endif
    if (EN_P0) {
        PHASE_LOCALS
        LAS float* sc = (LAS float*)lds;
        LAS float* red = (LAS float*)(lds + 9 * 1024 * 4);
        bool have_silu = false;
        for (int it = bid; it < 4 * 48; it += G) {
            if (!have_silu) {
                for (int i = tid; i < 9 * 1024; i += NTHREADS) { const float cv = (i < 8192) ? INP(I_C)[i] : INP(I_CCTX)[i - 8192]; sc[i] = silu_f(cv); }
                have_silu = true;
            }
            __syncthreads();
            const int layer = it / 48, cg0 = (it % 48) * 64, cl = tid & 63, kg = tid >> 6;
            const float* W = INP(I_MODW) + (size_t)layer * 1024 * 3072 + cg0 + cl;
            float acc[9];
#pragma unroll
            for (int r = 0; r < 9; ++r) acc[r] = 0.f;
            for (int k = kg * 128; k < kg * 128 + 128; k += 4) {
                const float w0 = W[(size_t)k * 3072], w1 = W[(size_t)(k + 1) * 3072], w2 = W[(size_t)(k + 2) * 3072], w3 = W[(size_t)(k + 3) * 3072];
#pragma unroll
                for (int r = 0; r < 9; ++r) { const f32x4 s4 = *(const LAS f32x4*)(sc + r * 1024 + k); acc[r] += (s4.x * w0 + s4.y * w1) + (s4.z * w2 + s4.w * w3); }
            }
#pragma unroll
            for (int r = 0; r < 9; ++r) red[(kg * 9 + r) * 64 + cl] = acc[r];
            __syncthreads();
            for (int idx = tid; idx < 9 * 64; idx += NTHREADS) {
                const int r = idx >> 6, c2 = idx & 63; float s = 0.f;
#pragma unroll
                for (int q = 0; q < 8; ++q) s += red[(q * 9 + r) * 64 + c2];
                MODS[((size_t)layer * 9 + r) * 3072 + cg0 + c2] = s + INP(I_MODB)[layer * 3072 + cg0 + c2];
            }
        }
        for (int it = gw; it < 2048 + 256 + 2048; it += NGW) {
            int o, Lf, pos; float* outp;
            if (it < 2048) { o = 0; Lf = 2048; pos = it; outp = HDN + (size_t)pos * 64; }
            else if (it < 2304) { o = 0; Lf = 256; pos = it - 2048; outp = HDN + (size_t)(2048 + pos) * 64; }
            else { o = 1; Lf = 2048; pos = it - 2304; outp = HDN + (size_t)(2304 + pos) * 64; }
            const float fpos = (float)pos, tt = fpos / (float)(Lf - 1);
            float z = 0.f;
            if (lane == 0) z = tt;
            else if (lane < 33) {
                const int bi = (lane - 1) & 15;
                const float band = 1e-4f + (float)bi * ((15.0f - 1e-4f) / 15.0f);
                const float ang = fpos * (6.283185307179586f / (float)Lf) * band;
                z = (lane < 17) ? cosf(ang) : -sinf(ang);
            }
            const float fr = INP(I_FREQ)[o * 64 + lane];
            float h = INP(I_FB1)[o * 64 + lane];
            const float* w1 = INP(I_FW1) + (size_t)o * 33 * 64;
            for (int i = 0; i < 33; ++i) h += bcast(z, i) * w1[i * 64 + lane];
            h = sinf(fr * h);
            for (int jj = 0; jj < 2; ++jj) {
                const float* w2 = INP(I_FW2) + ((size_t)o * 2 + jj) * 64 * 64;
                float h2 = INP(I_FB2)[(o * 2 + jj) * 64 + lane];
                for (int i = 0; i < 64; ++i) h2 += bcast(h, i) * w2[i * 64 + lane];
                h = sinf(fr * h2);
            }
            outp[lane] = h;
        }
    }
    { int tidp = threadIdx.x; asm volatile("" : "+v"(tidp)); xcd_barrier(xb, tidp); }
    if (a.out == nullptr) grid.sync();

#ifdef EXTRA_SYNCS
    { int tid1 = threadIdx.x; asm volatile("" : "+v"(tid1)); for (int i = 0; i < EXTRA_SYNCS; ++i) xcd_barrier(xb, tid1); }
#endif
#ifdef PG_BLOCK
    unsigned long long pg_t0 = 0, pg_acc = 0;
#endif
    for (int ph = 0; ph < NPHASES; ++ph) {
#ifdef PROBE_LO
        if (ph == PROBE_LO) PSTAMP(1);
        if (ph == PROBE_HI && bid == 0) {
            volatile unsigned long long* ts = (volatile unsigned long long*)(a.ws + OFF_PSTAMP);
            const unsigned long long t2 = __builtin_amdgcn_s_memrealtime(); const unsigned long long t1 = ts[1];
            while (__builtin_amdgcn_s_memrealtime() - t2 < t2 - t1) __builtin_amdgcn_s_sleep(8);
        }
#endif
        {
            PHASE_LOCALS
            int phs = ph; asm volatile("" : "+s"(phs));
            int layer, step;
            if (phs < 8) { layer = 0; step = phs; } else if (phs < 14) { layer = 1; step = phs - 7; } else if (phs < 20) { layer = 2; step = phs - 13; } else { layer = 3; step = phs - 19; }
            const bool even = !(layer & 1);
            const int e = layer >> 1;
            const bool ctx_out = (layer < 2);
            const bool ctx_in = (layer < 3);
            const int Mrows = ctx_in ? MTOT : NLAT;
            const int Mout = ctx_out ? MTOT : NLAT;
            const float* xsrc = (layer == 0) ? INP(I_X) : a.out;
            const float* xcsrc = (layer == 0) ? INP(I_CTX) : XC;
            const float* mods = MODS + (size_t)layer * 9 * 3072;
            const int nscan = (G >= 256) ? 128 : (G / 2);
#ifdef PG_BLOCK
            if (layer == 0 && step == 2 && bid == PG_BLOCK) pg_t0 = __builtin_amdgcn_s_memrealtime();
#endif
            const bool split = even && step >= 2 && step <= 4;
            const int grp_lo = split ? nscan : 0;
            const int Gl = G - grp_lo, bidl = bid - grp_lo;
            const int gwl = bidl * NWAVES + wave, NGWl = Gl * NWAVES;
            int nroute = 0; bool resid = false;
            if (even) { if (step == 1) nroute = 1; else if (step == 2) nroute = (bid >= nscan) ? 2 : 0; }
            else { if (step == 1) nroute = 1; }
            const int tail0 = even ? 5 : 4;
            int ew_lo = 0, ew_hi = 0, ew_blo = 0;
            int rs_rowoff = 0, rs_M = 0, rs_Gl = G, rs_bidl = bid;
            if (ctx_out) {
                if (step == tail0) { ew_lo = NLAT; ew_hi = MTOT; }
                else if (step == tail0 + 1) { if (bid < 32) { resid = true; rs_rowoff = NLAT; rs_M = NCTX; rs_Gl = 32; } else { ew_lo = 0; ew_hi = NLAT; ew_blo = 32; } }
                else if (step == tail0 + 2) { resid = true; rs_M = NLAT; }
            } else {
                if (step == tail0) { ew_hi = NLAT; }
                else if (step == tail0 + 1) { resid = true; rs_M = NLAT; }
            }
            const int gwE = (bid - ew_blo) * NWAVES + wave, NGWE = (G - ew_blo) * NWAVES;

            if (EN_NORM && step == 0) {
                bf16_t* H = (bf16_t*)(BIG + (even ? EV_E : OD_HV));
                const float* ng = INP(I_NORMG) + layer * 1024;
                for (int m2 = 2 * gw; m2 < Mrows; m2 += 2 * NGW) {
                    const float* xr0; const float* xr1; const float* md;
                    if (m2 < NLAT) { xr0 = xsrc + (size_t)m2 * DM; md = mods + (m2 >> 11) * 3072; }
                    else { xr0 = xcsrc + (size_t)(m2 - NLAT) * DM; md = mods + 8 * 3072; }
                    xr1 = xr0 + DM;
                    norm_row2(xr0, xr1, ng, md, H + (size_t)m2 * DM, lane);
                }
                LAS float* scr = (LAS float*)(lds + wave * 8448);
                even_wconv(INP(I_EVWIN) + (size_t)e * 1024 * 3232, INP(I_EVWOUT) + (size_t)e * 1024 * 1024, INP(I_WUQ) + (size_t)e * 256 * 768, INP(I_WUKV) + (size_t)e * 128 * 1024,
                           INP(I_QAN) + e * 256, INP(I_KVAN) + e * 128, WIN, WOUT, WUQ, WUKV, gw, NGW, scr, lane);
            } else if (EN_E4 && even && step == 3 && bid >= nscan) {
                {
                    LAS float* scr = (LAS float*)(lds + 4096 + wave * 8448);
                    const float* win = INP(I_ODWIN) + (size_t)e * 1024 * 4096;
                    for (int it = gwl; it < 128 * 16; it += NGWl) { const int nb = it / 16, kb = it % 16; transpose_item(win, 4096, nb * 32, true, WIN, 1024, nb * 32, kb * 64, scr, lane); }
                    __syncthreads();
                    filter_items(HDN + (size_t)(e == 0 ? 0 : 2304) * 64, INP(I_FWOUT) + (size_t)e * 64 * 2048, (bf16_t*)(ws + OFF_GR), 2048, bidl, Gl, (LAS float*)(lds + 72192), (LAS float*)(lds + 76288), tid);
                }
                bf16_t* Q = (bf16_t*)(BIG + EV_C); bf16_t* K = (bf16_t*)(BIG + EV_G); bf16_t* V = (bf16_t*)(BIG + EV_D);
                const bf16_t* PDQ = (const bf16_t*)(BIG + EV_F);
                const float* qn = INP(I_QN) + e * 96; const float* kn = INP(I_KN) + e * 96;
                const int hh = lane >> 3, d0 = (lane & 7) * 12;
                LAS float* RT = (LAS float*)lds;
                { const int pos = tid >> 3, fi = tid & 7; const float inv = powf(10000.0f, -(float)fi / 8.0f); const float ang = (float)pos * inv;
                  RT[2 * tid] = cosf(ang); RT[2 * tid + 1] = sinf(ang); }
                __syncthreads();
                float gq[12], gk[12];
#pragma unroll
                for (int j = 0; j < 12; ++j) { gq[j] = qn[d0 + j]; gk[j] = kn[d0 + j]; }
                for (int m2 = 2 * gwl; m2 < MTOT; m2 += 2 * NGWl) {
                    unsigned wq[2][6], wk[2][6]; u32x4 pw[2], vw[2];
#pragma unroll
                    for (int r = 0; r < 2; ++r) {
                        const int m = m2 + r;
                        pw[r] = *(const u32x4*)(PDQ + (size_t)m * 512 + 8 * lane);
                        vw[r] = *(const u32x4*)(V + (size_t)m * 512 + 8 * lane);
                        const bf16_t* src = Q + (size_t)m * 768 + lane * 12;
#pragma unroll
                        for (int j = 0; j < 6; ++j) { const int d = d0 + 2 * j;
                            wq[r][j] = *(const unsigned*)(src + 2 * j);
                            wk[r][j] = (d < 64) ? *(const unsigned*)(K + (size_t)m * 768 + hh * 96 + d) : *(const unsigned*)(PDQ + (size_t)m * 512 + 384 + (d - 64)); }
                    }
#pragma unroll
                    for (int r = 0; r < 2; ++r) {
                        const int m = m2 + r;
                        const bool lat = m < NLAT; const int t = m & 2047;
                        float s8 = 0.f;
                        { const u32x4 p = pw[r]; s8 = bflo(p.x) * bflo(p.x) + bfhi(p.x) * bfhi(p.x) + bflo(p.y) * bflo(p.y) + bfhi(p.y) * bfhi(p.y)
                                               + bflo(p.z) * bflo(p.z) + bfhi(p.z) * bfhi(p.z) + bflo(p.w) * bflo(p.w) + bfhi(p.w) * bfhi(p.w); }
                        const float sq = red64((lane < 32) ? s8 : 0.f), skv = red64((lane >= 32 && lane < 48) ? s8 : 0.f);
                        const float rq = 1.0f / sqrtf(sq * (1.f / 256.f) + NORM_EPS), rkv = 1.0f / sqrtf(skv * (1.f / 128.f) + NORM_EPS);
                        { const u32x4 p = vw[r]; u32x4 o;
                          o.x = pk2(bflo(p.x) * rkv, bfhi(p.x) * rkv); o.y = pk2(bflo(p.y) * rkv, bfhi(p.y) * rkv); o.z = pk2(bflo(p.z) * rkv, bfhi(p.z) * rkv); o.w = pk2(bflo(p.w) * rkv, bfhi(p.w) * rkv);
                          *(u32x4*)(V + (size_t)m * 512 + 8 * lane) = o; }
                        float rcs[6], rsn[6];
#pragma unroll
                        for (int jj = 0; jj < 6; ++jj) { const int d = d0 + 2 * jj; rcs[jj] = 1.f; rsn[jj] = 0.f;
                            if (lat && d >= 64) { const int pi = (d - 64) >> 1; const int pos = (pi < 8) ? (t >> 6) : (t & 63);
                                const f32x2 cs2 = *(const LAS f32x2*)(RT + 2 * (pos * 8 + (pi & 7))); rcs[jj] = cs2.x; rsn[jj] = cs2.y; } }
#pragma unroll
                        for (int which = 0; which < 2; ++which) {
                            float v[12];
#pragma unroll
                            for (int j = 0; j < 6; ++j) { const unsigned w = which ? wk[r][j] : wq[r][j]; v[2 * j] = bflo(w); v[2 * j + 1] = bfhi(w); }
#pragma unroll
                            for (int j = 0; j < 12; ++j) { const float sc = which ? ((d0 + j < 64) ? rkv : 1.0f) : rq; v[j] *= sc; }
                            float ss = 0.f;
#pragma unroll
                            for (int j = 0; j < 12; ++j) ss += v[j] * v[j];
                            const float rs = 1.0f / sqrtf(sum8(ss, lane) * (1.f / 96.f) + NORM_EPS);
#pragma unroll
                            for (int j = 0; j < 12; ++j) v[j] = v[j] * rs * (which ? gk[j] : gq[j]);
#pragma unroll
                            for (int jj = 0; jj < 6; ++jj) { const float aa = v[2 * jj], bb = v[2 * jj + 1];
                                v[2 * jj] = aa * rcs[jj] - bb * rsn[jj]; v[2 * jj + 1] = aa * rsn[jj] + bb * rcs[jj]; }
                            bf16_t* dst = (which ? K : Q) + (size_t)m * 768 + lane * 12;
#pragma unroll
                            for (int j = 0; j < 6; ++j) *(unsigned*)(dst + 2 * j) = pk2(v[2 * j], v[2 * j + 1]);
                        }
                    }
                }
            } else if (EN_E5 && even && ((step == 2 && bid < nscan) || (step == 4 && bid >= nscan))) {
                if (EN_SCAN && bid < nscan) {
                    const bf16_t* PRW = (const bf16_t*)(BIG + EV_A);
                    bf16_t* OUT = (bf16_t*)(BIG + EV_E);
                    LAS bf16_t* RAW = (LAS bf16_t*)(lds);
                    LAS bf16_t* WDA = (LAS bf16_t*)(lds + 21760);
                    LAS bf16_t* ADA = (LAS bf16_t*)(lds + 26368);
                    LAS float* WZ = (LAS float*)(lds + 30976);
                    LAS float* AZ = (LAS float*)(lds + 39168);
                    LAS float* GP = (LAS float*)(lds + 47360);
                    LAS float* MUL = (LAS float*)(lds + 49408);
                    LAS bf16_t* CUT = (LAS bf16_t*)(lds + 53248);
                    LAS float* CXL = (LAS float*)(lds + 58368);
                    LAS bf16_t* CSB = (LAS bf16_t*)(lds + 62464);
                    constexpr int HB = 71680;
                    constexpr int HSZ = 28672;
                    for (int chain = bid; chain < 128; chain += nscan) {
                        const int b = chain >> 4, hh = (chain >> 1) & 7, dir = chain & 1;
                        const int c = lane;
                        __syncthreads();
                        for (int i = tid; i < (HB + 2 * HSZ - 53248) / 4; i += NTHREADS) ((LAS unsigned*)(lds + 53248))[i] = 0u;
                        if (tid < 320) {
                            const float* mup = INP(I_MUP) + e * 1792; const float* mun = INP(I_MUN) + e * 1792;
                            const int g = tid >> 6, cc = tid & 63; const int col = (g < 3) ? (g * 512 + hh * 64 + cc) : ((g == 3 ? 1536 : 1664) + dir * 64 + cc);
                            const float mp = mup[col], mn = mun[col];
                            MUL[tid] = 1.0f - mp - mn; MUL[320 + tid] = dir ? mn : mp; MUL[640 + tid] = dir ? mp : mn;
                        }
                        const float kkw = INP(I_KK)[e * 512 + hh * 64 + c], kaw = INP(I_KA)[e * 512 + hh * 64 + c];
                        const float rkw = INP(I_RK)[(((size_t)e * 2 + dir) * 8 + hh) * 64 + c];
                        const int mm = wave >> 2, ct = wave & 3;
                        bf16x8 Bfr[2]; float lbias;
                        {
                            const float* up = (mm ? INP(I_AUP) : INP(I_WUP)) + ((size_t)e * 2 + dir) * 64 * 512 + hh * 64 + ct * 16 + (lane & 15);
#pragma unroll
                            for (int ks2 = 0; ks2 < 2; ++ks2) {
                                float t8[8];
#pragma unroll
                                for (int q = 0; q < 8; ++q) t8[q] = up[(size_t)(32 * ks2 + 8 * (lane >> 4) + q) * 512];
                                u32x4 w; w.x = pk2(t8[0], t8[1]); w.y = pk2(t8[2], t8[3]); w.z = pk2(t8[4], t8[5]); w.w = pk2(t8[6], t8[7]);
                                Bfr[ks2] = __builtin_bit_cast(bf16x8, w);
                            }
                            lbias = (mm ? INP(I_A0) : INP(I_W0))[((size_t)e * 2 + dir) * 512 + hh * 64 + ct * 16 + (lane & 15)];
                        }
                        f32x4 SA0 = (f32x4){0.f, 0.f, 0.f, 0.f}, SA1 = (f32x4){0.f, 0.f, 0.f, 0.f};
                        u32x4 pre[3];
#define CHUNK_GEO(chv) const bool isctx_ = (chv) < 8; const int seglen_ = isctx_ ? 256 : 2048; const int rowbase_ = isctx_ ? (NLAT + b * 256) : (b * 2048); \
                        const int jseg_ = isctx_ ? (chv) * 32 : ((chv) - 8) * 32; const int ttlo_ = dir ? (seglen_ - 1 - jseg_ - 31) : jseg_;
#define RAW_LOAD(chv) do { CHUNK_GEO(chv) _Pragma("unroll") for (int u = 0; u < 3; ++u) { const int id = tid + 512 * u; pre[u] = (u32x4){0u, 0u, 0u, 0u}; \
                            if (id < 1360) { const int i_ = id / 40, rem_ = id - i_ * 40, g_ = rem_ >> 3, c8_ = rem_ & 7; const int tt_ = ttlo_ - 1 + i_; \
                                if (tt_ >= 0 && tt_ < seglen_) { const int col_ = (g_ < 3) ? (g_ * 512 + hh * 64) : ((g_ == 3 ? 1536 : 1664) + dir * 64); \
                                    pre[u] = *(const u32x4*)(PRW + (size_t)(rowbase_ + tt_) * 1792 + col_ + 8 * c8_); } } } } while (0)
                        RAW_LOAD(0);
                        for (int ch = 0; ch < 72; ++ch) {
                            CHUNK_GEO(ch)
#pragma unroll
                            for (int u = 0; u < 3; ++u) { const int id = tid + 512 * u; if (id < 1360) { const int i_ = id / 40, rem_ = id - i_ * 40; *(LAS u32x4*)(RAW + i_ * 320 + rem_ * 8) = pre[u]; } }
                            __syncthreads();
                            if (ch + 1 < 72) RAW_LOAD(ch + 1);
                            float rr[4], kv4[4], vv[4], kn[4];
                            {
                                const int r0 = dir ? (33 - 4 * wave) : (4 * wave); const int rs = dir ? -1 : 1;
                                float y[5][6];
#pragma unroll
                                for (int g = 0; g < 5; ++g)
#pragma unroll
                                    for (int i = 0; i < 6; ++i) y[g][i] = bf2f(RAW[(r0 + rs * i) * 320 + g * 64 + c]);
                                float m0[5], ca[5], cb[5];
#pragma unroll
                                for (int g = 0; g < 5; ++g) { m0[g] = MUL[g * 64 + c]; ca[g] = MUL[320 + g * 64 + c]; cb[g] = MUL[640 + g * 64 + c]; }
#pragma unroll
                                for (int j = 0; j < 4; ++j) {
                                    const int s = 4 * wave + j;
                                    float sv[5];
#pragma unroll
                                    for (int g = 0; g < 5; ++g) sv[g] = y[g][j + 1] * m0[g] + y[g][j] * ca[g] + y[g][j + 2] * cb[g];
                                    rr[j] = sv[0]; kv4[j] = sv[1]; vv[j] = sv[2];
                                    const float e2 = __expf(2.0f * sv[3]); const float th = 1.0f - 2.0f * __builtin_amdgcn_rcpf(1.0f + e2);
                                    WDA[s * 72 + c] = (bf16_t)f2bf(th); ADA[s * 72 + c] = (bf16_t)f2bf(sv[4]);
                                    const float kr = sv[1] * kkw;
                                    const float nrm = red64(kr * kr);
                                    kn[j] = kr * __builtin_amdgcn_rsqf(fmaxf(nrm, 1e-24f));
                                }
                            }
                            __syncthreads();
                            {
                                const LAS bf16_t* Am = mm ? ADA : WDA; LAS float* Zm = mm ? AZ : WZ;
#pragma unroll
                                for (int rt = 0; rt < 2; ++rt) {
                                    f32x4 acc = (f32x4){lbias, lbias, lbias, lbias};
#pragma unroll
                                    for (int ks2 = 0; ks2 < 2; ++ks2) {
                                        const bf16x8 Af = *(const LAS bf16x8*)(Am + (16 * rt + (lane & 15)) * 72 + 32 * ks2 + 8 * (lane >> 4));
                                        acc = __builtin_amdgcn_mfma_f32_16x16x32_bf16(Af, Bfr[ks2], acc, 0, 0, 0);
                                    }
#pragma unroll
                                    for (int q = 0; q < 4; ++q) Zm[(16 * rt + 4 * (lane >> 4) + q) * 64 + ct * 16 + (lane & 15)] = acc[q];
                                }
                            }
                            __syncthreads();
                            float ecum[4], bb[4], kdv[4];
                            {
                                float es = 0.f;
#pragma unroll
                                for (int j = 0; j < 4; ++j) {
                                    const int s = 4 * wave + j;
                                    const float sg = __builtin_amdgcn_rcpf(1.0f + __expf(-WZ[s * 64 + c]));
                                    es += 0.60653065971f * sg; ecum[j] = es;
                                    const float av = __builtin_amdgcn_rcpf(1.0f + __expf(-AZ[s * 64 + c]));
                                    kdv[j] = kv4[j] * (1.0f + (av - 1.0f) * kaw);
                                    bb[j] = kn[j] * av;
                                    const float bon = red64(rr[j] * kdv[j] * rkw);
                                    if (lane == 0) { const int tt = dir ? (ttlo_ + 31 - s) : (ttlo_ + s); BONUS[((size_t)(rowbase_ + tt) * 2 + dir) * 8 + hh] = bon; }
                                }
                                GP[wave * 64 + c] = es;
                            }
                            __syncthreads();
                            {
                                const int wq = wave & 3;
                                LAS unsigned char* hb = lds + HB + (wave >> 2) * HSZ;
                                LAS bf16_t* AH = (LAS bf16_t*)hb; LAS bf16_t* RH = AH + 1152; LAS bf16_t* BH = RH + 1152; LAS bf16_t* KH = BH + 1152;
                                LAS bf16_t* BHT = (LAS bf16_t*)(hb + 9216); LAS bf16_t* KHT = (LAS bf16_t*)(hb + 14336); LAS bf16_t* VT = (LAS bf16_t*)(hb + 19456);
                                float base = 0.f;
                                if (wq > 0) base += GP[(wave - 1) * 64 + c];
                                if (wq > 1) base += GP[(wave - 2) * 64 + c];
                                if (wq > 2) base += GP[(wave - 3) * 64 + c];
                                float gprev = __expf(-base);
                                float bq[4], kq[4];
#pragma unroll
                                for (int j = 0; j < 4; ++j) {
                                    const int t = 4 * wq + j; const float es = base + ecum[j];
                                    const float gc = __expf(-es), ig = __expf(es);
                                    bq[j] = bb[j] * ig; kq[j] = kdv[j] * ig;
                                    AH[t * 72 + c] = (bf16_t)f2bf(-kn[j] * gprev); RH[t * 72 + c] = (bf16_t)f2bf(rr[j] * gc);
                                    BH[t * 72 + c] = (bf16_t)f2bf(bq[j]); KH[t * 72 + c] = (bf16_t)f2bf(kq[j]);
                                    gprev = gc;
                                }
                                u32x2 w;
                                w.x = pk2(bq[0], bq[1]); w.y = pk2(bq[2], bq[3]); *(LAS u32x2*)(BHT + c * 40 + 4 * wq) = w;
                                w.x = pk2(kq[0], kq[1]); w.y = pk2(kq[2], kq[3]); *(LAS u32x2*)(KHT + c * 40 + 4 * wq) = w;
                                w.x = pk2(vv[0], vv[1]); w.y = pk2(vv[2], vv[3]); *(LAS u32x2*)(VT + c * 40 + 4 * wq) = w;
                                if (wq == 3) ((LAS float*)(hb + 28416))[c] = gprev;
                            }
                            __syncthreads();
                            float l1r0 = 0.f, l1r1 = 0.f, l1r2 = 0.f, l1r3 = 0.f;
                            {
                                int lane_h = lane; asm volatile("" : "+v"(lane_h));
                                const int wq = wave & 3;
                                LAS unsigned char* hb = lds + HB + (wave >> 2) * HSZ;
                                const LAS bf16_t* M1 = (const LAS bf16_t*)(hb + ((wq < 2) ? 0 : 2304)); const LAS bf16_t* M2 = (const LAS bf16_t*)(hb + ((wq & 1) ? 6912 : 4608));
                                f32x4 acc = (f32x4){0.f, 0.f, 0.f, 0.f};
#pragma unroll
                                for (int kc = 0; kc < 2; ++kc) {
                                    const bf16x8 Af = *(const LAS bf16x8*)(M1 + (lane_h & 15) * 72 + 32 * kc + 8 * (lane_h >> 4));
                                    const bf16x8 Bf = *(const LAS bf16x8*)(M2 + (lane_h & 15) * 72 + 32 * kc + 8 * (lane_h >> 4));
                                    acc = __builtin_amdgcn_mfma_f32_16x16x32_bf16(Af, Bf, acc, 0, 0, 0);
                                }
                                const int sc = lane_h & 15;
                                LAS bf16_t* dst = (LAS bf16_t*)(hb + ((wq == 1) ? 24576 : (wq == 2) ? 25856 : 27136));
#pragma unroll
                                for (int q = 0; q < 4; ++q) {
                                    const int tr = 4 * (lane_h >> 4) + q;
                                    const bool keep = (wq < 2) ? (sc < tr) : (sc <= tr);
                                    const float val = keep ? acc[q] : 0.f;
                                    if (wq == 0) { if (q == 0) l1r0 = val; else if (q == 1) l1r1 = val; else if (q == 2) l1r2 = val; else l1r3 = val; }
                                    else dst[tr * 40 + sc] = (bf16_t)f2bf(val);
                                }
                            }
                            __syncthreads();
#pragma unroll 1
                            for (int hf = 0; hf < 2; ++hf) {
                                int lane_h = lane; asm volatile("" : "+v"(lane_h)); int wave_h = wave; asm volatile("" : "+s"(wave_h));
                                const int sb0 = 16 * hf;
                                LAS unsigned char* hb = lds + HB + hf * HSZ;
                                const LAS bf16_t* CAH = (const LAS bf16_t*)hb; const LAS bf16_t* CRH = CAH + 1152;
                                const LAS bf16_t* CBHT = (const LAS bf16_t*)(hb + 9216); const LAS bf16_t* CKHT = (const LAS bf16_t*)(hb + 14336); const LAS bf16_t* CVT = (const LAS bf16_t*)(hb + 19456);
                                const LAS bf16_t* CL2B = (const LAS bf16_t*)(hb + 24576); const LAS bf16_t* CN1B = (const LAS bf16_t*)(hb + 25856); const LAS bf16_t* CN2B = (const LAS bf16_t*)(hb + 27136);
                                const LAS float* CDL = (const LAS float*)(hb + 28416);
                                f32x4 oacc = (f32x4){0.f, 0.f, 0.f, 0.f};
                                {
                                    const int vt = wave_h & 3; const bool isx = wave_h < 4;
                                    const LAS bf16_t* M1 = isx ? CAH : CRH; const LAS bf16_t* M3 = isx ? CL2B : CN2B;
                                    f32x4 acc = (f32x4){0.f, 0.f, 0.f, 0.f};
#pragma unroll
                                    for (int kc = 0; kc < 2; ++kc) {
                                        const bf16x8 Af = *(const LAS bf16x8*)(M1 + (lane_h & 15) * 72 + 32 * kc + 8 * (lane_h >> 4));
                                        const bf16x8 Bf = *(const LAS bf16x8*)(CSB + (16 * vt + (lane_h & 15)) * 72 + 32 * kc + 8 * (lane_h >> 4));
                                        acc = __builtin_amdgcn_mfma_f32_16x16x32_bf16(Af, Bf, acc, 0, 0, 0);
                                    }
                                    {
                                        const bf16x8 Af = *(const LAS bf16x8*)(M3 + (lane_h & 15) * 40 + 8 * (lane_h >> 4));
                                        const bf16x8 Bf = *(const LAS bf16x8*)(CVT + (16 * vt + (lane_h & 15)) * 40 + 8 * (lane_h >> 4));
                                        acc = __builtin_amdgcn_mfma_f32_16x16x32_bf16(Af, Bf, acc, 0, 0, 0);
                                    }
                                    if (isx) {
#pragma unroll
                                        for (int q = 0; q < 4; ++q) CXL[(4 * (lane_h >> 4) + q) * 64 + 16 * vt + (lane_h & 15)] = acc[q];
                                    } else oacc = acc;
                                }
                                __syncthreads();
                                if (wave_h == 4 * hf) {
                                    float u[16];
#pragma unroll
                                    for (int t = 0; t < 16; ++t) u[t] = CXL[t * 64 + lane_h];
#pragma unroll
                                    for (int s2 = 0; s2 < 15; ++s2) {
#pragma unroll
                                        for (int t = s2 + 1; t < 16; ++t) {
                                            const float lsrc = ((t & 3) == 0) ? l1r0 : ((t & 3) == 1) ? l1r1 : ((t & 3) == 2) ? l1r2 : l1r3;
                                            const float lts = __builtin_bit_cast(float, __builtin_amdgcn_readlane(__builtin_bit_cast(int, lsrc), 16 * (t >> 2) + s2));
                                            u[t] += lts * u[s2];
                                        }
                                    }
                                    u32x4 w0, w1;
                                    w0.x = pk2(u[0], u[1]); w0.y = pk2(u[2], u[3]); w0.z = pk2(u[4], u[5]); w0.w = pk2(u[6], u[7]);
                                    w1.x = pk2(u[8], u[9]); w1.y = pk2(u[10], u[11]); w1.z = pk2(u[12], u[13]); w1.w = pk2(u[14], u[15]);
                                    *(LAS u32x4*)(CUT + lane_h * 40) = w0; *(LAS u32x4*)(CUT + lane_h * 40 + 8) = w1;
                                }
                                __syncthreads();
                                {
                                    const int kt = wave_h & 3, vt0 = 2 * (wave_h >> 2);
                                    const bf16x8 Ak = *(const LAS bf16x8*)(CKHT + (16 * kt + (lane_h & 15)) * 40 + 8 * (lane_h >> 4));
                                    const bf16x8 Ab = *(const LAS bf16x8*)(CBHT + (16 * kt + (lane_h & 15)) * 40 + 8 * (lane_h >> 4));
                                    const f32x4 dl = *(const LAS f32x4*)(CDL + 16 * kt + 4 * (lane_h >> 4));
#pragma unroll
                                    for (int i = 0; i < 2; ++i) {
                                        const int vt = vt0 + i;
                                        const bf16x8 Bv = *(const LAS bf16x8*)(CVT + (16 * vt + (lane_h & 15)) * 40 + 8 * (lane_h >> 4));
                                        const bf16x8 Bu = *(const LAS bf16x8*)(CUT + (16 * vt + (lane_h & 15)) * 40 + 8 * (lane_h >> 4));
                                        f32x4 sa_ = i ? SA1 : SA0;
                                        sa_ = __builtin_amdgcn_mfma_f32_16x16x32_bf16(Ak, Bv, sa_, 0, 0, 0);
                                        sa_ = __builtin_amdgcn_mfma_f32_16x16x32_bf16(Ab, Bu, sa_, 0, 0, 0);
                                        sa_ = sa_ * dl;
                                        if (i) SA1 = sa_; else SA0 = sa_;
                                        u32x2 w; w.x = pk2(sa_[0], sa_[1]); w.y = pk2(sa_[2], sa_[3]);
                                        *(LAS u32x2*)(CSB + (16 * vt + (lane_h & 15)) * 72 + 16 * kt + 4 * (lane_h >> 4)) = w;
                                    }
                                    if (wave_h >= 4) {
                                        const int vt = wave_h & 3;
                                        const bf16x8 Af = *(const LAS bf16x8*)(CN1B + (lane_h & 15) * 40 + 8 * (lane_h >> 4));
                                        const bf16x8 Bu = *(const LAS bf16x8*)(CUT + (16 * vt + (lane_h & 15)) * 40 + 8 * (lane_h >> 4));
                                        oacc = __builtin_amdgcn_mfma_f32_16x16x32_bf16(Af, Bu, oacc, 0, 0, 0);
#pragma unroll
                                        for (int q = 0; q < 4; ++q) { const int s = sb0 + 4 * (lane_h >> 4) + q; const int tt = dir ? (ttlo_ + 31 - s) : (ttlo_ + s);
                                            OUT[((size_t)(rowbase_ + tt) * 2 + dir) * 512 + hh * 64 + 16 * vt + (lane_h & 15)] = (bf16_t)f2bf(oacc[q]); }
                                    }
                                }
                                __syncthreads();
                            }
                        }
#undef RAW_LOAD
#undef CHUNK_GEO
                    }
                } else if (EN_ATTN && bid >= nscan) {
                    bf16_t* Q = (bf16_t*)(BIG + EV_C); const bf16_t* K = (const bf16_t*)(BIG + EV_G); const bf16_t* V = (const bf16_t*)(BIG + EV_D);
                    const int nunits = 512 + (ctx_out ? 64 : 0);
                    const int nab = G - nscan;
                    for (int unit = bid - nscan; unit < nunits; unit += nab) {
                        int b, hh, q0, nlat, NT;
                        if (unit < 512) { b = unit >> 6; hh = (unit >> 3) & 7; q0 = b * 2048 + (unit & 7) * 256; nlat = 32; NT = 36; }
                        else { const int u2 = unit - 512; b = u2 >> 3; hh = u2 & 7; q0 = NLAT + b * 256; nlat = 0; NT = 4; }
                        att::attn_body(Q + (size_t)q0 * 768 + hh * 96, K + hh * 96, V + hh * 64, Q + (size_t)q0 * 768 + hh * 96, b * 2048, NLAT + b * 256, nlat, NT, (LAS char*)lds, tid);
                    }
}
            } else if (EN_E6 && even && ew_hi > ew_lo && bid >= ew_blo) {
                const bf16_t* O = (const bf16_t*)(BIG + EV_C); const bf16_t* PG = (const bf16_t*)(BIG + EV_B); const bf16_t* PRW = (const bf16_t*)(BIG + EV_A);
                const bf16_t* OUT = (const bf16_t*)(BIG + EV_E);
                bf16_t* U = (bf16_t*)(BIG + EV_D);
                const float* mup = INP(I_MUP) + e * 1792 + 1024; const float* mun = INP(I_MUN) + e * 1792 + 1024;
                const float* lnw = INP(I_LNW) + e * 512; const float* lnb = INP(I_LNB) + e * 512;
                for (int m = ew_lo + gwE; m < ew_hi; m += NGWE) {
                    const int hh = lane >> 3, ch0 = lane * 8;
                    {
                        const u32x4 ow = *(const u32x4*)(O + (size_t)m * 768 + hh * 96 + (lane & 7) * 8);
                        const u32x4 gwd = *(const u32x4*)(PG + (size_t)m * 1024 + ch0);
                        u32x4 r;
                        r.x = pk2(bflo(ow.x) * silu_f(bflo(gwd.x)), bfhi(ow.x) * silu_f(bfhi(gwd.x)));
                        r.y = pk2(bflo(ow.y) * silu_f(bflo(gwd.y)), bfhi(ow.y) * silu_f(bfhi(gwd.y)));
                        r.z = pk2(bflo(ow.z) * silu_f(bflo(gwd.z)), bfhi(ow.z) * silu_f(bfhi(gwd.z)));
                        r.w = pk2(bflo(ow.w) * silu_f(bflo(gwd.w)), bfhi(ow.w) * silu_f(bfhi(gwd.w)));
                        *(u32x4*)(U + (size_t)m * 1024 + ch0) = r;
                    }
                    {
                        const u32x4 o0 = *(const u32x4*)(OUT + ((size_t)m * 2 + 0) * 512 + ch0), o1 = *(const u32x4*)(OUT + ((size_t)m * 2 + 1) * 512 + ch0);
                        float ov[8];
                        ov[0] = bflo(o0.x) + bflo(o1.x); ov[1] = bfhi(o0.x) + bfhi(o1.x); ov[2] = bflo(o0.y) + bflo(o1.y); ov[3] = bfhi(o0.y) + bfhi(o1.y);
                        ov[4] = bflo(o0.z) + bflo(o1.z); ov[5] = bfhi(o0.z) + bfhi(o1.z); ov[6] = bflo(o0.w) + bflo(o1.w); ov[7] = bfhi(o0.w) + bfhi(o1.w);
                        float s = 0.f;
#pragma unroll
                        for (int j = 0; j < 8; ++j) s += ov[j];
                        const float mu = sum8(s, lane) * (1.f / 64.f);
                        float s2 = 0.f;
#pragma unroll
                        for (int j = 0; j < 8; ++j) { ov[j] -= mu; s2 += ov[j] * ov[j]; }
                        const float rstd = 1.0f / sqrtf(sum8(s2, lane) * (1.f / 64.f) + 64e-5f);
                        const float bon = BONUS[((size_t)m * 2 + 0) * 8 + hh] + BONUS[((size_t)m * 2 + 1) * 8 + hh];
                        const bool lat = m < NLAT; const int tt = lat ? (m & 2047) : ((m - NLAT) & 255); const int seglen = lat ? 2048 : 256;
                        const bf16_t* pp = PRW + (size_t)m * 1792 + 1024 + ch0;
                        const u32x4 pc = *(const u32x4*)pp;
                        u32x4 pv = (u32x4){0u, 0u, 0u, 0u}, pn = (u32x4){0u, 0u, 0u, 0u};
                        if (tt > 0) pv = *(const u32x4*)(pp - 1792);
                        if (tt < seglen - 1) pn = *(const u32x4*)(pp + 1792);
                        const u32x4 gwd = *(const u32x4*)(PG + (size_t)m * 1024 + 512 + ch0);
                        float res[8];
#pragma unroll
                        for (int j = 0; j < 8; ++j) {
                            const unsigned wc_ = (j < 2) ? pc.x : (j < 4) ? pc.y : (j < 6) ? pc.z : pc.w;
                            const unsigned wp_ = (j < 2) ? pv.x : (j < 4) ? pv.y : (j < 6) ? pv.z : pv.w;
                            const unsigned wn_ = (j < 2) ? pn.x : (j < 4) ? pn.y : (j < 6) ? pn.z : pn.w;
                            const unsigned wg_ = (j < 2) ? gwd.x : (j < 4) ? gwd.y : (j < 6) ? gwd.z : gwd.w;
                            const float p = (j & 1) ? bfhi(wc_) : bflo(wc_), pr = (j & 1) ? bfhi(wp_) : bflo(wp_), nx = (j & 1) ? bfhi(wn_) : bflo(wn_);
                            const float gg = (j & 1) ? bfhi(wg_) : bflo(wg_);
                            const float vs = p + (pr - p) * mup[ch0 + j] + (nx - p) * mun[ch0 + j];
                            const float on = ov[j] * rstd * lnw[ch0 + j] + lnb[ch0 + j] + bon * vs;
                            res[j] = on * silu_f(gg);
                        }
                        u32x4 r; r.x = pk2(res[0], res[1]); r.y = pk2(res[2], res[3]); r.z = pk2(res[4], res[5]); r.w = pk2(res[6], res[7]);
                        *(u32x4*)(U + (size_t)m * 1024 + 512 + ch0) = r;
                    }
                }
            } else if (EN_O2 && !even && step == 2) {
                const bf16_t* P0 = (const bf16_t*)(BIG + OD_P); const bf16_t* P1 = (const bf16_t*)(BIG + OD_P + UU); const bf16_t* P2 = (const bf16_t*)(BIG + OD_P + 2 * UU);
                bf16_t* P3 = (bf16_t*)(BIG + OD_P + 3 * UU); bf16_t* VXT = (bf16_t*)(BIG + OD_HV);
                const float* cw = INP(I_CONVW) + (size_t)e * 3 * 3072; const float* cb = INP(I_CONVB) + (size_t)e * 3072;
                LAS bf16_t* TT = (LAS bf16_t*)lds;
                const int nitems = (Mrows / 64) * 16;
                u32x4 Lc[3] = {}, Lp[3] = {}, Ln[3] = {}, Lg = {};
#define O2_GEO(it) const int rt_ = (it) >> 4, ct_ = (it) & 15; const int m0_ = rt_ * 64; const bool lat_ = m0_ < NLAT; \
                const int bsel_ = lat_ ? (m0_ >> 11) : ((m0_ - NLAT) >> 8); const int t0_ = lat_ ? (m0_ & 2047) : ((m0_ - NLAT) & 255); const int seglen_ = lat_ ? 2048 : 256; \
                int tid_o = tid; asm volatile("" : "+v"(tid_o)); const int r_ = tid_o >> 3, c0_ = ct_ * 64 + (tid_o & 7) * 8; const int m_ = m0_ + r_; const int tt_ = t0_ + r_; (void)bsel_; (void)seglen_; (void)tt_; (void)m_; (void)c0_;
#define O2_LOAD(it) do { O2_GEO(it) const bool hp_ = tt_ > 0, hn_ = tt_ < seglen_ - 1; \
                _Pragma("unroll") for (int part = 0; part < 3; ++part) { const bf16_t* pp = ((part == 0) ? P0 : (part == 1) ? P1 : P2) + (size_t)m_ * 1024 + c0_; \
                    Lc[part] = *(const u32x4*)pp; Lp[part] = (u32x4){0u, 0u, 0u, 0u}; Ln[part] = (u32x4){0u, 0u, 0u, 0u}; \
                    if (hp_) Lp[part] = *(const u32x4*)(pp - 1024); if (hn_) Ln[part] = *(const u32x4*)(pp + 1024); } \
                Lg = *(const u32x4*)(P3 + (size_t)m_ * 1024 + c0_); } while (0)
                O2_LOAD(bid < nitems ? bid : 0);
                for (int item = bid; item < nitems; item += G) {
                    O2_GEO(item)
                    {
                        float cv[3][8];
#pragma unroll
                        for (int part = 0; part < 3; ++part) {
                            const u32x4 wc_ = Lc[part], wp_ = Lp[part], wn_ = Ln[part];
                            const float* w0 = cw + part * 1024 + c0_; const float* w1 = cw + 3072 + part * 1024 + c0_; const float* w2 = cw + 6144 + part * 1024 + c0_;
                            const float* bb = cb + part * 1024 + c0_;
#pragma unroll
                            for (int q = 0; q < 8; ++q) {
                                const unsigned a_ = (q < 2) ? wc_.x : (q < 4) ? wc_.y : (q < 6) ? wc_.z : wc_.w;
                                const unsigned p_ = (q < 2) ? wp_.x : (q < 4) ? wp_.y : (q < 6) ? wp_.z : wp_.w;
                                const unsigned n_ = (q < 2) ? wn_.x : (q < 4) ? wn_.y : (q < 6) ? wn_.z : wn_.w;
                                const float cc = (q & 1) ? bfhi(a_) : bflo(a_), pr = (q & 1) ? bfhi(p_) : bflo(p_), nx = (q & 1) ? bfhi(n_) : bflo(n_);
                                cv[part][q] = pr * w0[q] + cc * w1[q] + nx * w2[q] + bb[q];
                            }
                            __builtin_amdgcn_sched_barrier(0);
                        }
                        const u32x4 gw_ = Lg;
                        float vx[8], zz[8];
#pragma unroll
                        for (int q = 0; q < 8; ++q) {
                            const unsigned g_ = (q < 2) ? gw_.x : (q < 4) ? gw_.y : (q < 6) ? gw_.z : gw_.w;
                            const float gg = (q & 1) ? bfhi(g_) : bflo(g_);
                            vx[q] = cv[2][q] * cv[1][q]; zz[q] = cv[0][q] * silu_f(gg);
                        }
                        u32x4 rr; rr.x = pk2(vx[0], vx[1]); rr.y = pk2(vx[2], vx[3]); rr.z = pk2(vx[4], vx[5]); rr.w = pk2(vx[6], vx[7]);
                        *(LAS u32x4*)(TT + r_ * 72 + (tid & 7) * 8) = rr;
                        u32x4 r2; r2.x = pk2(zz[0], zz[1]); r2.y = pk2(zz[2], zz[3]); r2.z = pk2(zz[4], zz[5]); r2.w = pk2(zz[6], zz[7]);
                        *(u32x4*)(P3 + (size_t)m_ * 1024 + c0_) = r2;
                    }
                    if (item + G < nitems) O2_LOAD(item + G);
                    __syncthreads();
                    {
                        const int cc = tid >> 3, tq = tid & 7;
                        unsigned short hv[8];
#pragma unroll
                        for (int i = 0; i < 8; ++i) hv[i] = TT[(8 * tq + i) * 72 + cc];
                        u32x4 w; w.x = hv[0] | ((unsigned)hv[1] << 16); w.y = hv[2] | ((unsigned)hv[3] << 16); w.z = hv[4] | ((unsigned)hv[5] << 16); w.w = hv[6] | ((unsigned)hv[7] << 16);
                        bf16_t* dst = VXT + (lat_ ? (size_t)0 : (size_t)1024 * 8 * 2048) + ((size_t)(ct_ * 64 + cc) * 8 + bsel_) * seglen_ + t0_ + 8 * tq;
                        *(u32x4*)dst = w;
                    }
                    __syncthreads();
                }
#undef O2_LOAD
#undef O2_GEO
            } else if (EN_O3 && !even && step == 3) {
                const bf16_t* VXT = (const bf16_t*)(BIG + OD_HV); bf16_t* YT = (bf16_t*)(BIG + OD_P + UU);
                const bf16_t* GR = (const bf16_t*)(ws + OFF_GR); const bf16_t* GRC = (const bf16_t*)(BIG + OD_GRC);
                const float* bd = INP(I_BIASD) + e * 1024;
                constexpr int TL = 2312;
                LAS unsigned char* Vl = lds; LAS unsigned char* Gl = lds + 36992;
                for (int i = tid; i < 36992 / 16; i += NTHREADS) *(LAS u32x4*)(Vl + 16 * i) = (u32x4){0u, 0u, 0u, 0u};
                __syncthreads();
                const int nmode = (layer == 1) ? 2 : 1;
#ifndef TP_DUP
#define TP_DUP 1
#endif
                for (int tpd = 0; tpd < TP_DUP; ++tpd)
                for (int mode = nmode - 1; mode >= 0; --mode) {
                    const int Lf = mode ? 256 : 2048; const int CS = mode ? 1088 : 8256; const int grl = 2 * Lf + 16;
                    const size_t seg_off = mode ? (size_t)1024 * 8 * 2048 : 0;
                    u32x4 pv[4] = {}, pg0 = {}, pg1 = {};
#define TP_LOAD(cc) do { const bf16_t* vsrc_ = VXT + seg_off + (size_t)(cc) * 8 * Lf; \
                        _Pragma("unroll") for (int i_ = 0; i_ < 4; ++i_) { const int id_ = tid + 512 * i_; if (id_ < Lf) { const int b_ = id_ / (Lf >> 3), t8_ = id_ - b_ * (Lf >> 3); pv[i_] = *(const u32x4*)(vsrc_ + (size_t)b_ * Lf + 8 * t8_); } } \
                        if (tid < (Lf >> 2)) { const unsigned* gsrc_ = (const unsigned*)((mode ? GRC : GR) + (size_t)(cc) * grl) + 4 * tid; pg0 = *(const u32x4*)gsrc_; pg1 = *(const u32x4*)(gsrc_ + 4); } } while (0)
                    if (bid < 1024) TP_LOAD(bid);
                    for (int c = bid; c < 1024; c += G) {
#pragma unroll
                        for (int i_ = 0; i_ < 4; ++i_) { const int id_ = tid + 512 * i_; if (id_ < Lf) { const int b_ = id_ / (Lf >> 3), t8_ = id_ - b_ * (Lf >> 3); *(LAS u32x4*)(Vl + ((b_ * TL + 128 + 8 * t8_) * 2)) = pv[i_]; } }
                        if (tid < (Lf >> 2)) {
                            const u32x4 lo = pg0, hi4 = pg1;
                            const unsigned d0 = lo.x, d1 = lo.y, d2 = lo.z, d3 = lo.w, d4 = hi4.x, d5 = hi4.y, d6 = hi4.z, d7 = hi4.w;
#define AB(h, l) __builtin_amdgcn_alignbit((h), (l), 16)
                            LAS unsigned char* gd = Gl + 16 * tid;
                            *(LAS u32x4*)(gd + 0 * CS) = (u32x4){d4, d5, d6, d7};
                            *(LAS u32x4*)(gd + 1 * CS) = (u32x4){AB(d4, d3), AB(d5, d4), AB(d6, d5), AB(d7, d6)};
                            *(LAS u32x4*)(gd + 2 * CS) = (u32x4){d3, d4, d5, d6};
                            *(LAS u32x4*)(gd + 3 * CS) = (u32x4){AB(d3, d2), AB(d4, d3), AB(d5, d4), AB(d6, d5)};
                            *(LAS u32x4*)(gd + 4 * CS) = (u32x4){d2, d3, d4, d5};
                            *(LAS u32x4*)(gd + 5 * CS) = (u32x4){AB(d2, d1), AB(d3, d2), AB(d4, d3), AB(d5, d4)};
                            *(LAS u32x4*)(gd + 6 * CS) = (u32x4){d1, d2, d3, d4};
                            *(LAS u32x4*)(gd + 7 * CS) = (u32x4){AB(d1, d0), AB(d2, d1), AB(d3, d2), AB(d4, d3)};
#undef AB
                        }
                        if (c + G < 1024) TP_LOAD(c + G);
                        __syncthreads();
                        const bool active = mode ? (wave == 0) : true;
                        if (active) {
                            const int r = lane & 31, hh = lane >> 5, q = r & 7, rho = r >> 3, bb = r >> 2, nn = r & 3;
                            att::f32x16 accA = {}, accB = {};
                            const int T0a = mode ? 0 : wave * 8, T0b = T0a + 4;
                            const int nS = Lf >> 5;
                            const LAS unsigned char* vbase = Vl + ((bb * TL + 128 + 32 * nn + 8 * hh) * 2);
                            const LAS unsigned char* gbase = Gl + q * CS + ((Lf - 8 * rho + 8 * hh) * 2);
#define TP_LD(F, S) do { const int da_ = T0a - (S); \
                                F[0] = *(const LAS bf16x8*)(vbase + (32 * (S)) * 2); F[1] = *(const LAS bf16x8*)(vbase + (32 * (S) + 16) * 2); \
                                F[2] = *(const LAS bf16x8*)(gbase + (-32 * da_) * 2); F[3] = *(const LAS bf16x8*)(gbase + (-32 * da_ + 16) * 2); \
                                F[4] = *(const LAS bf16x8*)(gbase + (-32 * (da_ + 4)) * 2); F[5] = *(const LAS bf16x8*)(gbase + (-32 * (da_ + 4) + 16) * 2); } while (0)
#define TP_MM(F) do { accA = __builtin_amdgcn_mfma_f32_32x32x16_bf16(F[2], F[0], accA, 0, 0, 0); accB = __builtin_amdgcn_mfma_f32_32x32x16_bf16(F[4], F[0], accB, 0, 0, 0); \
                                accA = __builtin_amdgcn_mfma_f32_32x32x16_bf16(F[3], F[1], accA, 0, 0, 0); accB = __builtin_amdgcn_mfma_f32_32x32x16_bf16(F[5], F[1], accB, 0, 0, 0); } while (0)
                            bf16x8 fa[6], fb[6];
                            TP_LD(fa, -3);
                            for (int S0 = -3; ; ) {
                                TP_LD(fb, S0 + 1);
                                __builtin_amdgcn_sched_barrier(0);
                                TP_MM(fa);
                                __builtin_amdgcn_sched_barrier(0);
                                if (++S0 >= nS) break;
                                TP_LD(fa, S0 + 1);
                                __builtin_amdgcn_sched_barrier(0);
                                TP_MM(fb);
                                __builtin_amdgcn_sched_barrier(0);
                                if (++S0 >= nS) break;
                            }
#undef TP_LD
#undef TP_MM
                            const float bias = bd[c];
                            bf16_t* ydst = YT + seg_off + ((size_t)c * 8 + bb) * Lf;
#pragma unroll
                            for (int g = 0; g < 4; ++g) {
                                { const int t = 32 * (T0a + nn) + 8 * g + 4 * hh;
                                  const u32x2 vw = *(const LAS u32x2*)(Vl + ((bb * TL + 128 + t) * 2));
                                  u32x2 o; o.x = pk2(accA[4 * g] + bflo(vw.x) * bias, accA[4 * g + 1] + bfhi(vw.x) * bias); o.y = pk2(accA[4 * g + 2] + bflo(vw.y) * bias, accA[4 * g + 3] + bfhi(vw.y) * bias);
                                  *(u32x2*)(ydst + t) = o; }
                                { const int t = 32 * (T0b + nn) + 8 * g + 4 * hh;
                                  const u32x2 vw = *(const LAS u32x2*)(Vl + ((bb * TL + 128 + t) * 2));
                                  u32x2 o; o.x = pk2(accB[4 * g] + bflo(vw.x) * bias, accB[4 * g + 1] + bfhi(vw.x) * bias); o.y = pk2(accB[4 * g + 2] + bflo(vw.y) * bias, accB[4 * g + 3] + bfhi(vw.y) * bias);
                                  *(u32x2*)(ydst + t) = o; }
                            }
                        }
                        __syncthreads();
                    }
                }
#undef TP_LOAD
            } else if (EN_O3 && !even && ew_hi > ew_lo && bid >= ew_blo) {
                const bf16_t* YT = (const bf16_t*)(BIG + OD_P + UU); const bf16_t* Z = (const bf16_t*)(BIG + OD_P + 3 * UU); bf16_t* U2 = (bf16_t*)(BIG + OD_P);
                LAS bf16_t* TT = (LAS bf16_t*)lds;
                for (int item = bid - ew_blo; item < ((ew_hi - ew_lo) / 64) * 16; item += G - ew_blo) {
                    const int rt = (ew_lo / 64) + (item >> 4), ct = item & 15;
                    const int m0 = rt * 64; const bool lat = m0 < NLAT;
                    const int bsel = lat ? (m0 >> 11) : ((m0 - NLAT) >> 8); const int t0 = lat ? (m0 & 2047) : ((m0 - NLAT) & 255); const int seglen = lat ? 2048 : 256;
                    {
                        const int cc = tid >> 3, tq = tid & 7;
                        const bf16_t* s = YT + (lat ? (size_t)0 : (size_t)1024 * 8 * 2048) + ((size_t)(ct * 64 + cc) * 8 + bsel) * seglen + t0 + 8 * tq;
                        *(LAS u32x4*)(TT + cc * 72 + 8 * tq) = *(const u32x4*)s;
                    }
                    __syncthreads();
                    {
                        const int r = tid >> 3, cg = tid & 7; const int m = m0 + r, c0 = ct * 64 + cg * 8;
                        const u32x4 zw = *(const u32x4*)(Z + (size_t)m * 1024 + c0);
                        float yv[8];
#pragma unroll
                        for (int j = 0; j < 8; ++j) yv[j] = bf2f(TT[(8 * cg + j) * 72 + r]);
                        u32x4 o; o.x = pk2(yv[0] * bflo(zw.x), yv[1] * bfhi(zw.x)); o.y = pk2(yv[2] * bflo(zw.y), yv[3] * bfhi(zw.y));
                        o.z = pk2(yv[4] * bflo(zw.z), yv[5] * bfhi(zw.z)); o.w = pk2(yv[6] * bflo(zw.w), yv[7] * bfhi(zw.w));
                        *(u32x4*)(U2 + (size_t)m * 1024 + c0) = o;
                    }
                    __syncthreads();
                }
            }

            if (EN_NORM && layer == 1 && step == 2) {
                __syncthreads();
                LAS float* scr = (LAS float*)(lds + wave * 8448);
                even_wconv(INP(I_EVWIN) + (size_t)1024 * 3232, nullptr, INP(I_WUQ) + (size_t)256 * 768, INP(I_WUKV) + (size_t)128 * 1024,
                           INP(I_QAN) + 256, INP(I_KVAN) + 128, WIN, WOUT, WUQ, WUKV, gw, NGW, scr, lane);
                __syncthreads();
                filter_items(HDN + (size_t)2048 * 64, INP(I_FWOUT), (bf16_t*)(BIG + OD_GRC), 256, bid, G, (LAS float*)(lds + 8 * 8448), (LAS float*)(lds + 8 * 8448 + 4096), tid);
            }
            if (EN_NORM && layer >= 1 && step == tail0) {
                __syncthreads();
                LAS float* scr = (LAS float*)(lds + wave * 8448);
                const float* wout = (even ? INP(I_EVWOUT) : INP(I_ODWOUT)) + (size_t)e * 1024 * 1024;
                for (int it = gw; it < 32 * 16; it += NGW) { const int nb = it / 16, kb = it % 16; transpose_item(wout, 1024, nb * 32, true, WOUT, 1024, nb * 32, kb * 64, scr, lane); }
            }
            if (EN_NORM && layer < 3 && step == tail0) {
                __syncthreads();
                LAS float* sht = (LAS float*)(lds + 73728);
                const float* mdn = MODS + (size_t)(layer + 1) * 9 * 3072;
                for (int i = tid; i < 9 * 1024; i += NTHREADS) sht[i] = mdn[(i >> 10) * 3072 + (i & 1023)];
                __syncthreads();
                const int Nn = even ? 4096 : 3328;
                float* BV = (float*)(ws + OFF_BIAS);
                for (int n = gw; n < Nn; n += NGW) {
                    const bf16_t* wrow = WIN + (size_t)n * 1024 + 8 * lane;
                    const u32x4 wa = *(const u32x4*)wrow, wb = *(const u32x4*)(wrow + 512);
                    const f32x4 a0 = {bflo(wa.x), bfhi(wa.x), bflo(wa.y), bfhi(wa.y)}, a1 = {bflo(wa.z), bfhi(wa.z), bflo(wa.w), bfhi(wa.w)};
                    const f32x4 b0 = {bflo(wb.x), bfhi(wb.x), bflo(wb.y), bfhi(wb.y)}, b1 = {bflo(wb.z), bfhi(wb.z), bflo(wb.w), bfhi(wb.w)};
                    float mine = 0.f;
#pragma unroll
                    for (int r = 0; r < 9; ++r) {
                        const LAS f32x4* sp = (const LAS f32x4*)(sht + r * 1024 + 8 * lane);
                        const f32x4 p = (sp[0] * a0 + sp[1] * a1) + (sp[128] * b0 + sp[129] * b1);
                        const float tot = red64((p.x + p.y) + (p.z + p.w));
                        if (lane == r) mine = tot;
                    }
                    if (lane < 9) BV[(size_t)lane * 4096 + n] = mine;
                }
            }

            for (int jb = 0; EN_GR && jb < nroute; ++jb) {
                pg8::Gemm g; pg8::EpiRoute E; E.remap96 = 0; E.ssq = nullptr; E.bias = (const float*)(ws + OFF_BIAS);
                if (step == 1 && layer >= 1) E.ssq = BONUS;
                if (even && step == 1) {
                    g = pg8::Gemm{(const bf16_t*)(BIG + EV_E), WIN, MTOT, 3328, 1024, 1024};
                    E.base[0] = (bf16_t*)(BIG + EV_A); E.ld[0] = 1792; E.base[1] = (bf16_t*)(BIG + EV_B); E.ld[1] = 1024; E.base[2] = (bf16_t*)(BIG + EV_F); E.ld[2] = 512;
                    E.base[3] = E.base[2]; E.ld[3] = 512; E.t0 = 7; E.t1 = 11; E.t2 = 64;
                } else if (even && jb == 0) {
                    g = pg8::Gemm{(const bf16_t*)(BIG + EV_F), WUQ, MTOT, 768, 256, 512};
                    E.base[0] = (bf16_t*)(BIG + EV_C); E.ld[0] = 768; E.base[1] = E.base[0]; E.ld[1] = 768; E.base[2] = E.base[0]; E.ld[2] = 768; E.base[3] = E.base[0]; E.ld[3] = 768;
                    E.t0 = 64; E.t1 = 64; E.t2 = 64;
                } else if (even) {
                    g = pg8::Gemm{(const bf16_t*)(BIG + EV_F) + 256, WUKV, MTOT, 1024, 256, 512};
                    E.base[0] = (bf16_t*)(BIG + EV_G); E.ld[0] = 768; E.base[1] = (bf16_t*)(BIG + EV_D); E.ld[1] = 512; E.base[2] = E.base[1]; E.ld[2] = 512; E.base[3] = E.base[1]; E.ld[3] = 512;
                    E.t0 = 2; E.t1 = 64; E.t2 = 64; E.remap96 = 1;
                } else {
                    g = pg8::Gemm{(const bf16_t*)(BIG + OD_H2), WIN, Mrows, 4096, 1024, 1024};
                    E.base[0] = (bf16_t*)(BIG + OD_P); E.base[1] = (bf16_t*)(BIG + OD_P + UU); E.base[2] = (bf16_t*)(BIG + OD_P + 2 * UU); E.base[3] = (bf16_t*)(BIG + OD_P + 3 * UU);
                    E.ld[0] = E.ld[1] = E.ld[2] = E.ld[3] = 1024; E.t0 = 4; E.t1 = 8; E.t2 = 12;
                }
                pg8::StaticOrder S; S.init(g.M, g.N, Gl, bidl);
                pg8::gemm_phase<pg8::EpiRoute, pg8::StaticOrder, true, true>(lds, g, S, E, tid);
            }
            if (EN_GS && resid) {
                pg8::Gemm g{(const bf16_t*)(BIG + (even ? EV_D : OD_P)) + (size_t)rs_rowoff * 1024, WOUT, rs_M, 1024, 1024, 1024};
                pg8::EpiResid E{xsrc, a.out, xcsrc, XC, mods, rs_rowoff, nullptr, INP(I_NORMG) + (layer + 1) * 1024, mods + 9 * 3072, BONUS};
                if (layer < 3) E.hn = (bf16_t*)(BIG + (even ? OD_H2 : EV_E));
                pg8::StaticOrder S; S.init(g.M, g.N, rs_Gl, rs_bidl);
                pg8::gemm_phase<pg8::EpiResid, pg8::StaticOrder, true, true>(lds, g, S, E, tid);
            }
#ifdef PG_BLOCK
            if (layer == 0 && step == 4 && bid == PG_BLOCK) pg_acc = __builtin_amdgcn_s_memrealtime() - pg_t0;
#endif
            if (split && step < 4) { if (bid >= nscan) xcd_barrier(xb2, tid); }
            else xcd_barrier(xb, tid);
        }
    }
#ifdef PG_BLOCK
    if (bid == PG_BLOCK) { const unsigned long long t2 = __builtin_amdgcn_s_memrealtime(); while (__builtin_amdgcn_s_memrealtime() - t2 < pg_acc) __builtin_amdgcn_s_sleep(8); }
#endif
#ifdef PROBE_LO
    if (PROBE_HI >= NPHASES && bid == 0) {
        volatile unsigned long long* ts = (volatile unsigned long long*)(a.ws + OFF_PSTAMP);
        const unsigned long long t2 = __builtin_amdgcn_s_memrealtime(); const unsigned long long t1 = ts[1];
        while (__builtin_amdgcn_s_memrealtime() - t2 < t2 - t1) __builtin_amdgcn_s_sleep(8);
    }
#endif
}

extern "C" void kernel_launch(void* const* d_in, const int* in_sizes, int n_in, void* d_out, int out_size,
                              void* d_ws, size_t ws_size, hipStream_t stream) {
    static int grid_blocks = 0;
    if (!grid_blocks) {
        int dev = 0, cus = 0, per_cu = 0;
        (void)hipGetDevice(&dev);
        (void)hipDeviceGetAttribute(&cus, hipDeviceAttributeMultiprocessorCount, dev);
        (void)hipFuncSetAttribute((const void*)mega_fwd, hipFuncAttributeMaxDynamicSharedMemorySize, LDS_BYTES);
        (void)hipOccupancyMaxActiveBlocksPerMultiprocessor(&per_cu, (const void*)mega_fwd, NTHREADS, LDS_BYTES);
        if (per_cu < 1) per_cu = 1;
        if (per_cu > 1) per_cu = 1;
        grid_blocks = cus * per_cu;
        if (n_in != 37 || ws_size < 268435456) fprintf(stderr, "kernel_launch: unexpected n_in %d / ws %zu\n", n_in, ws_size);
    }
    Args a{};
    for (int i = 0; i < 37 && i < n_in; ++i) a.in[i] = (const float*)d_in[i];
    a.out = (float*)d_out; a.ws = (unsigned char*)d_ws;
    (void)hipMemsetAsync((unsigned char*)d_ws + OFF_BAR, 0, 32768, stream);
    void* args[] = {&a};
    hipError_t e = hipLaunchCooperativeKernel((const void*)mega_fwd, dim3(grid_blocks), dim3(NTHREADS), args, LDS_BYTES, stream);
    if (e != hipSuccess) fprintf(stderr, "cooperative launch failed: %s (grid %d)\n", hipGetErrorString(e), grid_blocks);
}
```

```cpp
#include <hip/hip_runtime.h>
#include <hip/hip_cooperative_groups.h>
#include <cstdio>
#include <cstdint>
namespace cg = cooperative_groups;

#define LAS __attribute__((address_space(3)))
#define GAS __attribute__((address_space(1)))
typedef unsigned short bf16_t;
typedef short bf16x8 __attribute__((ext_vector_type(8)));
typedef float f32x4 __attribute__((ext_vector_type(4)));
typedef unsigned u32x4 __attribute__((ext_vector_type(4)));
typedef unsigned u32x2 __attribute__((ext_vector_type(2)));
typedef float f32x2 __attribute__((ext_vector_type(2)));

#ifndef EN_P0
#define EN_P0 1
#endif
#ifndef EN_NORM
#define EN_NORM 1
#endif
#ifndef EN_E2
#define EN_E2 1
#endif
#ifndef EN_E4
#define EN_E4 1
#endif
#ifndef EN_E5
#define EN_E5 1
#endif
#ifndef EN_SCAN
#define EN_SCAN 1
#endif
#ifndef EN_ATTN
#define EN_ATTN 1
#endif
#ifndef EN_E6
#define EN_E6 1
#endif
#ifndef EN_O2
#define EN_O2 1
#endif
#ifndef EN_O3
#define EN_O3 1
#endif
#ifndef EN_GR
#define EN_GR 1
#endif
#ifndef EN_GS
#define EN_GS 1
#endif
constexpr int NB = 8, SEQ = 2048, DM = 1024, CTXL = 256;
constexpr int NLAT = NB * SEQ;
constexpr int NCTX = NB * CTXL;
constexpr int MTOT = NLAT + NCTX;
constexpr int NTHREADS = 512, NWAVES = 8;
constexpr int LDS_BYTES = 147456;
constexpr float NORM_EPS = 1e-6f;

constexpr size_t UU = (size_t)MTOT * 1024 * 2;
constexpr size_t MiB = 1u << 20;
constexpr size_t OFF_MODS = 0;
constexpr size_t OFF_BONUS = MiB / 2;
constexpr size_t OFF_HDN = 2 * MiB;
constexpr size_t OFF_BAR = 3 * MiB + MiB / 4;
constexpr size_t OFF_PSTAMP = OFF_BAR + 65536;
constexpr size_t OFF_WTS = 3 * MiB + MiB / 2;
constexpr size_t OFF_XC = 14 * MiB + MiB / 2;
constexpr size_t OFF_BIG = 22 * MiB + MiB / 2;
constexpr size_t EV_A = 0;
constexpr size_t EV_B = EV_A + UU * 7 / 4;
constexpr size_t EV_C = EV_B + UU;
constexpr size_t EV_D = EV_C + UU * 3 / 4;
constexpr size_t EV_F = EV_D + UU / 2;
constexpr size_t EV_E = EV_F + UU / 2;
constexpr size_t EV_G = EV_E + UU;
constexpr size_t EV_END = EV_G + UU * 3 / 4;
constexpr size_t OD_P = 0;
constexpr size_t OD_HV = 4 * UU;
constexpr size_t OD_GRC = 5 * UU;
constexpr size_t OD_END = OD_GRC + (size_t)1024 * 528 * 2;
constexpr size_t OFF_GR = OFF_BIG + EV_END;
static_assert(OFF_GR + (size_t)1024 * 4112 * 2 <= 268435456 && OFF_BIG + OD_END <= OFF_GR, "ws map");
constexpr size_t W_IN = 0;
constexpr size_t W_OUT = (size_t)4096 * 1024 * 2;
constexpr size_t W_UQ = W_OUT + (size_t)1024 * 1024 * 2;
constexpr size_t W_UKV = W_UQ + (size_t)768 * 256 * 2;
static_assert(W_UKV + (size_t)1024 * 256 * 2 <= 11 * MiB, "weights region");

#ifdef OLD_CVT
__device__ __forceinline__ unsigned f2bf(float f) { unsigned u = __builtin_bit_cast(unsigned, f); return (u + 0x7fffu + ((u >> 16) & 1u)) >> 16; }
__device__ __forceinline__ unsigned pk2(float lo, float hi) { return f2bf(lo) | (f2bf(hi) << 16); }
#else
typedef __bf16 hwbf16x2 __attribute__((ext_vector_type(2)));
__device__ __forceinline__ unsigned pk2(float lo, float hi) { const f32x2 v = {lo, hi}; return __builtin_bit_cast(unsigned, __builtin_convertvector(v, hwbf16x2)); }
__device__ __forceinline__ unsigned f2bf(float f) { return pk2(f, 0.f) & 0xffffu; }
#endif
__device__ __forceinline__ float bf2f(unsigned h) { return __builtin_bit_cast(float, (h & 0xffffu) << 16); }
__device__ __forceinline__ float bflo(unsigned w) { return __builtin_bit_cast(float, w << 16); }
__device__ __forceinline__ float bfhi(unsigned w) { return __builtin_bit_cast(float, w & 0xffff0000u); }
__device__ __forceinline__ float shx(float v, int m, int lane) { return __builtin_bit_cast(float, __builtin_amdgcn_ds_bpermute((lane ^ m) << 2, __builtin_bit_cast(int, v))); }
__device__ __forceinline__ float bcast(float v, int src) { return __builtin_bit_cast(float, __builtin_amdgcn_readlane(__builtin_bit_cast(int, v), src)); }
__device__ __forceinline__ float wave_sum(float v, int lane) {
#pragma unroll
    for (int o = 1; o < 64; o <<= 1) v += shx(v, o, lane);
    return v;
}
__device__ __forceinline__ float sum8(float v, int lane) { v += shx(v, 1, lane); v += shx(v, 2, lane); v += shx(v, 4, lane); return v; }
__device__ __forceinline__ float silu_f(float x) { return x / (1.0f + __expf(-x)); }
template <int CTRL> __device__ __forceinline__ float dpp_f(float v) { return __builtin_bit_cast(float, __builtin_amdgcn_update_dpp(0, __builtin_bit_cast(int, v), CTRL, 0xF, 0xF, true)); }
__device__ __forceinline__ float red16(float x) { x += dpp_f<0xB1>(x); x += dpp_f<0x4E>(x); x += dpp_f<0x141>(x); x += dpp_f<0x140>(x); return x; }
__device__ __forceinline__ float red64(float x) { x = red16(x);
    const float s0 = bcast(x, 0), s1 = bcast(x, 16), s2 = bcast(x, 32), s3 = bcast(x, 48); return (s0 + s1) + (s2 + s3); }

__device__ __forceinline__ float sigmoid_f(float x) { return 1.0f / (1.0f + __expf(-x)); }

namespace pg8 {
constexpr int BM = 256, BK = 64, HALF = 128, HTB = HALF * BK * 2, STAGE_BYTES = 8 * HTB, NXCD = 8, WGM = 8;
__host__ __device__ __forceinline__ int lds_byte(int r, int c) { const int st = (r >> 4) * 2 + (c >> 5), rr = r & 15, cc = c & 31, ob = rr * 64 + cc * 2; return st * 1024 + (ob ^ (((ob >> 9) & 1) << 5)); }
__host__ __device__ __forceinline__ void stage_rc(int b, int& R, int& C) { const int st = b / 1024, sb = b % 1024, swz = sb ^ (((sb >> 9) & 1) << 5); R = (st >> 1) * 16 + swz / 64; C = (st & 1) * 32 + (swz % 64) / 2; }
__host__ __device__ __forceinline__ int perm32(int rho) { const int n = rho >> 4, i = rho & 15; return 8 * (i >> 2) + 4 * n + (i & 3); }
struct Unit { int pm, pn; };
struct Gemm { const bf16_t* A; const bf16_t* Bt; int M, N, K, lda; };
struct StaticOrder {
    int nM, nN, nwg, G, c;
    __host__ __device__ void init(int M, int N, int G_, int c_) { nM = M / BM; nN = N / BM; nwg = nM * nN; G = G_; c = c_; }
    __host__ __device__ bool next(int i, Unit& u) const {
        const long L = (long)i * G + c; if (L >= nwg) return false;
        int wgid = (int)L; { const int q = nwg / NXCD, r = nwg % NXCD, xcd = wgid % NXCD, off = wgid / NXCD; wgid = (xcd < r ? xcd * (q + 1) : r * (q + 1) + (xcd - r) * q) + off; }
        const int nig = WGM * nN, gid = wgid / nig, fm = gid * WGM, gsz = (nM - fm) < WGM ? (nM - fm) : WGM;
        u.pm = fm + ((wgid % nig) % gsz); u.pn = (wgid % nig) / gsz; return true;
    }
    __device__ __forceinline__ void a_ready(const Unit&) const {}
    __device__ __forceinline__ void done(const Unit&) const {}
};

struct EpiRoute {
    static constexpr bool PERM = true, AFTER_DRAIN = false;
    bf16_t* base[4]; int ld[4]; int t0, t1, t2;
    int remap96;
    __device__ __forceinline__ void operator()(const f32x4 (&acc)[2][2][4][2], const Unit& u, int wr, int wc, int fr, int fq) const {
        const int row0 = u.pm * BM + wr * 64 + fr;
        bf16_t* b; int ldc, colt;
        if (u.pn < t0) { b = base[0]; ldc = ld[0]; colt = u.pn * BM; }
        else if (u.pn < t1) { b = base[1]; ldc = ld[1]; colt = (u.pn - t0) * BM; }
        else if (u.pn < t2) { b = base[2]; ldc = ld[2]; colt = (u.pn - t1) * BM; }
        else { b = base[3]; ldc = ld[3]; colt = (u.pn - t2) * BM; }
        const int col0 = colt + wc * 32 + 8 * fq;
#pragma unroll
        for (int ai = 0; ai < 2; ++ai)
#pragma unroll
            for (int m = 0; m < 4; ++m) {
                const int row = row0 + ai * HALF + m * 16;
                {
                    bf16_t* rowp = b + (size_t)row * ldc + col0;
#pragma unroll
                    for (int bj = 0; bj < 2; ++bj) {
                        const f32x4 v0 = acc[ai][bj][m][0], v1 = acc[ai][bj][m][1];
                        u32x4 w; w.x = pk2(v0[0], v0[1]); w.y = pk2(v0[2], v0[3]); w.z = pk2(v1[0], v1[1]); w.w = pk2(v1[2], v1[3]);
                        int coff = bj * HALF;
                        if (remap96 && u.pn < t0) { const int n = col0 + bj * HALF; coff = (n >> 6) * 96 + (n & 63) - col0; }
                        *(u32x4*)(rowp + coff) = w;
                    }
                }
            }
    }
};
struct EpiResid {
    static constexpr bool PERM = false, AFTER_DRAIN = false;
    const void* xsrc; void* xdst; const float* xcsrc; float* xcdst; const float* mods;
    int rowoff;
    int src_bf16, dst_bf16;
    __device__ __forceinline__ void operator()(const f32x4 (&acc)[2][2][4][2], const Unit& u, int wr, int wc, int fr_, int fq_) const {
        int fr = fr_, fq = fq_; asm volatile("" : "+v"(fr), "+v"(fq));
        const int rbase = rowoff + u.pm * BM;
        const bool lat = rbase < NLAT; const int b = lat ? (rbase >> 11) : 8;
        const int colw = u.pn * BM + wc * 32, col0 = colw + 4 * fq;
        const int colh = colw + ((fq & 1) ? 16 : 0) + 8 * (fq >> 1);
        f32x4 g[2][2];
#pragma unroll
        for (int bj = 0; bj < 2; ++bj)
#pragma unroll
            for (int n = 0; n < 2; ++n) g[bj][n] = *(const f32x4*)(mods + b * 3072 + 2048 + col0 + bj * HALF + n * 16);
        const bool sb = lat && src_bf16, db = lat && dst_bf16;
        const float* srcf = lat ? (const float*)xsrc + (size_t)rbase * DM : xcsrc + (size_t)(rbase - NLAT) * DM;
        float* dstf = lat ? (float*)xdst + (size_t)rbase * DM : xcdst + (size_t)(rbase - NLAT) * DM;
        const bf16_t* srch = (const bf16_t*)xsrc + (size_t)rbase * DM; bf16_t* dsth = (bf16_t*)xdst + (size_t)rbase * DM;
#pragma unroll
        for (int ai = 0; ai < 2; ++ai)
#pragma unroll
            for (int m = 0; m < 4; ++m) {
                const int rl = wr * 64 + fr + ai * HALF + m * 16;
#pragma unroll
                for (int bj = 0; bj < 2; ++bj) {
                    f32x4 x0, x1;
                    if (sb) {
                        const u32x4 w = *(const u32x4*)(srch + (size_t)rl * DM + colh + bj * HALF);
                        const auto r0 = __builtin_amdgcn_permlane16_swap(w.x, w.z, false, false);
                        const auto r1 = __builtin_amdgcn_permlane16_swap(w.y, w.w, false, false);
                        x0 = (f32x4){bflo(r0[0]), bfhi(r0[0]), bflo(r1[0]), bfhi(r1[0])}; x1 = (f32x4){bflo(r0[1]), bfhi(r0[1]), bflo(r1[1]), bfhi(r1[1])};
                    } else {
                        x0 = *(const f32x4*)(srcf + (size_t)rl * DM + col0 + bj * HALF); x1 = *(const f32x4*)(srcf + (size_t)rl * DM + col0 + bj * HALF + 16);
                    }
                    const f32x4 y0 = x0 + g[bj][0] * acc[ai][bj][m][0], y1 = x1 + g[bj][1] * acc[ai][bj][m][1];
                    if (db) {
                        const auto r0 = __builtin_amdgcn_permlane16_swap(pk2(y0.x, y0.y), pk2(y1.x, y1.y), false, false);
                        const auto r1 = __builtin_amdgcn_permlane16_swap(pk2(y0.z, y0.w), pk2(y1.z, y1.w), false, false);
                        u32x4 w; w.x = r0[0]; w.y = r1[0]; w.z = r0[1]; w.w = r1[1];
                        *(u32x4*)(dsth + (size_t)rl * DM + colh + bj * HALF) = w;
                    } else {
                        *(f32x4*)(dstf + (size_t)rl * DM + col0 + bj * HALF) = y0; *(f32x4*)(dstf + (size_t)rl * DM + col0 + bj * HALF + 16) = y1;
                    }
                }
            }
    }
};

template <class Epi, class Sched, bool ALIGN_EPI = false, bool SP2 = false>
__device__ __forceinline__ void gemm_phase(LAS unsigned char* lds, const Gemm g, const Sched& S, const Epi& E, const int tid) {
    const int wid = __builtin_amdgcn_readfirstlane(tid >> 6), lane = tid & 63, wr = wid >> 2, wc = wid & 3, fr = lane & 15, fq = lane >> 4;
    const int K = g.K, nt = K / BK;
    unsigned voffA[2], voffB[2];
#pragma unroll
    for (int i = 0; i < 2; ++i) { int R, C; stage_rc(tid * 16 + i * 8192, R, C); const int Rb = Epi::PERM ? ((R & ~31) + perm32(R & 31)) : R;
        voffA[i] = (unsigned)(R * g.lda + C) * 2u; voffB[i] = (unsigned)(Rb * K + C) * 2u; }
    const size_t kstep = (size_t)(BK * 2);
    const size_t hstepB = (size_t)HALF * K * 2, hstepA = (size_t)HALF * g.lda * 2;
    const size_t tstepB = 2 * hstepB, tstepA = 2 * hstepA;
    const unsigned ldsw = (unsigned)wid * 1024u;
    const int aoff = lds_byte(wr * 64 + fr, fq * 8), boff = lds_byte(wc * 32 + fr, fq * 8);
#define PG8_SA(b, h) (((b) * 2 + (h)) * HTB)
#define PG8_SB(b, h) ((4 + (b) * 2 + (h)) * HTB)
#define PG8_STAGE(bufoff, gbase, voff) do { _Pragma("unroll") for (int _i = 0; _i < 2; ++_i) \
        __builtin_amdgcn_global_load_lds((const unsigned*)((const char*)(gbase) + (voff)[_i]), (LAS unsigned*)(lds + (bufoff) + ldsw + _i * 8192), 16, 0, 0); } while (0)
#define PG8_LDA(dst, b, h) do { _Pragma("unroll") for (int m = 0; m < 4; ++m) _Pragma("unroll") for (int k = 0; k < 2; ++k) dst[m][k] = *(const LAS bf16x8*)(lds + PG8_SA(b, h) + aoff + m * 2048 + k * 1024); } while (0)
#define PG8_LDB(dst, b, h) do { _Pragma("unroll") for (int n = 0; n < 2; ++n) _Pragma("unroll") for (int k = 0; k < 2; ++k) dst[n][k] = *(const LAS bf16x8*)(lds + PG8_SB(b, h) + boff + n * 2048 + k * 1024); } while (0)
#define PG8_MMA(ai, bj, At, Bt) do { __builtin_amdgcn_s_setprio(1); _Pragma("unroll") for (int m = 0; m < 4; ++m) _Pragma("unroll") for (int n = 0; n < 2; ++n) _Pragma("unroll") for (int k = 0; k < 2; ++k) \
        acc[ai][bj][m][n] = __builtin_amdgcn_mfma_f32_16x16x32_bf16(Bt[n][k], At[m][k], acc[ai][bj][m][n], 0, 0, 0); __builtin_amdgcn_s_setprio(0); } while (0)
#define PG8_WAIT_V(n) asm volatile("s_waitcnt vmcnt(" #n ")" ::: "memory")
#define PG8_WAIT_L(n) asm volatile("s_waitcnt lgkmcnt(" #n ")" ::: "memory")
#define PG8_BAR __builtin_amdgcn_s_barrier()
#define PG8_SCHED __builtin_amdgcn_sched_barrier(0)
    Unit cur, nxt; int ui = 0;
    if (!S.next(0, cur)) return;
    f32x4 acc[2][2][4][2];
#pragma unroll
    for (int a = 0; a < 2; ++a)
#pragma unroll
        for (int b = 0; b < 2; ++b)
#pragma unroll
            for (int m = 0; m < 4; ++m)
#pragma unroll
                for (int n = 0; n < 2; ++n) acc[a][b][m][n] = (f32x4){0.f, 0.f, 0.f, 0.f};
    bf16x8 At[4][2], B0[2][2], B1[2][2];
    const char* cA = (const char*)g.A + (size_t)cur.pm * tstepA; const char* cB = (const char*)g.Bt + (size_t)cur.pn * tstepB;
    S.a_ready(cur);
    if constexpr (SP2) {
        PG8_STAGE(PG8_SB(0, 0), cB, voffB); PG8_STAGE(PG8_SB(0, 1), cB + hstepB, voffB); PG8_STAGE(PG8_SA(0, 0), cA, voffA); PG8_STAGE(PG8_SA(0, 1), cA + hstepA, voffA);
        if (wr == 1) PG8_BAR;
        PG8_WAIT_V(2); PG8_BAR;
        PG8_STAGE(PG8_SB(1, 0), cB + kstep, voffB); PG8_STAGE(PG8_SA(1, 0), cA + kstep, voffA); PG8_STAGE(PG8_SB(1, 1), cB + hstepB + kstep, voffB);
        PG8_WAIT_V(6); PG8_BAR;
    } else {
        PG8_STAGE(PG8_SB(0, 0), cB, voffB); PG8_STAGE(PG8_SA(0, 0), cA, voffA); PG8_STAGE(PG8_SB(0, 1), cB + hstepB, voffB); PG8_STAGE(PG8_SA(0, 1), cA + hstepA, voffA);
        if (wr == 1) PG8_BAR;
        PG8_WAIT_V(4); PG8_BAR;
        PG8_STAGE(PG8_SB(1, 0), cB + kstep, voffB); PG8_STAGE(PG8_SA(1, 0), cA + kstep, voffA); PG8_STAGE(PG8_SB(1, 1), cB + hstepB + kstep, voffB);
        PG8_WAIT_V(6); PG8_BAR;
    }
    for (;;) {
        const bool has_next = S.next(ui + 1, nxt);
        const char* nA = has_next ? (const char*)g.A + (size_t)nxt.pm * tstepA : cA; const char* nB = has_next ? (const char*)g.Bt + (size_t)nxt.pn * tstepB : cB;
        for (int t = 0; t < nt; t += 2) {
            const bool last = (t == nt - 2);
            const char* a1 = cA + (size_t)(t + 1) * kstep;
            const char* a2 = last ? nA : cA + (size_t)(t + 2) * kstep; const char* b2 = last ? nB : cB + (size_t)(t + 2) * kstep;
            const char* a3 = a2 + kstep; const char* b3 = b2 + kstep;
            if (last && has_next) S.a_ready(nxt);
            if constexpr (SP2) {
            PG8_LDB(B0, 0, 0); PG8_LDB(B1, 0, 1); PG8_SCHED; PG8_LDA(At, 0, 0); PG8_STAGE(PG8_SA(1, 1), a1 + hstepA, voffA);
            PG8_WAIT_V(8); PG8_WAIT_L(0); PG8_BAR; PG8_MMA(0, 0, At, B0); PG8_MMA(0, 1, At, B1); PG8_BAR; PG8_SCHED;
            PG8_LDA(At, 0, 1); PG8_STAGE(PG8_SB(0, 0), b2, voffB); PG8_STAGE(PG8_SB(0, 1), b2 + hstepB, voffB); PG8_STAGE(PG8_SA(0, 0), a2, voffA);
            PG8_WAIT_V(8); PG8_WAIT_L(0); PG8_BAR; PG8_MMA(1, 0, At, B0); PG8_MMA(1, 1, At, B1); PG8_BAR; PG8_SCHED;
            PG8_LDB(B0, 1, 0); PG8_LDB(B1, 1, 1); PG8_SCHED; PG8_LDA(At, 1, 0); PG8_STAGE(PG8_SA(0, 1), a2 + hstepA, voffA);
            PG8_WAIT_V(8); PG8_WAIT_L(0); PG8_BAR; PG8_MMA(0, 0, At, B0); PG8_MMA(0, 1, At, B1); PG8_BAR; PG8_SCHED;
            PG8_LDA(At, 1, 1); PG8_STAGE(PG8_SB(1, 0), b3, voffB); PG8_STAGE(PG8_SB(1, 1), b3 + hstepB, voffB); PG8_STAGE(PG8_SA(1, 0), a3, voffA);
            PG8_WAIT_V(8); PG8_WAIT_L(0); PG8_BAR; PG8_MMA(1, 0, At, B0); PG8_MMA(1, 1, At, B1); PG8_BAR; PG8_SCHED;
            } else {
            PG8_LDB(B0, 0, 0); PG8_SCHED; PG8_LDA(At, 0, 0); PG8_STAGE(PG8_SA(1, 1), a1 + hstepA, voffA);
            PG8_WAIT_L(8); PG8_BAR; PG8_WAIT_L(0); PG8_MMA(0, 0, At, B0); PG8_BAR; PG8_SCHED;
            PG8_LDB(B1, 0, 1); PG8_STAGE(PG8_SB(0, 0), b2, voffB);
            PG8_BAR; PG8_WAIT_L(0); PG8_MMA(0, 1, At, B1); PG8_BAR;
            PG8_LDA(At, 0, 1); PG8_STAGE(PG8_SA(0, 0), a2, voffA);
            PG8_BAR; PG8_WAIT_L(0); PG8_MMA(1, 0, At, B0); PG8_BAR; PG8_SCHED;
            PG8_STAGE(PG8_SB(0, 1), b2 + hstepB, voffB);
            PG8_WAIT_V(6); PG8_BAR; PG8_MMA(1, 1, At, B1); PG8_BAR;
            PG8_LDB(B0, 1, 0); PG8_SCHED; PG8_LDA(At, 1, 0); PG8_STAGE(PG8_SA(0, 1), a2 + hstepA, voffA);
            PG8_WAIT_L(8); PG8_BAR; PG8_WAIT_L(0); PG8_MMA(0, 0, At, B0); PG8_BAR; PG8_SCHED;
            PG8_LDB(B1, 1, 1); PG8_STAGE(PG8_SB(1, 0), b3, voffB);
            PG8_BAR; PG8_WAIT_L(0); PG8_MMA(0, 1, At, B1); PG8_BAR;
            PG8_LDA(At, 1, 1); PG8_STAGE(PG8_SA(1, 0), a3, voffA);
            PG8_BAR; PG8_WAIT_L(0); PG8_MMA(1, 0, At, B0); PG8_BAR; PG8_SCHED;
            PG8_STAGE(PG8_SB(1, 1), b3 + hstepB, voffB);
            PG8_WAIT_V(6); PG8_BAR; PG8_MMA(1, 1, At, B1); PG8_BAR;
            }
        }
        if constexpr (ALIGN_EPI) { if (wr == 0) PG8_BAR; }
        if constexpr (!Epi::AFTER_DRAIN) { E(acc, cur, wr, wc, fr, fq); S.done(cur); }
        if (!has_next) break;
#pragma unroll
        for (int a = 0; a < 2; ++a)
#pragma unroll
            for (int b = 0; b < 2; ++b)
#pragma unroll
                for (int m = 0; m < 4; ++m)
#pragma unroll
                    for (int n = 0; n < 2; ++n) acc[a][b][m][n] = (f32x4){0.f, 0.f, 0.f, 0.f};
        cur = nxt; cA = nA; cB = nB; ++ui;
        if constexpr (ALIGN_EPI) { if (wr == 1) PG8_BAR; }
    }
    PG8_WAIT_V(0);
    if constexpr (!ALIGN_EPI) { if (wr == 0) PG8_BAR; }
    PG8_BAR;
#undef PG8_SA
#undef PG8_SB
#undef PG8_STAGE
#undef PG8_LDA
#undef PG8_LDB
#undef PG8_MMA
#undef PG8_WAIT_V
#undef PG8_WAIT_L
#undef PG8_BAR
#undef PG8_SCHED
}
}


namespace att {
using f32x16 = __attribute__((ext_vector_type(16))) float;
using s16x4 = __attribute__((ext_vector_type(4))) short;
constexpr int NW = 8, QBLK = 32, KVBLK = 64, LDQ = 768, LDK = 768, LDV = 512;
constexpr float SCALE = 0.10206207261596575f;
constexpr float THR = 8.f;
constexpr int SHM_V = 16384, SHM_K = 16384, SHM_ATTN = 2 * SHM_V + 2 * SHM_K + NW * 64 * 4;
#define KSWZ(row, colB) ((row) * 256 + ((colB) ^ (((row) & 7) << 4)))
#define SBAR() __builtin_amdgcn_sched_barrier(0)
__device__ __forceinline__ int crow(int r, int hi) { return (r & 3) + 8 * (r >> 2) + 4 * hi; }
__device__ __forceinline__ unsigned cvtpk(float lo, float hi) { unsigned r; asm volatile("v_cvt_pk_bf16_f32 %0, %1, %2" : "=v"(r) : "v"(lo), "v"(hi)); return r; }
__device__ __forceinline__ void partialSM(f32x16& p0, f32x16& p1, float& m_reg, float& mn, float& alpha) {
  constexpr float C = SCALE * 1.4426950408889634f;
  float pmax = p0[0];
#pragma unroll
  for (int r = 1; r < 16; ++r) pmax = fmaxf(pmax, p0[r]);
#pragma unroll
  for (int r = 0; r < 16; ++r) pmax = fmaxf(pmax, p1[r]);
  { auto rr = __builtin_amdgcn_permlane32_swap(__float_as_uint(pmax), __float_as_uint(pmax), false, false);
    pmax = fmaxf(__uint_as_float(rr[0]), __uint_as_float(rr[1])); }
  if (__builtin_expect(__all(pmax - m_reg <= THR / SCALE), 1)) { mn = m_reg; alpha = 1.f; }
  else { mn = fmaxf(m_reg, pmax); alpha = __builtin_amdgcn_exp2f((m_reg - mn) * C); m_reg = mn; }
  float mnC = -mn * C;
#pragma unroll
  for (int r = 0; r < 16; ++r) p0[r] = fmaf(p0[r], C, mnC);
#pragma unroll
  for (int r = 0; r < 16; ++r) p1[r] = fmaf(p1[r], C, mnC);
#pragma unroll
  for (int r = 0; r < 16; ++r) p0[r] = __builtin_amdgcn_exp2f(p0[r]);
}
__device__ __forceinline__ void finishSM(f32x16& p0, f32x16& p1, float alpha, float& l_reg, bf16x8& pa0, bf16x8& pa1, bf16x8& pa2, bf16x8& pa3) {
#pragma unroll
  for (int r = 0; r < 16; ++r) p1[r] = __builtin_amdgcn_exp2f(p1[r]);
  float ps = 0;
#pragma unroll
  for (int r = 0; r < 16; ++r) ps += p0[r];
#pragma unroll
  for (int r = 0; r < 16; ++r) ps += p1[r];
  { auto rr = __builtin_amdgcn_permlane32_swap(__float_as_uint(ps), __float_as_uint(ps), false, false);
    ps = __uint_as_float(rr[0]) + __uint_as_float(rr[1]); }
  l_reg = l_reg * alpha + ps;
#define PK4(P, BASE, OUT) do { unsigned a0 = cvtpk(P[BASE + 0], P[BASE + 1]), a1 = cvtpk(P[BASE + 2], P[BASE + 3]);   \
    unsigned b0 = cvtpk(P[BASE + 4], P[BASE + 5]), b1 = cvtpk(P[BASE + 6], P[BASE + 7]);                              \
    auto r0 = __builtin_amdgcn_permlane32_swap(a0, b0, false, false); auto r1 = __builtin_amdgcn_permlane32_swap(a1, b1, false, false); \
    u32x4 w = {r0[0], r1[0], r0[1], r1[1]}; OUT = __builtin_bit_cast(bf16x8, w); } while (0)
  PK4(p0, 0, pa0); PK4(p0, 8, pa1); PK4(p1, 0, pa2); PK4(p1, 8, pa3);
#undef PK4
}
__device__ __forceinline__ void qkt(f32x16& p0, f32x16& p1, const LAS char* Ks, const bf16x8* qr, int r32, int hi) {
  p0 = f32x16{}; p1 = f32x16{};
#pragma unroll
  for (int d0 = 0; d0 < 6; ++d0) { const int cb = (d0 * 16 + hi * 8) * 2;
    const bf16x8 b0 = *(const LAS bf16x8*)(Ks + KSWZ(r32, cb));
    const bf16x8 b1 = *(const LAS bf16x8*)(Ks + KSWZ(32 + r32, cb));
    p0 = __builtin_amdgcn_mfma_f32_32x32x16_bf16(b0, qr[d0], p0, 0, 0, 0);
    p1 = __builtin_amdgcn_mfma_f32_32x32x16_bf16(b1, qr[d0], p1, 0, 0, 0); }
}
__device__ __forceinline__ int v_st(int k, int c) { const int kk = (k & ~0xC) | ((k & 4) << 1) | ((k & 8) >> 1); return ((kk >> 3) * 4 + (c >> 5)) * 512 + ((kk & 7) * 32 + (c & 31)) * 2; }
__device__ __forceinline__ int v_rd_base(int lane) { return ((lane & 3) << 3) | (((lane >> 2) & 3) << 6) | (((lane >> 4) & 1) << 5) | (((lane >> 5) & 1) << 8); }
constexpr int v_rd_off(int d0, int ks, int half) { return d0 * 512 + ks * 4096 + half * 2048; }
template <int OFF> __device__ __forceinline__ s16x4 tr_read(int vb) {
  s16x4 r; asm volatile("ds_read_b64_tr_b16 %0, %1 offset:%2" : "=&v"(r) : "v"(vb), "i"(OFF) : "memory"); return r;
}
template <int D0> __device__ __forceinline__ void pv_one(f32x16& od, int vb, bf16x8 pa0, bf16x8 pa1, bf16x8 pa2, bf16x8 pa3) {
  const s16x4 l0 = tr_read<v_rd_off(D0, 0, 0)>(vb), h0 = tr_read<v_rd_off(D0, 0, 1)>(vb), l1 = tr_read<v_rd_off(D0, 1, 0)>(vb), h1 = tr_read<v_rd_off(D0, 1, 1)>(vb);
  const s16x4 l2 = tr_read<v_rd_off(D0, 2, 0)>(vb), h2 = tr_read<v_rd_off(D0, 2, 1)>(vb), l3 = tr_read<v_rd_off(D0, 3, 0)>(vb), h3 = tr_read<v_rd_off(D0, 3, 1)>(vb);
  asm volatile("s_waitcnt lgkmcnt(0)" ::: "memory"); SBAR();
#define PK(L, H) (bf16x8){L[0], L[1], L[2], L[3], H[0], H[1], H[2], H[3]}
  od = __builtin_amdgcn_mfma_f32_32x32x16_bf16(pa0, PK(l0, h0), od, 0, 0, 0);
  od = __builtin_amdgcn_mfma_f32_32x32x16_bf16(pa1, PK(l1, h1), od, 0, 0, 0);
  od = __builtin_amdgcn_mfma_f32_32x32x16_bf16(pa2, PK(l2, h2), od, 0, 0, 0);
  od = __builtin_amdgcn_mfma_f32_32x32x16_bf16(pa3, PK(l3, h3), od, 0, 0, 0);
#undef PK
}
__device__ __forceinline__ void pv_d0(f32x16* o, int vb, bf16x8 pa0, bf16x8 pa1, bf16x8 pa2, bf16x8 pa3) {
  pv_one<0>(o[0], vb, pa0, pa1, pa2, pa3); pv_one<1>(o[1], vb, pa0, pa1, pa2, pa3);
}
__device__ __forceinline__ void attn_body(const bf16_t* Qb, const bf16_t* Kh, const bf16_t* Vh, bf16_t* Ob, int rlat, int rctx, int nlat, int NT, LAS char* lds, int tid) {
  const int wid = tid >> 6, lane = tid & 63, r32 = lane & 31, hi = lane >> 5;
  LAS char* V_lds = lds; LAS char* K_lds = lds + 2 * SHM_V;
  LAS float* wsl = (LAS float*)(lds + 2 * SHM_V + 2 * SHM_K) + wid * 64; LAS float* li_l = wsl; LAS float* al_l = wsl + 32;
  float m_reg = -1e30f, l_reg = 0; f32x16 o[2] = {}; bf16x8 qr[6];
  const bf16_t* Qw = Qb + (long)(wid * QBLK + r32) * LDQ + hi * 8;
#pragma unroll
  for (int d0 = 0; d0 < 6; ++d0) qr[d0] = *(const bf16x8*)(Qw + d0 * 16);
  const int cid1 = 512 + (tid & 255);
  const int kr0 = tid / 12, kc0 = (tid % 12) * 8, kr1 = cid1 / 12, kc1 = (cid1 % 12) * 8, vr = tid >> 3, vc = (tid & 7) * 8;
  const int vst0 = v_st(vr, vc), kst0 = KSWZ(kr0, kc0 * 2), kst1 = KSWZ(kr1, kc1 * 2);
  const int vb0 = (int)(unsigned)(unsigned long)V_lds + v_rd_base(lane);
  struct { bf16x8 vs0, ks0, ks1; } sr_[2];
#define TROW(j) ((j) < nlat ? rlat + 64 * (j) : rctx + 64 * ((j) - nlat))
#define SLOAD(i, j) do { const long rb_ = TROW(j); sr_[i].vs0 = *(const bf16x8*)(Vh + (rb_ + vr) * LDV + vc); \
    sr_[i].ks0 = *(const bf16x8*)(Kh + (rb_ + kr0) * LDK + kc0); sr_[i].ks1 = *(const bf16x8*)(Kh + (rb_ + kr1) * LDK + kc1); } while (0)
#define SWRITE(b, i) do { *(LAS bf16x8*)(V_lds + (b) * SHM_V + vst0) = sr_[i].vs0; \
    *(LAS bf16x8*)(K_lds + (b) * SHM_K + kst0) = sr_[i].ks0; *(LAS bf16x8*)(K_lds + (b) * SHM_K + kst1) = sr_[i].ks1; } while (0)
#define SWAIT() asm volatile("s_waitcnt vmcnt(3)" ::: "memory")
#define RESC(a) do { if (__any((a) < 1.f)) { if (hi == 0) al_l[r32] = (a); asm volatile("s_waitcnt lgkmcnt(0)" ::: "memory"); \
    _Pragma("unroll") for (int d = 0; d < 2; ++d) _Pragma("unroll") for (int r = 0; r < 16; ++r) o[d][r] *= al_l[crow(r, hi)]; } } while (0)
  f32x16 pA0, pA1, pB0, pB1; float mnA, mnB, alA, alB; bf16x8 pa0, pa1, pa2, pa3;
  constexpr int SE = 0, SO = 1;
  SLOAD(SE, 0); asm volatile("s_waitcnt vmcnt(0)" ::: "memory"); SWRITE(0, SE); __syncthreads();
  qkt(pA0, pA1, K_lds, qr, r32, hi); partialSM(pA0, pA1, m_reg, mnA, alA);
  SLOAD(SO, 1); if (2 < NT) SLOAD(SE, 2);
  SWAIT(); SWRITE(1, SO); __syncthreads();
  for (int j = 1; j + 1 < NT; j += 2) {
    SBAR(); qkt(pB0, pB1, K_lds + SHM_K, qr, r32, hi);
    finishSM(pA0, pA1, alA, l_reg, pa0, pa1, pa2, pa3); SBAR();
    SLOAD(SO, j + 2); SBAR();
    pv_d0(o, vb0, pa0, pa1, pa2, pa3); partialSM(pB0, pB1, m_reg, mnB, alB);
    __syncthreads(); SWAIT(); SWRITE(0, SE);
    RESC(alB); __syncthreads();
    SBAR(); qkt(pA0, pA1, K_lds, qr, r32, hi);
    finishSM(pB0, pB1, alB, l_reg, pa0, pa1, pa2, pa3); SBAR();
    if (j + 3 < NT) SLOAD(SE, j + 3); SBAR();
    pv_d0(o, vb0 + SHM_V, pa0, pa1, pa2, pa3); partialSM(pA0, pA1, m_reg, mnA, alA);
    __syncthreads(); SWAIT(); SWRITE(1, SO);
    RESC(alA); __syncthreads();
  }
  SBAR(); qkt(pB0, pB1, K_lds + SHM_K, qr, r32, hi);
  finishSM(pA0, pA1, alA, l_reg, pa0, pa1, pa2, pa3); SBAR();
  pv_d0(o, vb0, pa0, pa1, pa2, pa3); partialSM(pB0, pB1, m_reg, mnB, alB);
  __syncthreads(); RESC(alB);
  finishSM(pB0, pB1, alB, l_reg, pa0, pa1, pa2, pa3); SBAR();
  pv_d0(o, vb0 + SHM_V, pa0, pa1, pa2, pa3);
  if (hi == 0) li_l[r32] = l_reg; asm volatile("s_waitcnt lgkmcnt(0)" ::: "memory");
  float rli[16];
#pragma unroll
  for (int r = 0; r < 16; ++r) rli[r] = __builtin_amdgcn_rcpf(li_l[crow(r, hi)]);
  bf16_t* Ow = Ob + (long)(wid * QBLK) * LDQ;
#pragma unroll
  for (int r = 0; r < 16; ++r) { const int orow = crow(r, hi);
#pragma unroll
    for (int d0 = 0; d0 < 2; ++d0) Ow[(long)orow * LDQ + d0 * 32 + r32] = (bf16_t)f2bf(o[d0][r] * rli[r]); }
  __syncthreads();
#undef TROW
#undef SLOAD
#undef SWRITE
#undef SWAIT
#undef RESC
}
}


#define XB_TMO      128
#define XB_XCNT(j)  (256  + 64 * (j))
#define XB_XSUB(j)  (1280 + 64 * (j))
#define XB_XGEN(j)  (2304 + 64 * (j))
#define XB_TOP      3328
#define XB_TOPGEN   3392
#define XCD_BAR_WORDS 3456
#define XB_SPIN_CAP (1u << 22)
__device__ __forceinline__ unsigned xb_ld(unsigned* p)              { return __hip_atomic_load(p, __ATOMIC_RELAXED, __HIP_MEMORY_SCOPE_AGENT); }
__device__ __forceinline__ unsigned xb_add(unsigned* p, unsigned v) { return __hip_atomic_fetch_add(p, v, __ATOMIC_RELAXED, __HIP_MEMORY_SCOPE_AGENT); }
__device__ __forceinline__ unsigned xb_xcc_id() { return (unsigned)__builtin_amdgcn_s_getreg((3 << 11) | 20) & 0xFu; }
#define XB_SPIN(cond, bar) do { unsigned _sp = 0; while (cond) { __builtin_amdgcn_s_sleep(1); \
    if ((++_sp & 255u) == 0u) { if (xb_ld(&(bar)[XB_TMO])) break; if (_sp > XB_SPIN_CAP) { atomicAdd(&(bar)[XB_TMO], 1u); break; } } } } while (0)
struct XcdBarrier { unsigned* bar; unsigned x; volatile LAS unsigned* st; unsigned nmemb; };
__device__ __forceinline__ XcdBarrier xcd_barrier_post(unsigned* bar, volatile LAS unsigned* st, int tid, unsigned nmemb) {
    XcdBarrier b; b.bar = bar; b.x = xb_xcc_id(); b.st = st; b.nmemb = nmemb;
    if (tid == 0) (void)xb_add(&bar[XB_XCNT(b.x)], 1u);
    return b;
}
__device__ __forceinline__ void xcd_barrier_complete(unsigned* bar, unsigned x, unsigned& nloc, unsigned& nx, unsigned G) {
    unsigned sum, cnt, mine, sp = 0u;
    for (;;) {
        sum = 0u; cnt = 0u; mine = 0u;
#pragma unroll
        for (unsigned j = 0; j < 16; ++j) { const unsigned c = xb_ld(&bar[XB_XCNT(j)]); sum += c; cnt += (c > 0u) ? 1u : 0u; mine = (j == x) ? c : mine; }
        if (sum == G) break;
        __builtin_amdgcn_s_sleep(1);
        if ((++sp & 255u) == 0u) { if (xb_ld(&bar[XB_TMO])) break; if (sp > XB_SPIN_CAP) { atomicAdd(&bar[XB_TMO], 1u); break; } }
    }
    nloc = mine > 0u ? mine : 1u; nx = cnt > 0u ? cnt : 1u;
}
__device__ __forceinline__ void xcd_barrier(const XcdBarrier& b, int tid) {
    asm volatile("s_waitcnt vmcnt(0)" ::: "memory");
    __syncthreads();
    if (tid == 0) {
        unsigned* bar = b.bar;
        __builtin_amdgcn_s_waitcnt(0);
        unsigned nloc = b.st[0], nx = b.st[1];
        if (nloc == 0u) { xcd_barrier_complete(bar, b.x, nloc, nx, b.nmemb); b.st[0] = nloc; b.st[1] = nx; }
        const unsigned old = xb_add(&bar[XB_XSUB(b.x)], 1u);
        const unsigned gen = old / nloc;
        if (old + 1u == (gen + 1u) * nloc) {
            __builtin_amdgcn_fence(__ATOMIC_RELEASE, "agent");
            asm volatile("s_waitcnt vmcnt(0)" ::: "memory");
            const unsigned og = xb_add(&bar[XB_TOP], 1u);
            const unsigned tg = og / nx;
            if (og + 1u == (tg + 1u) * nx) xb_add(&bar[XB_TOPGEN], 1u);
            else XB_SPIN(xb_ld(&bar[XB_TOPGEN]) == tg, bar);
            __builtin_amdgcn_fence(__ATOMIC_ACQUIRE, "agent");
            xb_add(&bar[XB_XGEN(b.x)], 1u);
            asm volatile("s_waitcnt vmcnt(0)" ::: "memory");
        } else {
            XB_SPIN(xb_ld(&bar[XB_XGEN(b.x)]) == gen, bar);
            __builtin_amdgcn_fence(__ATOMIC_ACQUIRE, "agent");
            asm volatile("s_waitcnt vmcnt(0)" ::: "memory");
        }
    }
    __syncthreads();
}

struct Args { const float* in[37]; float* out; unsigned char* ws; };

enum { I_X = 0, I_C, I_CTX, I_CCTX, I_MODW, I_MODB, I_NORMG, I_EVWIN, I_EVWOUT, I_QAN, I_WUQ, I_KVAN, I_WUKV, I_QN, I_KN,
       I_MUP, I_MUN, I_W0, I_WUP, I_A0, I_AUP, I_KK, I_KA, I_RK, I_LNW, I_LNB, I_ODWIN, I_ODWOUT, I_CONVW, I_CONVB, I_BIASD,
       I_FW1, I_FB1, I_FW2, I_FB2, I_FWOUT, I_FREQ };

#define INP(i) (a.in[(i) + opq0])
__device__ __forceinline__ void transpose_item(const float* W, int ldw, int src_col0, bool valid, bf16_t* WT, int Kd, int dst_row0, int k0, LAS float* scr, int lane, const float* kscale = nullptr) {
    if (valid) {
        float wv[32];
#pragma unroll
        for (int i = 0; i < 32; ++i) { const int kk = 2 * i + (lane >> 5); wv[i] = __builtin_nontemporal_load(W + (size_t)(k0 + kk) * ldw + src_col0 + (lane & 31)); }
#pragma unroll
        for (int i = 0; i < 32; ++i) { const int kk = 2 * i + (lane >> 5); const float ks = kscale ? kscale[k0 + kk] : 1.0f; scr[kk * 33 + (lane & 31)] = wv[i] * ks; }
    } else {
#pragma unroll 8
        for (int i = 0; i < 32; ++i) { const int kk = 2 * i + (lane >> 5); scr[kk * 33 + (lane & 31)] = 0.f; }
    }
    asm volatile("s_waitcnt vmcnt(0) lgkmcnt(0)" ::: "memory");
    const int c = lane & 7;
#pragma unroll
    for (int j = 0; j < 4; ++j) { const int n = (lane >> 3) + 8 * j; const LAS float* s = scr + (8 * c) * 33 + n;
        u32x4 o; o.x = pk2(s[0 * 33], s[1 * 33]); o.y = pk2(s[2 * 33], s[3 * 33]); o.z = pk2(s[4 * 33], s[5 * 33]); o.w = pk2(s[6 * 33], s[7 * 33]);
        *(u32x4*)(WT + (size_t)(dst_row0 + n) * Kd + k0 + 8 * c) = o; }
    asm volatile("s_waitcnt lgkmcnt(0)" ::: "memory");
}

__device__ __forceinline__ void norm_row(const float* xrow, const float* g, const float* md, bf16_t* orow, int lane) {
    const f32x4* xr = (const f32x4*)xrow + lane;
    f32x4 v[4]; float s = 0.f;
#pragma unroll
    for (int j = 0; j < 4; ++j) { v[j] = xr[64 * j]; s += (v[j].x * v[j].x + v[j].y * v[j].y) + (v[j].z * v[j].z + v[j].w * v[j].w); }
    const float rstd = 1.0f / sqrtf(wave_sum(s, lane) * (1.f / DM) + NORM_EPS);
    u32x2* o8 = (u32x2*)orow + lane;
#pragma unroll
    for (int j = 0; j < 4; ++j) {
        const f32x4 gg = ((const f32x4*)g)[lane + 64 * j], sh = ((const f32x4*)md)[lane + 64 * j], sc = ((const f32x4*)(md + 1024))[lane + 64 * j];
        const f32x4 y = (v[j] * rstd) * gg * (sc + 1.0f) + sh;
        u32x2 w; w.x = pk2(y.x, y.y); w.y = pk2(y.z, y.w); o8[64 * j] = w;
    }
}


__device__ __forceinline__ void filter_items(const float* hd, const float* fwout_e, bf16_t* go, int Lf, int it0, int itstep, LAS float* fred, LAS float* fcache  , int tid) {
    for (int it = it0; it < 256; it += itstep) {
        const int cg0 = it * 4;
        const int grl = 2 * Lf + 16;
        const int ch = tid & 3, dir = (tid >> 2) & 1, lg = tid >> 3, c = cg0 + ch;
        const float* wo = fwout_e + dir * 1024 + c;
        float wreg[64];
#pragma unroll
        for (int j = 0; j < 64; ++j) wreg[j] = wo[(size_t)j * 2048];
        const float dstart = -15.350567286626973f, dstop = -3.0701134573253946f;
        const float delta = fabsf(dstart + (float)c * ((dstop - dstart) / 1023.0f));
        const float invL1 = 1.0f / (float)(Lf - 1);
        float asum = 0.f;
        for (int l = lg; l < Lf; l += 64) {
            const f32x4* hp = (const f32x4*)(hd + (size_t)l * 64);
            float f = 0.f;
#pragma unroll
            for (int j4 = 0; j4 < 16; ++j4) { const f32x4 h4 = hp[j4]; f += h4.x * wreg[4 * j4] + h4.y * wreg[4 * j4 + 1] + h4.z * wreg[4 * j4 + 2] + h4.w * wreg[4 * j4 + 3]; }
            f *= expf(-((float)l * invL1) * delta);
            fcache[(dir * 4 + ch) * Lf + l] = f;
            if (!(dir == 1 && l == 0)) asum += fabsf(f);
        }
        fred[tid] = asum;
        __syncthreads();
        if (tid < 4) { float s = 0.f; for (int q = 0; q < 128; ++q) s += fred[q * 4 + tid]; fred[512 + tid] = s; }
        __syncthreads();
        const float inv = 1.0f / fred[512 + ch];
        bf16_t* grow = go + (size_t)c * grl;
        for (int l = lg; l < Lf; l += 64) {
            const float f = fcache[(dir * 4 + ch) * Lf + l];
            if (!(dir == 1 && l == 0)) grow[8 + Lf + (dir ? l : -l)] = (bf16_t)f2bf(f * inv);
        }
        if (tid < 4 * 17) { const int c2 = cg0 + (tid & 3), k = tid >> 2; bf16_t* g2 = go + (size_t)c2 * grl;
            g2[(k < 9) ? k : (2 * Lf + 8 + (k - 9))] = 0; }
        __syncthreads();
    }
}

__device__ __forceinline__ void mods_items(const float* pc, const float* pcctx, const float* modw, const float* modb, float* modsout, int item0, int nitems, int it0, int itstep,
                                           LAS float* sc  , LAS float* red  , int tid) {
    bool have_silu = false;
    for (int it = it0; it < nitems; it += itstep) {
        if (!have_silu) {
            for (int i = tid; i < 9 * 1024; i += NTHREADS) { const float cv = (i < 8192) ? pc[i] : pcctx[i - 8192]; sc[i] = silu_f(cv); }
            have_silu = true;
        }
        __syncthreads();
        const int layer = (item0 + it) / 48, cg0 = ((item0 + it) % 48) * 64, q4 = tid & 15, kg = tid >> 4;
        const float* W = modw + (size_t)layer * 1024 * 3072 + cg0 + 4 * q4;
        f32x4 acc[9];
#pragma unroll
        for (int r = 0; r < 9; ++r) acc[r] = (f32x4){0.f, 0.f, 0.f, 0.f};
#pragma unroll 1
        for (int k = kg * 32; k < kg * 32 + 32; k += 4) {
            const f32x4 w0 = __builtin_nontemporal_load((const f32x4*)(W + (size_t)k * 3072)), w1 = __builtin_nontemporal_load((const f32x4*)(W + (size_t)(k + 1) * 3072)), w2 = __builtin_nontemporal_load((const f32x4*)(W + (size_t)(k + 2) * 3072)), w3 = __builtin_nontemporal_load((const f32x4*)(W + (size_t)(k + 3) * 3072));
#pragma unroll
            for (int r = 0; r < 9; ++r) { const f32x4 s4 = *(const LAS f32x4*)(sc + r * 1024 + k); acc[r] += (w0 * s4.x + w1 * s4.y) + (w2 * s4.z + w3 * s4.w); }
        }
#pragma unroll
        for (int r = 0; r < 9; ++r) *(LAS f32x4*)(red + (kg * 9 + r) * 64 + 4 * q4) = acc[r];
        __syncthreads();
        for (int idx = tid; idx < 9 * 64; idx += NTHREADS) {
            const int r = idx >> 6, c2 = idx & 63; float s = 0.f;
#pragma unroll 8
            for (int q = 0; q < 32; ++q) s += red[(q * 9 + r) * 64 + c2];
            modsout[((size_t)layer * 9 + r) * 3072 + cg0 + c2] = s + modb[layer * 3072 + cg0 + c2];
        }
    }
}

__device__ __forceinline__ void mlp_positions(float* hdn, const float* pfreq, const float* pfb1, const float* pfw1, const float* pfw2, const float* pfb2, int it, int n, int lane) {
    int o, Lf, pos0;
    if (it < 2048) { o = 0; Lf = 2048; pos0 = it; } else if (it < 2304) { o = 0; Lf = 256; pos0 = it - 2048; } else { o = 1; Lf = 2048; pos0 = it - 2304; }
    float* outp = hdn + (size_t)it * 64;
    float z0, z1, z2;
    {
        float zz[3];
#pragma unroll
        for (int q = 0; q < 3; ++q) {
            const float fpos = (float)(pos0 + q), tt = fpos / (float)(Lf - 1);
            zz[q] = 0.f;
            if (lane == 0) zz[q] = tt;
            else if (lane < 33) {
                const int bi = (lane - 1) & 15;
                const float band = 1e-4f + (float)bi * ((15.0f - 1e-4f) / 15.0f);
                const float ang = fpos * (6.283185307179586f / (float)Lf) * band;
                zz[q] = (lane < 17) ? cosf(ang) : -sinf(ang);
            }
        }
        z0 = zz[0]; z1 = zz[1]; z2 = zz[2];
    }
    const float fr = pfreq[o * 64 + lane];
    const float b1 = pfb1[o * 64 + lane];
    float h0 = b1, h1 = b1, h2 = b1;
    const float* w1 = pfw1 + (size_t)o * 33 * 64;
#pragma unroll 11
    for (int i = 0; i < 33; ++i) { const float w = w1[i * 64 + lane]; h0 += bcast(z0, i) * w; h1 += bcast(z1, i) * w; h2 += bcast(z2, i) * w; }
    h0 = sinf(fr * h0); h1 = sinf(fr * h1); h2 = sinf(fr * h2);
    for (int jj = 0; jj < 2; ++jj) {
        const float* w2 = pfw2 + ((size_t)o * 2 + jj) * 64 * 64;
        const float b2 = pfb2[(o * 2 + jj) * 64 + lane];
        float g0 = b2, g1 = b2, g2 = b2;
#pragma unroll 16
        for (int i = 0; i < 64; ++i) { const float w = w2[i * 64 + lane]; g0 += bcast(h0, i) * w; g1 += bcast(h1, i) * w; g2 += bcast(h2, i) * w; }
        h0 = sinf(fr * g0); h1 = sinf(fr * g1); h2 = sinf(fr * g2);
    }
    outp[lane] = h0;
    if (n > 1) outp[64 + lane] = h1;
    if (n > 2) outp[128 + lane] = h2;
}
__device__ __forceinline__ void mlp_run(float* hdn, const float* pfreq, const float* pfb1, const float* pfw1, const float* pfw2, const float* pfb2, int p, int cnt, int lane) {
    constexpr int NPOS = 2048 + 256 + 2048;
    while (cnt > 0 && p < NPOS) {
        const int send = (p < 2048) ? 2048 : (p < 2304) ? 2304 : NPOS;
        int n = cnt; if (n > send - p) n = send - p;
        mlp_positions(hdn, pfreq, pfb1, pfw1, pfw2, pfb2, p, n, lane); p += n; cnt -= n;
    }
}

__device__ __forceinline__ void even_wconv(const float* win, const float* wout, const float* wuq, const float* wukv, const float* qan, const float* kvan,
                                           bf16_t* WIN_, bf16_t* WOUT_, bf16_t* WUQ_, bf16_t* WUKV_, int it0, int itstep, LAS float* scr, int lane) {
    constexpr int N1f = 104 * 16, N2f = 32 * 16, N3f = 24 * 4, N4f = 32 * 4;
    const int N1 = win ? N1f : 0, N2 = wout ? N2f : 0, N3 = wuq ? N3f : 0, N4 = wukv ? N4f : 0;
    for (int it = it0; it < N1 + N2 + N3 + N4; it += itstep) {
        int r = it;
        if (r < N1) { const int nb = r / 16, kb = r % 16; const int d0 = nb * 32; int s0;
            if (d0 < 1792) s0 = 416 + d0; else if (d0 < 2816) s0 = 2208 + (d0 - 1792); else if (d0 < 3072) s0 = d0 - 2816; else if (d0 < 3232) s0 = 256 + (d0 - 3072); else s0 = -1;
            transpose_item(win, 3232, s0, s0 >= 0, WIN_, 1024, d0, kb * 64, scr, lane); continue; }
        r -= N1;
        if (r < N2) { const int nb = r / 16, kb = r % 16; transpose_item(wout, 1024, nb * 32, true, WOUT_, 1024, nb * 32, kb * 64, scr, lane); continue; }
        r -= N2;
        if (r < N3) { const int nb = r / 4, kb = r % 4; transpose_item(wuq, 768, nb * 32, true, WUQ_, 256, nb * 32, kb * 64, scr, lane, qan); continue; }
        r -= N3;
        { const int nb = r / 4, kb = r % 4; const int d0 = nb * 32; const int hh = (d0 & 511) >> 6, dd = d0 & 63; const int s0 = hh * 128 + dd + ((d0 >= 512) ? 64 : 0);
          transpose_item(wukv, 1024, s0, kb < 2, WUKV_, 256, d0, kb * 64, scr, lane, kvan); }
    }
}

__device__ __forceinline__ void norm_row2(const float* xrow0, const float* xrow1, const float* g, const float* md, bf16_t* orow, int lane) {
    const f32x4* xr0 = (const f32x4*)xrow0 + lane; const f32x4* xr1 = (const f32x4*)xrow1 + lane;
    f32x4 v0[4], v1[4]; float s0 = 0.f, s1 = 0.f;
#pragma unroll
    for (int j = 0; j < 4; ++j) { v0[j] = __builtin_nontemporal_load(xr0 + 64 * j); v1[j] = __builtin_nontemporal_load(xr1 + 64 * j); }
#pragma unroll
    for (int j = 0; j < 4; ++j) { s0 += (v0[j].x * v0[j].x + v0[j].y * v0[j].y) + (v0[j].z * v0[j].z + v0[j].w * v0[j].w); s1 += (v1[j].x * v1[j].x + v1[j].y * v1[j].y) + (v1[j].z * v1[j].z + v1[j].w * v1[j].w); }
    const float r0 = 1.0f / sqrtf(wave_sum(s0, lane) * (1.f / DM) + NORM_EPS), r1 = 1.0f / sqrtf(wave_sum(s1, lane) * (1.f / DM) + NORM_EPS);
    u32x2* o0 = (u32x2*)orow + lane; u32x2* o1 = (u32x2*)(orow + DM) + lane;
#pragma unroll
    for (int j = 0; j < 4; ++j) {
        const f32x4 gg = ((const f32x4*)g)[lane + 64 * j], sh = ((const f32x4*)md)[lane + 64 * j], sc = ((const f32x4*)(md + 1024))[lane + 64 * j];
        const f32x4 gs = gg * (sc + 1.0f);
        const f32x4 y0 = (v0[j] * r0) * gs + sh, y1 = (v1[j] * r1) * gs + sh;
        u32x2 w; w.x = pk2(y0.x, y0.y); w.y = pk2(y0.z, y0.w); o0[64 * j] = w;
        w.x = pk2(y1.x, y1.y); w.y = pk2(y1.z, y1.w); o1[64 * j] = w;
    }
}

__device__ __forceinline__ void norm_row2_h(const bf16_t* xrow0, const bf16_t* xrow1, const float* g, const float* md, bf16_t* orow, int lane) {
    const u32x4* xr0 = (const u32x4*)xrow0 + lane; const u32x4* xr1 = (const u32x4*)xrow1 + lane;
    u32x4 w0[2], w1[2]; float s0 = 0.f, s1 = 0.f;
#pragma unroll
    for (int j = 0; j < 2; ++j) { w0[j] = __builtin_nontemporal_load(xr0 + 64 * j); w1[j] = __builtin_nontemporal_load(xr1 + 64 * j); }
    float v0[2][8], v1[2][8];
#pragma unroll
    for (int j = 0; j < 2; ++j) {
        v0[j][0] = bflo(w0[j].x); v0[j][1] = bfhi(w0[j].x); v0[j][2] = bflo(w0[j].y); v0[j][3] = bfhi(w0[j].y); v0[j][4] = bflo(w0[j].z); v0[j][5] = bfhi(w0[j].z); v0[j][6] = bflo(w0[j].w); v0[j][7] = bfhi(w0[j].w);
        v1[j][0] = bflo(w1[j].x); v1[j][1] = bfhi(w1[j].x); v1[j][2] = bflo(w1[j].y); v1[j][3] = bfhi(w1[j].y); v1[j][4] = bflo(w1[j].z); v1[j][5] = bfhi(w1[j].z); v1[j][6] = bflo(w1[j].w); v1[j][7] = bfhi(w1[j].w);
#pragma unroll
        for (int q = 0; q < 8; ++q) { s0 += v0[j][q] * v0[j][q]; s1 += v1[j][q] * v1[j][q]; }
    }
    const float r0 = 1.0f / sqrtf(wave_sum(s0, lane) * (1.f / DM) + NORM_EPS), r1 = 1.0f / sqrtf(wave_sum(s1, lane) * (1.f / DM) + NORM_EPS);
    u32x4* o0 = (u32x4*)orow + lane; u32x4* o1 = (u32x4*)(orow + DM) + lane;
#pragma unroll
    for (int j = 0; j < 2; ++j) {
        float y0[8], y1[8];
#pragma unroll
        for (int h = 0; h < 2; ++h) {
            const int c4 = 2 * (lane + 64 * j) + h;
            const f32x4 gg = ((const f32x4*)g)[c4], sh = ((const f32x4*)md)[c4], sc = ((const f32x4*)(md + 1024))[c4];
            const f32x4 gs = gg * (sc + 1.0f);
#pragma unroll
            for (int q = 0; q < 4; ++q) { y0[4 * h + q] = (v0[j][4 * h + q] * r0) * gs[q] + sh[q]; y1[4 * h + q] = (v1[j][4 * h + q] * r1) * gs[q] + sh[q]; }
        }
        u32x4 w; w.x = pk2(y0[0], y0[1]); w.y = pk2(y0[2], y0[3]); w.z = pk2(y0[4], y0[5]); w.w = pk2(y0[6], y0[7]); o0[64 * j] = w;
        w.x = pk2(y1[0], y1[1]); w.y = pk2(y1[2], y1[3]); w.z = pk2(y1[4], y1[5]); w.w = pk2(y1[6], y1[7]); o1[64 * j] = w;
    }
}

__global__ void __launch_bounds__(NTHREADS, 2) mega_fwd(Args a) {
    extern __shared__ __attribute__((aligned(16))) unsigned char lds_raw[];
    cg::grid_group grid = cg::this_grid();
    LAS unsigned char* lds = (LAS unsigned char*)lds_raw;
    const int G = gridDim.x, bid = blockIdx.x;
    const int NGW = G * NWAVES;
    XcdBarrier xb, xb2;
    {
        int tid0 = threadIdx.x; asm volatile("" : "+v"(tid0));
        volatile LAS unsigned* stw = (volatile LAS unsigned*)(lds + LDS_BYTES - 16);
        if (tid0 < 4) stw[tid0] = 0u;
        __syncthreads();
        xb = xcd_barrier_post((unsigned*)(a.ws + OFF_BAR), stw, tid0, (unsigned)G);
        const int nscan0 = (G >= 256) ? 128 : (G / 2);
        if (bid >= nscan0) xb2 = xcd_barrier_post((unsigned*)(a.ws + OFF_BAR + 16384), stw + 2, tid0, (unsigned)(G - nscan0));
        else { xb2.bar = (unsigned*)(a.ws + OFF_BAR + 16384); xb2.x = 0; xb2.st = stw + 2; xb2.nmemb = 1; }
    }
#define PHASE_LOCALS \
    int tid = threadIdx.x; asm volatile("" : "+v"(tid)); \
    const int lane = tid & 63, wave = __builtin_amdgcn_readfirstlane(tid >> 6); \
    const int gw = bid * NWAVES + wave; \
    int opq0 = 0; asm volatile("" : "+s"(opq0)); \
    unsigned char* ws = a.ws + opq0; \
    (void)lane; (void)wave; (void)gw; (void)ws; (void)opq0;
#define MODS ((float*)(ws + OFF_MODS))
#define BONUS ((float*)(ws + OFF_BONUS))
#define HDN ((float*)(ws + OFF_HDN))
#define XC ((float*)(ws + OFF_XC))
#define BIG (ws + OFF_BIG)
#define WIN ((bf16_t*)(ws + OFF_WTS + W_IN))
#define WOUT ((bf16_t*)(ws + OFF_WTS + W_OUT))
#define WUQ ((bf16_t*)(ws + OFF_WTS + W_UQ))
#define WUKV ((bf16_t*)(ws + OFF_WTS + W_UKV))

#ifdef PROBE_LO
#ifndef PROBE_MULT
#define PROBE_MULT 1
#endif
#define PSTAMP(k) do { if (bid == 0) ((volatile unsigned long long*)(a.ws + OFF_PSTAMP))[k] = __builtin_amdgcn_s_memrealtime(); } while (0)
    if (PROBE_LO < 0) PSTAMP(1);
#else
#define PSTAMP(k) do {} while (0)
#endif
    if (EN_P0) {
        PHASE_LOCALS
        const int nmod0 = (G >= 48) ? 48 : G;
        if (bid < nmod0) mods_items(INP(I_C), INP(I_CCTX), INP(I_MODW), INP(I_MODB), MODS, 0, 48, bid, nmod0, (LAS float*)lds, (LAS float*)(lds + 9 * 1024 * 4), tid);
        {
            const bool share = (G <= nmod0);
            if (share) __syncthreads();
            if (share || bid >= nmod0)
                even_wconv(INP(I_EVWIN), INP(I_EVWOUT), INP(I_WUQ), INP(I_WUKV), INP(I_QAN), INP(I_KVAN), WIN, WOUT, WUQ, WUKV,
                           (share ? bid : bid - nmod0) * NWAVES + wave, (share ? G : G - nmod0) * NWAVES, (LAS float*)(lds + wave * 8448), lane);
        }
        {
            const float* pfreq = INP(I_FREQ); const float* pfb1 = INP(I_FB1); const float* pfw1 = INP(I_FW1); const float* pfw2 = INP(I_FW2); const float* pfb2 = INP(I_FB2);
            constexpr int NPOS = 2048 + 256 + 2048;
            const int nidle = G - nmod0, nI = nidle * NWAVES, S = G * NWAVES;
            const int slot = ((bid >= nmod0) ? (bid - nmod0) : (bid + nidle)) * NWAVES + wave;
            if (slot < nI) mlp_run(HDN, pfreq, pfb1, pfw1, pfw2, pfb2, 3 * slot, 3, lane); else mlp_run(HDN, pfreq, pfb1, pfw1, pfw2, pfb2, 3 * nI + 2 * (slot - nI), 2, lane);
            for (int p = 3 * nI + 2 * (S - nI) + slot; p < NPOS; p += S) mlp_run(HDN, pfreq, pfb1, pfw1, pfw2, pfb2, p, 1, lane);
        }
    }
    { int tidp = threadIdx.x; asm volatile("" : "+v"(tidp)); xcd_barrier(xb, tidp); }
    if (a.out == nullptr) grid.sync();

#ifdef EXTRA_SYNCS
    { int tid1 = threadIdx.x; asm volatile("" : "+v"(tid1)); for (int i = 0; i < EXTRA_SYNCS; ++i) xcd_barrier(xb, tid1); }
#endif
#ifdef PG_BLOCK
#ifndef PG_MULT
#define PG_MULT 1
#endif
    unsigned long long pg_t0 = 0, pg_acc = 0;
#endif
    for (int ph = 0; ph < 28; ++ph) {
#ifdef PROBE_LO
        if (ph == PROBE_LO) PSTAMP(1);
        if (ph == PROBE_HI && bid == 0) {
            volatile unsigned long long* ts = (volatile unsigned long long*)(a.ws + OFF_PSTAMP);
            const unsigned long long t2 = __builtin_amdgcn_s_memrealtime(); const unsigned long long t1 = ts[1];
            while (__builtin_amdgcn_s_memrealtime() - t2 < (t2 - t1) * PROBE_MULT) __builtin_amdgcn_s_sleep(8);
        }
#endif
        {
            PHASE_LOCALS
            int phs = ph; asm volatile("" : "+s"(phs));
            int layer, step;
            if (phs < 8) { layer = 0; step = phs; } else if (phs < 15) { layer = 1; step = phs - 8; } else if (phs < 22) { layer = 2; step = phs - 15; } else { layer = 3; step = phs - 22; }
            const bool even = !(layer & 1);
            const int e = layer >> 1;
            const bool ctx_out = (layer < 2);
            const bool ctx_in = (layer < 3);
            const int Mrows = ctx_in ? MTOT : NLAT;
            const int Mout = ctx_out ? MTOT : NLAT;
            bf16_t* const XB3 = (bf16_t*)(BIG + 5 * UU + UU / 4);
            const void* xsrc = (layer == 0) ? (const void*)INP(I_X) : (layer == 3) ? (const void*)XB3 : (const void*)a.out;
            void* xdst = (layer == 2) ? (void*)XB3 : (void*)a.out;
            const int xs_bf16 = (layer != 0), xd_bf16 = (layer != 3);
            const float* xcsrc = (layer == 0) ? INP(I_CTX) : XC;
            const float* mods = MODS + (size_t)layer * 9 * 3072;
            const int nscan = (G >= 256) ? 128 : (G / 2);
#ifdef PG_BLOCK
            if (layer == 0 && step == 2 && bid == PG_BLOCK) pg_t0 = __builtin_amdgcn_s_memrealtime();
#endif
            const bool split = even && step >= 2 && step <= 4;
            const int grp_lo = split ? nscan : 0;
            const int Gl = G - grp_lo, bidl = bid - grp_lo;
            const int gwl = bidl * NWAVES + wave, NGWl = Gl * NWAVES;
            int nroute = 0; bool resid = false;
            if (even) { if (step == 1) nroute = 1; else if (step == 2) nroute = (bid >= nscan) ? 2 : 0; }
            else { if (step == 1) nroute = 1; }
            const int tail0 = even ? 5 : 4;
            int ew_lo = 0, ew_hi = 0, ew_blo = 0;
            int rs_rowoff = 0, rs_M = 0, rs_Gl = G, rs_bidl = bid;
            if (ctx_out) {
                if (step == tail0) { ew_lo = NLAT; ew_hi = MTOT; }
                else if (step == tail0 + 1) { if (bid < 32) { resid = true; rs_rowoff = NLAT; rs_M = NCTX; rs_Gl = 32; } else { ew_lo = 0; ew_hi = NLAT; ew_blo = 32; } }
                else if (step == tail0 + 2) { resid = true; rs_M = NLAT; }
            } else {
                if (step == tail0) { ew_hi = NLAT; }
                else if (step == tail0 + 1) { resid = true; rs_M = NLAT; }
            }
            const int gwE = (bid - ew_blo) * NWAVES + wave, NGWE = (G - ew_blo) * NWAVES;

            if (EN_NORM && step == 0) {
                bf16_t* H = (bf16_t*)(BIG + (even ? EV_E : OD_HV));
                const float* ng = INP(I_NORMG) + layer * 1024;
                for (int m2 = 2 * gw; m2 < Mrows; m2 += 2 * NGW) {
                    if (m2 < NLAT) {
                        const float* md = mods + (m2 >> 11) * 3072;
                        if (xs_bf16) { const bf16_t* xr0 = (const bf16_t*)xsrc + (size_t)m2 * DM; norm_row2_h(xr0, xr0 + DM, ng, md, H + (size_t)m2 * DM, lane); }
                        else { const float* xr0 = (const float*)xsrc + (size_t)m2 * DM; norm_row2(xr0, xr0 + DM, ng, md, H + (size_t)m2 * DM, lane); }
                    } else { const float* xr0 = xcsrc + (size_t)(m2 - NLAT) * DM; norm_row2(xr0, xr0 + DM, ng, mods + 8 * 3072, H + (size_t)m2 * DM, lane); }
                }
                LAS float* scr = (LAS float*)(lds + wave * 8448);
                if (even) {
                    if (layer != 0) even_wconv(INP(I_EVWIN) + (size_t)e * 1024 * 3232, nullptr, nullptr, nullptr,
                                               INP(I_QAN) + e * 256, INP(I_KVAN) + e * 128, WIN, WOUT, WUQ, WUKV, gw, NGW, scr, lane);
                } else {
                    const float* win = INP(I_ODWIN) + (size_t)e * 1024 * 4096;
                    const float* wout = INP(I_ODWOUT) + (size_t)e * 1024 * 1024;
                    constexpr int N1 = 128 * 16, N2 = 32 * 16;
                    (void)win; (void)N1;
                    if (layer != 1) for (int it = gw; it < N2; it += NGW) { const int nb = it / 16, kb = it % 16; transpose_item(wout, 1024, nb * 32, true, WOUT, 1024, nb * 32, kb * 64, scr, lane); }
                }
            } else if (EN_E4 && even && step == 3 && bid >= nscan) {
                {
                    LAS float* scr = (LAS float*)(lds + 4096 + wave * 8448);
                    const float* win = INP(I_ODWIN) + (size_t)e * 1024 * 4096;
                    for (int it = gwl; it < 128 * 16; it += NGWl) { const int nb = it / 16, kb = it % 16; transpose_item(win, 4096, nb * 32, true, WIN, 1024, nb * 32, kb * 64, scr, lane); }
                    __syncthreads();
                    filter_items(HDN + (size_t)(e == 0 ? 0 : 2304) * 64, INP(I_FWOUT) + (size_t)e * 64 * 2048, (bf16_t*)(ws + OFF_GR), 2048, bidl, Gl, (LAS float*)(lds + 72192), (LAS float*)(lds + 76288), tid);
                }
                bf16_t* Q = (bf16_t*)(BIG + EV_C); bf16_t* K = (bf16_t*)(BIG + EV_G); bf16_t* V = (bf16_t*)(BIG + EV_D);
                const bf16_t* PDQ = (const bf16_t*)(BIG + EV_F);
                const float* qn = INP(I_QN) + e * 96; const float* kn = INP(I_KN) + e * 96;
                const int hh = lane >> 3, d0 = (lane & 7) * 12;
                LAS float* RT = (LAS float*)lds;
                { const int pos = tid >> 3, fi = tid & 7; const float inv = powf(10000.0f, -(float)fi / 8.0f); const float ang = (float)pos * inv;
                  RT[2 * tid] = cosf(ang); RT[2 * tid + 1] = sinf(ang); }
                __syncthreads();
                float gq[12], gk[12];
#pragma unroll
                for (int j = 0; j < 12; ++j) { gq[j] = qn[d0 + j]; gk[j] = kn[d0 + j]; }
                for (int m2 = 2 * gwl; m2 < MTOT; m2 += 2 * NGWl) {
                    unsigned wq[2][6], wk[2][6]; u32x4 pw[2], vw[2];
#pragma unroll
                    for (int r = 0; r < 2; ++r) {
                        const int m = m2 + r;
                        pw[r] = *(const u32x4*)(PDQ + (size_t)m * 512 + 8 * lane);
                        vw[r] = *(const u32x4*)(V + (size_t)m * 512 + 8 * lane);
                        const bf16_t* src = Q + (size_t)m * 768 + lane * 12;
#pragma unroll
                        for (int j = 0; j < 6; ++j) { const int d = d0 + 2 * j;
                            wq[r][j] = *(const unsigned*)(src + 2 * j);
                            wk[r][j] = (d < 64) ? *(const unsigned*)(K + (size_t)m * 768 + hh * 96 + d) : *(const unsigned*)(PDQ + (size_t)m * 512 + 384 + (d - 64)); }
                    }
#pragma unroll
                    for (int r = 0; r < 2; ++r) {
                        const int m = m2 + r;
                        const bool lat = m < NLAT; const int t = m & 2047;
                        float s8 = 0.f;
                        { const u32x4 p = pw[r]; s8 = bflo(p.x) * bflo(p.x) + bfhi(p.x) * bfhi(p.x) + bflo(p.y) * bflo(p.y) + bfhi(p.y) * bfhi(p.y)
                                               + bflo(p.z) * bflo(p.z) + bfhi(p.z) * bfhi(p.z) + bflo(p.w) * bflo(p.w) + bfhi(p.w) * bfhi(p.w); }
                        const float sq = red64((lane < 32) ? s8 : 0.f), skv = red64((lane >= 32 && lane < 48) ? s8 : 0.f);
                        const float rq = 1.0f / sqrtf(sq * (1.f / 256.f) + NORM_EPS), rkv = 1.0f / sqrtf(skv * (1.f / 128.f) + NORM_EPS);
                        { const u32x4 p = vw[r]; u32x4 o;
                          o.x = pk2(bflo(p.x) * rkv, bfhi(p.x) * rkv); o.y = pk2(bflo(p.y) * rkv, bfhi(p.y) * rkv); o.z = pk2(bflo(p.z) * rkv, bfhi(p.z) * rkv); o.w = pk2(bflo(p.w) * rkv, bfhi(p.w) * rkv);
                          *(u32x4*)(V + (size_t)m * 512 + 8 * lane) = o; }
                        float rcs[6], rsn[6];
#pragma unroll
                        for (int jj = 0; jj < 6; ++jj) { const int d = d0 + 2 * jj; rcs[jj] = 1.f; rsn[jj] = 0.f;
                            if (lat && d >= 64) { const int pi = (d - 64) >> 1; const int pos = (pi < 8) ? (t >> 6) : (t & 63);
                                const f32x2 cs2 = *(const LAS f32x2*)(RT + 2 * (pos * 8 + (pi & 7))); rcs[jj] = cs2.x; rsn[jj] = cs2.y; } }
#pragma unroll
                        for (int which = 0; which < 2; ++which) {
                            float v[12];
#pragma unroll
                            for (int j = 0; j < 6; ++j) { const unsigned w = which ? wk[r][j] : wq[r][j]; v[2 * j] = bflo(w); v[2 * j + 1] = bfhi(w); }
#pragma unroll
                            for (int j = 0; j < 12; ++j) { const float sc = which ? ((d0 + j < 64) ? rkv : 1.0f) : rq; v[j] *= sc; }
                            float ss = 0.f;
#pragma unroll
                            for (int j = 0; j < 12; ++j) ss += v[j] * v[j];
                            const float rs = 1.0f / sqrtf(sum8(ss, lane) * (1.f / 96.f) + NORM_EPS);
#pragma unroll
                            for (int j = 0; j < 12; ++j) v[j] = v[j] * rs * (which ? gk[j] : gq[j]);
#pragma unroll
                            for (int jj = 0; jj < 6; ++jj) { const float aa = v[2 * jj], bb = v[2 * jj + 1];
                                v[2 * jj] = aa * rcs[jj] - bb * rsn[jj]; v[2 * jj + 1] = aa * rsn[jj] + bb * rcs[jj]; }
                            bf16_t* dst = (which ? K : Q) + (size_t)m * 768 + lane * 12;
#pragma unroll
                            for (int j = 0; j < 6; ++j) *(unsigned*)(dst + 2 * j) = pk2(v[2 * j], v[2 * j + 1]);
                        }
                    }
                }
            } else if (EN_E5 && even && ((step == 2 && bid < nscan) || (step == 4 && bid >= nscan))) {
                if (EN_SCAN && bid < nscan) {
                    const bf16_t* PRW = (const bf16_t*)(BIG + EV_A);
                    bf16_t* OUT = (bf16_t*)(BIG + EV_E);
                    LAS bf16_t* RAW = (LAS bf16_t*)(lds);
                    LAS bf16_t* WDA = (LAS bf16_t*)(lds + 21760);
                    LAS bf16_t* ADA = (LAS bf16_t*)(lds + 26368);
                    LAS float* WZ = (LAS float*)(lds + 30976);
                    LAS float* AZ = (LAS float*)(lds + 39168);
                    LAS float* GP = (LAS float*)(lds + 47360);
                    LAS float* MUL = (LAS float*)(lds + 49408);
                    LAS bf16_t* CUT = (LAS bf16_t*)(lds + 53248);
                    LAS float* CXL = (LAS float*)(lds + 58368);
                    LAS bf16_t* CSB = (LAS bf16_t*)(lds + 62464);
                    constexpr int HB = 71680;
                    constexpr int HSZ = 28672;
                    for (int chain = bid; chain < 128; chain += nscan) {
                        const int b = chain >> 4, hh = (chain >> 1) & 7, dir = chain & 1;
                        const int c = lane;
                        __syncthreads();
                        for (int i = tid; i < (HB + 2 * HSZ - 53248) / 4; i += NTHREADS) ((LAS unsigned*)(lds + 53248))[i] = 0u;
                        if (tid < 320) {
                            const float* mup = INP(I_MUP) + e * 1792; const float* mun = INP(I_MUN) + e * 1792;
                            const int g = tid >> 6, cc = tid & 63; const int col = (g < 3) ? (g * 512 + hh * 64 + cc) : ((g == 3 ? 1536 : 1664) + dir * 64 + cc);
                            const float mp = mup[col], mn = mun[col];
                            MUL[tid] = 1.0f - mp - mn; MUL[320 + tid] = dir ? mn : mp; MUL[640 + tid] = dir ? mp : mn;
                        }
                        const float kkw = INP(I_KK)[e * 512 + hh * 64 + c], kaw = INP(I_KA)[e * 512 + hh * 64 + c];
                        const float rkw = INP(I_RK)[(((size_t)e * 2 + dir) * 8 + hh) * 64 + c];
                        const int mm = wave >> 2, ct = wave & 3;
                        bf16x8 Bfr[2]; float lbias;
                        {
                            const float* up = (mm ? INP(I_AUP) : INP(I_WUP)) + ((size_t)e * 2 + dir) * 64 * 512 + hh * 64 + ct * 16 + (lane & 15);
#pragma unroll
                            for (int ks2 = 0; ks2 < 2; ++ks2) {
                                float t8[8];
#pragma unroll
                                for (int q = 0; q < 8; ++q) t8[q] = up[(size_t)(32 * ks2 + 8 * (lane >> 4) + q) * 512];
                                u32x4 w; w.x = pk2(t8[0], t8[1]); w.y = pk2(t8[2], t8[3]); w.z = pk2(t8[4], t8[5]); w.w = pk2(t8[6], t8[7]);
                                Bfr[ks2] = __builtin_bit_cast(bf16x8, w);
                            }
                            lbias = (mm ? INP(I_A0) : INP(I_W0))[((size_t)e * 2 + dir) * 512 + hh * 64 + ct * 16 + (lane & 15)];
                        }
                        f32x4 SA0 = (f32x4){0.f, 0.f, 0.f, 0.f}, SA1 = (f32x4){0.f, 0.f, 0.f, 0.f};
                        u32x4 pre[3];
#define CHUNK_GEO(chv) const bool isctx_ = (chv) < 8; const int seglen_ = isctx_ ? 256 : 2048; const int rowbase_ = isctx_ ? (NLAT + b * 256) : (b * 2048); \
                        const int jseg_ = isctx_ ? (chv) * 32 : ((chv) - 8) * 32; const int ttlo_ = dir ? (seglen_ - 1 - jseg_ - 31) : jseg_;
#define RAW_LOAD(chv) do { CHUNK_GEO(chv) _Pragma("unroll") for (int u = 0; u < 3; ++u) { const int id = tid + 512 * u; pre[u] = (u32x4){0u, 0u, 0u, 0u}; \
                            if (id < 1360) { const int i_ = id / 40, rem_ = id - i_ * 40, g_ = rem_ >> 3, c8_ = rem_ & 7; const int tt_ = ttlo_ - 1 + i_; \
                                if (tt_ >= 0 && tt_ < seglen_) { const int col_ = (g_ < 3) ? (g_ * 512 + hh * 64) : ((g_ == 3 ? 1536 : 1664) + dir * 64); \
                                    pre[u] = *(const u32x4*)(PRW + (size_t)(rowbase_ + tt_) * 1792 + col_ + 8 * c8_); } } } } while (0)
                        RAW_LOAD(0);
                        for (int ch = 0; ch < 72; ++ch) {
                            CHUNK_GEO(ch)
#pragma unroll
                            for (int u = 0; u < 3; ++u) { const int id = tid + 512 * u; if (id < 1360) { const int i_ = id / 40, rem_ = id - i_ * 40; *(LAS u32x4*)(RAW + i_ * 320 + rem_ * 8) = pre[u]; } }
                            __syncthreads();
                            if (ch + 1 < 72) RAW_LOAD(ch + 1);
                            float rr[4], kv4[4], vv[4], kn[4];
                            {
                                const int r0 = dir ? (33 - 4 * wave) : (4 * wave); const int rs = dir ? -1 : 1;
                                float y[5][6];
#pragma unroll
                                for (int g = 0; g < 5; ++g)
#pragma unroll
                                    for (int i = 0; i < 6; ++i) y[g][i] = bf2f(RAW[(r0 + rs * i) * 320 + g * 64 + c]);
                                float m0[5], ca[5], cb[5];
#pragma unroll
                                for (int g = 0; g < 5; ++g) { m0[g] = MUL[g * 64 + c]; ca[g] = MUL[320 + g * 64 + c]; cb[g] = MUL[640 + g * 64 + c]; }
#pragma unroll
                                for (int j = 0; j < 4; ++j) {
                                    const int s = 4 * wave + j;
                                    float sv[5];
#pragma unroll
                                    for (int g = 0; g < 5; ++g) sv[g] = y[g][j + 1] * m0[g] + y[g][j] * ca[g] + y[g][j + 2] * cb[g];
                                    rr[j] = sv[0]; kv4[j] = sv[1]; vv[j] = sv[2];
                                    const float e2 = __expf(2.0f * sv[3]); const float th = 1.0f - 2.0f * __builtin_amdgcn_rcpf(1.0f + e2);
                                    WDA[s * 72 + c] = (bf16_t)f2bf(th); ADA[s * 72 + c] = (bf16_t)f2bf(sv[4]);
                                    const float kr = sv[1] * kkw;
                                    const float nrm = red64(kr * kr);
                                    kn[j] = kr * __builtin_amdgcn_rsqf(fmaxf(nrm, 1e-24f));
                                }
                            }
                            __syncthreads();
                            {
                                const LAS bf16_t* Am = mm ? ADA : WDA; LAS float* Zm = mm ? AZ : WZ;
#pragma unroll
                                for (int rt = 0; rt < 2; ++rt) {
                                    f32x4 acc = (f32x4){lbias, lbias, lbias, lbias};
#pragma unroll
                                    for (int ks2 = 0; ks2 < 2; ++ks2) {
                                        const bf16x8 Af = *(const LAS bf16x8*)(Am + (16 * rt + (lane & 15)) * 72 + 32 * ks2 + 8 * (lane >> 4));
                                        acc = __builtin_amdgcn_mfma_f32_16x16x32_bf16(Af, Bfr[ks2], acc, 0, 0, 0);
                                    }
#pragma unroll
                                    for (int q = 0; q < 4; ++q) Zm[(16 * rt + 4 * (lane >> 4) + q) * 64 + ct * 16 + (lane & 15)] = acc[q];
                                }
                            }
                            __syncthreads();
                            float ecum[4], bb[4], kdv[4];
                            {
                                float es = 0.f;
#pragma unroll
                                for (int j = 0; j < 4; ++j) {
                                    const int s = 4 * wave + j;
                                    const float sg = __builtin_amdgcn_rcpf(1.0f + __expf(-WZ[s * 64 + c]));
                                    es += 0.60653065971f * sg; ecum[j] = es;
                                    const float av = __builtin_amdgcn_rcpf(1.0f + __expf(-AZ[s * 64 + c]));
                                    kdv[j] = kv4[j] * (1.0f + (av - 1.0f) * kaw);
                                    bb[j] = kn[j] * av;
                                    const float bon = red64(rr[j] * kdv[j] * rkw);
                                    if (lane == 0) { const int tt = dir ? (ttlo_ + 31 - s) : (ttlo_ + s); BONUS[((size_t)(rowbase_ + tt) * 2 + dir) * 8 + hh] = bon; }
                                }
                                GP[wave * 64 + c] = es;
                            }
                            __syncthreads();
                            {
                                const int wq = wave & 3;
                                LAS unsigned char* hb = lds + HB + (wave >> 2) * HSZ;
                                LAS bf16_t* AH = (LAS bf16_t*)hb; LAS bf16_t* RH = AH + 1152; LAS bf16_t* BH = RH + 1152; LAS bf16_t* KH = BH + 1152;
                                LAS bf16_t* BHT = (LAS bf16_t*)(hb + 9216); LAS bf16_t* KHT = (LAS bf16_t*)(hb + 14336); LAS bf16_t* VT = (LAS bf16_t*)(hb + 19456);
                                float base = 0.f;
                                if (wq > 0) base += GP[(wave - 1) * 64 + c];
                                if (wq > 1) base += GP[(wave - 2) * 64 + c];
                                if (wq > 2) base += GP[(wave - 3) * 64 + c];
                                float gprev = __expf(-base);
                                float bq[4], kq[4];
#pragma unroll
                                for (int j = 0; j < 4; ++j) {
                                    const int t = 4 * wq + j; const float es = base + ecum[j];
                                    const float gc = __expf(-es), ig = __expf(es);
                                    bq[j] = bb[j] * ig; kq[j] = kdv[j] * ig;
                                    AH[t * 72 + c] = (bf16_t)f2bf(-kn[j] * gprev); RH[t * 72 + c] = (bf16_t)f2bf(rr[j] * gc);
                                    BH[t * 72 + c] = (bf16_t)f2bf(bq[j]); KH[t * 72 + c] = (bf16_t)f2bf(kq[j]);
                                    gprev = gc;
                                }
                                u32x2 w;
                                w.x = pk2(bq[0], bq[1]); w.y = pk2(bq[2], bq[3]); *(LAS u32x2*)(BHT + c * 40 + 4 * wq) = w;
                                w.x = pk2(kq[0], kq[1]); w.y = pk2(kq[2], kq[3]); *(LAS u32x2*)(KHT + c * 40 + 4 * wq) = w;
                                w.x = pk2(vv[0], vv[1]); w.y = pk2(vv[2], vv[3]); *(LAS u32x2*)(VT + c * 40 + 4 * wq) = w;
                                if (wq == 3) ((LAS float*)(hb + 28416))[c] = gprev;
                            }
                            __syncthreads();
                            LAS float* L1T = (LAS float*)(lds + HB + 2 * HSZ);
                            {
                                int lane_h = lane; asm volatile("" : "+v"(lane_h));
                                const int wq = wave & 3;
                                LAS unsigned char* hb = lds + HB + (wave >> 2) * HSZ;
                                const LAS bf16_t* M1 = (const LAS bf16_t*)(hb + ((wq < 2) ? 0 : 2304)); const LAS bf16_t* M2 = (const LAS bf16_t*)(hb + ((wq & 1) ? 6912 : 4608));
                                f32x4 acc = (f32x4){0.f, 0.f, 0.f, 0.f};
#pragma unroll
                                for (int kc = 0; kc < 2; ++kc) {
                                    const bf16x8 Af = *(const LAS bf16x8*)(M1 + (lane_h & 15) * 72 + 32 * kc + 8 * (lane_h >> 4));
                                    const bf16x8 Bf = *(const LAS bf16x8*)(M2 + (lane_h & 15) * 72 + 32 * kc + 8 * (lane_h >> 4));
                                    acc = __builtin_amdgcn_mfma_f32_16x16x32_bf16(Af, Bf, acc, 0, 0, 0);
                                }
                                const int sc = lane_h & 15;
                                LAS bf16_t* dst = (LAS bf16_t*)(hb + ((wq == 1) ? 24576 : (wq == 2) ? 25856 : 27136));
                                f32x4 lv;
#pragma unroll
                                for (int q = 0; q < 4; ++q) {
                                    const int tr = 4 * (lane_h >> 4) + q;
                                    const bool keep = (wq < 2) ? (sc < tr) : (sc <= tr);
                                    const float val = keep ? acc[q] : 0.f;
                                    lv[q] = val;
                                    if (wq != 0) dst[tr * 40 + sc] = (bf16_t)f2bf(val);
                                }
                                if (wq == 0) *(LAS f32x4*)(L1T + (wave >> 2) * 256 + sc * 16 + 4 * (lane_h >> 4)) = lv;
                            }
                            __syncthreads();
#pragma unroll 1
                            for (int hf = 0; hf < 2; ++hf) {
                                int lane_h = lane; asm volatile("" : "+v"(lane_h)); int wave_h = wave; asm volatile("" : "+s"(wave_h));
                                const int sb0 = 16 * hf;
                                LAS unsigned char* hb = lds + HB + hf * HSZ;
                                const LAS bf16_t* CAH = (const LAS bf16_t*)hb; const LAS bf16_t* CRH = CAH + 1152;
                                const LAS bf16_t* CBHT = (const LAS bf16_t*)(hb + 9216); const LAS bf16_t* CKHT = (const LAS bf16_t*)(hb + 14336); const LAS bf16_t* CVT = (const LAS bf16_t*)(hb + 19456);
                                const LAS bf16_t* CL2B = (const LAS bf16_t*)(hb + 24576); const LAS bf16_t* CN1B = (const LAS bf16_t*)(hb + 25856); const LAS bf16_t* CN2B = (const LAS bf16_t*)(hb + 27136);
                                const LAS float* CDL = (const LAS float*)(hb + 28416);
                                f32x4 oacc = (f32x4){0.f, 0.f, 0.f, 0.f};
                                {
                                    const int vt = wave_h & 3; const bool isx = wave_h < 4;
                                    const LAS bf16_t* M1 = isx ? CAH : CRH; const LAS bf16_t* M3 = isx ? CL2B : CN2B;
                                    f32x4 acc = (f32x4){0.f, 0.f, 0.f, 0.f};
#pragma unroll
                                    for (int kc = 0; kc < 2; ++kc) {
                                        const bf16x8 Af = *(const LAS bf16x8*)(M1 + (lane_h & 15) * 72 + 32 * kc + 8 * (lane_h >> 4));
                                        const bf16x8 Bf = *(const LAS bf16x8*)(CSB + (16 * vt + (lane_h & 15)) * 72 + 32 * kc + 8 * (lane_h >> 4));
                                        acc = __builtin_amdgcn_mfma_f32_16x16x32_bf16(Af, Bf, acc, 0, 0, 0);
                                    }
                                    {
                                        const bf16x8 Af = *(const LAS bf16x8*)(M3 + (lane_h & 15) * 40 + 8 * (lane_h >> 4));
                                        const bf16x8 Bf = *(const LAS bf16x8*)(CVT + (16 * vt + (lane_h & 15)) * 40 + 8 * (lane_h >> 4));
                                        acc = __builtin_amdgcn_mfma_f32_16x16x32_bf16(Af, Bf, acc, 0, 0, 0);
                                    }
                                    if (isx) {
#pragma unroll
                                        for (int q = 0; q < 4; ++q) CXL[(4 * (lane_h >> 4) + q) * 64 + 16 * vt + (lane_h & 15)] = acc[q];
                                    } else oacc = acc;
                                }
                                __syncthreads();
                                if (wave_h == 4 * hf) {
                                    float u[16];
#pragma unroll
                                    for (int t = 0; t < 16; ++t) u[t] = CXL[t * 64 + lane_h];
                                    const LAS float* lt = L1T + hf * 256;
#pragma unroll
                                    for (int s2 = 0; s2 < 15; ++s2) {
#pragma unroll
                                        for (int c4 = (s2 + 1) >> 2; c4 < 4; ++c4) {
                                            const f32x4 lq = *(const LAS f32x4*)(lt + s2 * 16 + 4 * c4);
#pragma unroll
                                            for (int q = 0; q < 4; ++q) { const int t = 4 * c4 + q; if (t > s2) u[t] += lq[q] * u[s2]; }
                                        }
                                    }
                                    u32x4 w0, w1;
                                    w0.x = pk2(u[0], u[1]); w0.y = pk2(u[2], u[3]); w0.z = pk2(u[4], u[5]); w0.w = pk2(u[6], u[7]);
                                    w1.x = pk2(u[8], u[9]); w1.y = pk2(u[10], u[11]); w1.z = pk2(u[12], u[13]); w1.w = pk2(u[14], u[15]);
                                    *(LAS u32x4*)(CUT + lane_h * 40) = w0; *(LAS u32x4*)(CUT + lane_h * 40 + 8) = w1;
                                }
                                __syncthreads();
                                {
                                    const int kt = wave_h & 3, vt0 = 2 * (wave_h >> 2);
                                    const bf16x8 Ak = *(const LAS bf16x8*)(CKHT + (16 * kt + (lane_h & 15)) * 40 + 8 * (lane_h >> 4));
                                    const bf16x8 Ab = *(const LAS bf16x8*)(CBHT + (16 * kt + (lane_h & 15)) * 40 + 8 * (lane_h >> 4));
                                    const f32x4 dl = *(const LAS f32x4*)(CDL + 16 * kt + 4 * (lane_h >> 4));
#pragma unroll
                                    for (int i = 0; i < 2; ++i) {
                                        const int vt = vt0 + i;
                                        const bf16x8 Bv = *(const LAS bf16x8*)(CVT + (16 * vt + (lane_h & 15)) * 40 + 8 * (lane_h >> 4));
                                        const bf16x8 Bu = *(const LAS bf16x8*)(CUT + (16 * vt + (lane_h & 15)) * 40 + 8 * (lane_h >> 4));
                                        f32x4 sa_ = i ? SA1 : SA0;
                                        sa_ = __builtin_amdgcn_mfma_f32_16x16x32_bf16(Ak, Bv, sa_, 0, 0, 0);
                                        sa_ = __builtin_amdgcn_mfma_f32_16x16x32_bf16(Ab, Bu, sa_, 0, 0, 0);
                                        sa_ = sa_ * dl;
                                        if (i) SA1 = sa_; else SA0 = sa_;
                                        u32x2 w; w.x = pk2(sa_[0], sa_[1]); w.y = pk2(sa_[2], sa_[3]);
                                        *(LAS u32x2*)(CSB + (16 * vt + (lane_h & 15)) * 72 + 16 * kt + 4 * (lane_h >> 4)) = w;
                                    }
                                    if (wave_h >= 4) {
                                        const int vt = wave_h & 3;
                                        const bf16x8 Af = *(const LAS bf16x8*)(CN1B + (lane_h & 15) * 40 + 8 * (lane_h >> 4));
                                        const bf16x8 Bu = *(const LAS bf16x8*)(CUT + (16 * vt + (lane_h & 15)) * 40 + 8 * (lane_h >> 4));
                                        oacc = __builtin_amdgcn_mfma_f32_16x16x32_bf16(Af, Bu, oacc, 0, 0, 0);
#pragma unroll
                                        for (int q = 0; q < 4; ++q) { const int s = sb0 + 4 * (lane_h >> 4) + q; const int tt = dir ? (ttlo_ + 31 - s) : (ttlo_ + s);
                                            OUT[((size_t)(rowbase_ + tt) * 2 + dir) * 512 + hh * 64 + 16 * vt + (lane_h & 15)] = (bf16_t)f2bf(oacc[q]); }
                                    }
                                }
                                __syncthreads();
                            }
                        }
#undef RAW_LOAD
#undef CHUNK_GEO
                    }
                } else if (EN_ATTN && bid >= nscan) {
                    bf16_t* Q = (bf16_t*)(BIG + EV_C); const bf16_t* K = (const bf16_t*)(BIG + EV_G); const bf16_t* V = (const bf16_t*)(BIG + EV_D);
                    const int nunits = 512 + (ctx_out ? 64 : 0);
                    const int nab = G - nscan;
                    for (int unit = bid - nscan; unit < nunits; unit += nab) {
                        int b, hh, q0, nlat, NT;
                        if (unit < 512) { b = unit >> 6; hh = (unit >> 3) & 7; q0 = b * 2048 + (unit & 7) * 256; nlat = 32; NT = 36; }
                        else { const int u2 = unit - 512; b = u2 >> 3; hh = u2 & 7; q0 = NLAT + b * 256; nlat = 0; NT = 4; }
                        att::attn_body(Q + (size_t)q0 * 768 + hh * 96, K + hh * 96, V + hh * 64, Q + (size_t)q0 * 768 + hh * 96, b * 2048, NLAT + b * 256, nlat, NT, (LAS char*)lds, tid);
                    }
                    xcd_barrier(xb2, tid);
                    {
                        const bf16_t* O = (const bf16_t*)(BIG + EV_C); const bf16_t* PG = (const bf16_t*)(BIG + EV_B); bf16_t* U = (bf16_t*)(BIG + EV_D);
                        const int hh = lane >> 3, ch0 = lane * 8;
                        for (int m = gwl; m < Mout; m += NGWl) {
                            const u32x4 ow = __builtin_nontemporal_load((const u32x4*)(O + (size_t)m * 768 + hh * 96 + (lane & 7) * 8));
                            const u32x4 gwd = __builtin_nontemporal_load((const u32x4*)(PG + (size_t)m * 1024 + ch0));
                            u32x4 r;
                            r.x = pk2(bflo(ow.x) * silu_f(bflo(gwd.x)), bfhi(ow.x) * silu_f(bfhi(gwd.x)));
                            r.y = pk2(bflo(ow.y) * silu_f(bflo(gwd.y)), bfhi(ow.y) * silu_f(bfhi(gwd.y)));
                            r.z = pk2(bflo(ow.z) * silu_f(bflo(gwd.z)), bfhi(ow.z) * silu_f(bfhi(gwd.z)));
                            r.w = pk2(bflo(ow.w) * silu_f(bflo(gwd.w)), bfhi(ow.w) * silu_f(bfhi(gwd.w)));
                            *(u32x4*)(U + (size_t)m * 1024 + ch0) = r;
                        }
                    }
}
            } else if (EN_E6 && even && ew_hi > ew_lo && bid >= ew_blo) {
                const bf16_t* O = (const bf16_t*)(BIG + EV_C); const bf16_t* PG = (const bf16_t*)(BIG + EV_B); const bf16_t* PRW = (const bf16_t*)(BIG + EV_A);
                const bf16_t* OUT = (const bf16_t*)(BIG + EV_E);
                bf16_t* U = (bf16_t*)(BIG + EV_D);
                const float* mup = INP(I_MUP) + e * 1792 + 1024; const float* mun = INP(I_MUN) + e * 1792 + 1024;
                const float* lnw = INP(I_LNW) + e * 512; const float* lnb = INP(I_LNB) + e * 512;
                for (int m = ew_lo + gwE; m < ew_hi; m += NGWE) {
                    const int hh = lane >> 3, ch0 = lane * 8;
                    {
                        const u32x4 o0 = __builtin_nontemporal_load((const u32x4*)(OUT + ((size_t)m * 2 + 0) * 512 + ch0)), o1 = __builtin_nontemporal_load((const u32x4*)(OUT + ((size_t)m * 2 + 1) * 512 + ch0));
                        float ov[8];
                        ov[0] = bflo(o0.x) + bflo(o1.x); ov[1] = bfhi(o0.x) + bfhi(o1.x); ov[2] = bflo(o0.y) + bflo(o1.y); ov[3] = bfhi(o0.y) + bfhi(o1.y);
                        ov[4] = bflo(o0.z) + bflo(o1.z); ov[5] = bfhi(o0.z) + bfhi(o1.z); ov[6] = bflo(o0.w) + bflo(o1.w); ov[7] = bfhi(o0.w) + bfhi(o1.w);
                        float s = 0.f;
#pragma unroll
                        for (int j = 0; j < 8; ++j) s += ov[j];
                        const float mu = sum8(s, lane) * (1.f / 64.f);
                        float s2 = 0.f;
#pragma unroll
                        for (int j = 0; j < 8; ++j) { ov[j] -= mu; s2 += ov[j] * ov[j]; }
                        const float rstd = 1.0f / sqrtf(sum8(s2, lane) * (1.f / 64.f) + 64e-5f);
                        const float bon = BONUS[((size_t)m * 2 + 0) * 8 + hh] + BONUS[((size_t)m * 2 + 1) * 8 + hh];
                        const bool lat = m < NLAT; const int tt = lat ? (m & 2047) : ((m - NLAT) & 255); const int seglen = lat ? 2048 : 256;
                        const bf16_t* pp = PRW + (size_t)m * 1792 + 1024 + ch0;
                        const u32x4 pc = *(const u32x4*)pp;
                        u32x4 pv = (u32x4){0u, 0u, 0u, 0u}, pn = (u32x4){0u, 0u, 0u, 0u};
                        if (tt > 0) pv = *(const u32x4*)(pp - 1792);
                        if (tt < seglen - 1) pn = *(const u32x4*)(pp + 1792);
                        const u32x4 gwd = __builtin_nontemporal_load((const u32x4*)(PG + (size_t)m * 1024 + 512 + ch0));
                        float res[8];
#pragma unroll
                        for (int j = 0; j < 8; ++j) {
                            const unsigned wc_ = (j < 2) ? pc.x : (j < 4) ? pc.y : (j < 6) ? pc.z : pc.w;
                            const unsigned wp_ = (j < 2) ? pv.x : (j < 4) ? pv.y : (j < 6) ? pv.z : pv.w;
                            const unsigned wn_ = (j < 2) ? pn.x : (j < 4) ? pn.y : (j < 6) ? pn.z : pn.w;
                            const unsigned wg_ = (j < 2) ? gwd.x : (j < 4) ? gwd.y : (j < 6) ? gwd.z : gwd.w;
                            const float p = (j & 1) ? bfhi(wc_) : bflo(wc_), pr = (j & 1) ? bfhi(wp_) : bflo(wp_), nx = (j & 1) ? bfhi(wn_) : bflo(wn_);
                            const float gg = (j & 1) ? bfhi(wg_) : bflo(wg_);
                            const float vs = p + (pr - p) * mup[ch0 + j] + (nx - p) * mun[ch0 + j];
                            const float on = ov[j] * rstd * lnw[ch0 + j] + lnb[ch0 + j] + bon * vs;
                            res[j] = on * silu_f(gg);
                        }
                        u32x4 r; r.x = pk2(res[0], res[1]); r.y = pk2(res[2], res[3]); r.z = pk2(res[4], res[5]); r.w = pk2(res[6], res[7]);
                        *(u32x4*)(U + (size_t)m * 1024 + 512 + ch0) = r;
                    }
                }
            } else if (EN_O2 && !even && step == 2) {
                const bf16_t* P0 = (const bf16_t*)(BIG + OD_P); const bf16_t* P1 = (const bf16_t*)(BIG + OD_P + UU); const bf16_t* P2 = (const bf16_t*)(BIG + OD_P + 2 * UU);
                bf16_t* P3 = (bf16_t*)(BIG + OD_P + 3 * UU); bf16_t* VXT = (bf16_t*)(BIG + OD_HV);
                const float* cw = INP(I_CONVW) + (size_t)e * 3 * 3072; const float* cb = INP(I_CONVB) + (size_t)e * 3072;
                LAS bf16_t* TT = (LAS bf16_t*)lds;
                LAS float* WL = (LAS float*)(lds + 9216);
                for (int i = tid; i < 4 * 3072 / 4; i += NTHREADS) { const int arr = i / 768, c4 = (i - arr * 768) * 4;
                    *(LAS f32x4*)(WL + arr * 3072 + c4) = *(const f32x4*)((arr < 3 ? cw + arr * 3072 : cb) + c4); }
                __syncthreads();
                const int nitems = (Mrows / 64) * 16;
                u32x4 Lc[3] = {}, Lp[3] = {}, Ln[3] = {}, Lg = {};
#define O2_GEO(it) const int rt_ = (it) >> 4, ct_ = (it) & 15; const int m0_ = rt_ * 64; const bool lat_ = m0_ < NLAT; \
                const int bsel_ = lat_ ? (m0_ >> 11) : ((m0_ - NLAT) >> 8); const int t0_ = lat_ ? (m0_ & 2047) : ((m0_ - NLAT) & 255); const int seglen_ = lat_ ? 2048 : 256; \
                int tid_o = tid; asm volatile("" : "+v"(tid_o)); const int r_ = tid_o >> 3, c0_ = ct_ * 64 + (tid_o & 7) * 8; const int m_ = m0_ + r_; const int tt_ = t0_ + r_; (void)bsel_; (void)seglen_; (void)tt_; (void)m_; (void)c0_;
#define O2_LOAD(it) do { O2_GEO(it) const bool hp_ = tt_ > 0, hn_ = tt_ < seglen_ - 1; \
                _Pragma("unroll") for (int part = 0; part < 3; ++part) { const bf16_t* pp = ((part == 0) ? P0 : (part == 1) ? P1 : P2) + (size_t)m_ * 1024 + c0_; \
                    Lc[part] = __builtin_nontemporal_load((const u32x4*)pp); Lp[part] = (u32x4){0u, 0u, 0u, 0u}; Ln[part] = (u32x4){0u, 0u, 0u, 0u}; \
                    if (hp_) Lp[part] = *(const u32x4*)(pp - 1024); if (hn_) Ln[part] = *(const u32x4*)(pp + 1024); } \
                Lg = __builtin_nontemporal_load((const u32x4*)(P3 + (size_t)m_ * 1024 + c0_)); } while (0)
                O2_LOAD(bid < nitems ? bid : 0);
                for (int item = bid; item < nitems; item += G) {
                    O2_GEO(item)
                    {
                        float cv[3][8];
#pragma unroll
                        for (int part = 0; part < 3; ++part) {
                            const u32x4 wc_ = Lc[part], wp_ = Lp[part], wn_ = Ln[part];
                            const LAS float* w0 = WL + part * 1024 + c0_; const LAS float* w1 = WL + 3072 + part * 1024 + c0_; const LAS float* w2 = WL + 6144 + part * 1024 + c0_;
                            const LAS float* bb = WL + 9216 + part * 1024 + c0_;
#pragma unroll
                            for (int q = 0; q < 8; ++q) {
                                const unsigned a_ = (q < 2) ? wc_.x : (q < 4) ? wc_.y : (q < 6) ? wc_.z : wc_.w;
                                const unsigned p_ = (q < 2) ? wp_.x : (q < 4) ? wp_.y : (q < 6) ? wp_.z : wp_.w;
                                const unsigned n_ = (q < 2) ? wn_.x : (q < 4) ? wn_.y : (q < 6) ? wn_.z : wn_.w;
                                const float cc = (q & 1) ? bfhi(a_) : bflo(a_), pr = (q & 1) ? bfhi(p_) : bflo(p_), nx = (q & 1) ? bfhi(n_) : bflo(n_);
                                cv[part][q] = pr * w0[q] + cc * w1[q] + nx * w2[q] + bb[q];
                            }
                            __builtin_amdgcn_sched_barrier(0);
                        }
                        const u32x4 gw_ = Lg;
                        float vx[8], zz[8];
#pragma unroll
                        for (int q = 0; q < 8; ++q) {
                            const unsigned g_ = (q < 2) ? gw_.x : (q < 4) ? gw_.y : (q < 6) ? gw_.z : gw_.w;
                            const float gg = (q & 1) ? bfhi(g_) : bflo(g_);
                            vx[q] = cv[2][q] * cv[1][q]; zz[q] = cv[0][q] * silu_f(gg);
                        }
                        u32x4 rr; rr.x = pk2(vx[0], vx[1]); rr.y = pk2(vx[2], vx[3]); rr.z = pk2(vx[4], vx[5]); rr.w = pk2(vx[6], vx[7]);
                        *(LAS u32x4*)(TT + r_ * 72 + (tid & 7) * 8) = rr;
                        u32x4 r2; r2.x = pk2(zz[0], zz[1]); r2.y = pk2(zz[2], zz[3]); r2.z = pk2(zz[4], zz[5]); r2.w = pk2(zz[6], zz[7]);
                        *(u32x4*)(P3 + (size_t)m_ * 1024 + c0_) = r2;
                    }
                    if (item + G < nitems) O2_LOAD(item + G);
                    __syncthreads();
                    {
                        const int cc = tid >> 3, tq = tid & 7;
                        unsigned short hv[8];
#pragma unroll
                        for (int i = 0; i < 8; ++i) hv[i] = TT[(8 * tq + i) * 72 + cc];
                        u32x4 w; w.x = hv[0] | ((unsigned)hv[1] << 16); w.y = hv[2] | ((unsigned)hv[3] << 16); w.z = hv[4] | ((unsigned)hv[5] << 16); w.w = hv[6] | ((unsigned)hv[7] << 16);
                        bf16_t* dst = VXT + (lat_ ? (size_t)0 : (size_t)1024 * 8 * 2048) + ((size_t)(ct_ * 64 + cc) * 8 + bsel_) * seglen_ + t0_ + 8 * tq;
                        *(u32x4*)dst = w;
                    }
                    __syncthreads();
                }
#undef O2_LOAD
#undef O2_GEO
            } else if (EN_O3 && !even && step == 3) {
                const bf16_t* VXT = (const bf16_t*)(BIG + OD_HV); bf16_t* YT = (bf16_t*)(BIG + OD_P + UU);
                const bf16_t* GR = (const bf16_t*)(ws + OFF_GR); const bf16_t* GRC = (const bf16_t*)(BIG + OD_GRC);
                const float* bd = INP(I_BIASD) + e * 1024;
                constexpr int TL = 2312;
                LAS unsigned char* Vl = lds; LAS unsigned char* Gl = lds + 36992;
                for (int i = tid; i < 36992 / 16; i += NTHREADS) *(LAS u32x4*)(Vl + 16 * i) = (u32x4){0u, 0u, 0u, 0u};
                __syncthreads();
                const int nmode = (layer == 1) ? 2 : 1;
#ifndef TP_DUP
#define TP_DUP 1
#endif
                for (int tpd = 0; tpd < TP_DUP; ++tpd)
                for (int mode = nmode - 1; mode >= 0; --mode) {
                    const int Lf = mode ? 256 : 2048; const int CS = mode ? 1088 : 8256; const int grl = 2 * Lf + 16;
                    const size_t seg_off = mode ? (size_t)1024 * 8 * 2048 : 0;
                    u32x4 pv[4] = {}, pg0 = {}, pg1 = {};
#define TP_LOAD(cc) do { const bf16_t* vsrc_ = VXT + seg_off + (size_t)(cc) * 8 * Lf; \
                        _Pragma("unroll") for (int i_ = 0; i_ < 4; ++i_) { const int id_ = tid + 512 * i_; if (id_ < Lf) { const int b_ = id_ / (Lf >> 3), t8_ = id_ - b_ * (Lf >> 3); pv[i_] = __builtin_nontemporal_load((const u32x4*)(vsrc_ + (size_t)b_ * Lf + 8 * t8_)); } } \
                        if (tid < (Lf >> 2)) { const unsigned* gsrc_ = (const unsigned*)((mode ? GRC : GR) + (size_t)(cc) * grl) + 4 * tid; pg0 = __builtin_nontemporal_load((const u32x4*)gsrc_); pg1 = __builtin_nontemporal_load((const u32x4*)(gsrc_ + 4)); } } while (0)
                    if (bid < 1024) TP_LOAD(bid);
                    for (int c = bid; c < 1024; c += G) {
#pragma unroll
                        for (int i_ = 0; i_ < 4; ++i_) { const int id_ = tid + 512 * i_; if (id_ < Lf) { const int b_ = id_ / (Lf >> 3), t8_ = id_ - b_ * (Lf >> 3); *(LAS u32x4*)(Vl + ((b_ * TL + 128 + 8 * t8_) * 2)) = pv[i_]; } }
                        if (tid < (Lf >> 2)) {
                            const u32x4 lo = pg0, hi4 = pg1;
                            const unsigned d0 = lo.x, d1 = lo.y, d2 = lo.z, d3 = lo.w, d4 = hi4.x, d5 = hi4.y, d6 = hi4.z, d7 = hi4.w;
#define AB(h, l) __builtin_amdgcn_alignbit((h), (l), 16)
                            LAS unsigned char* gd = Gl + 16 * tid;
                            *(LAS u32x4*)(gd + 0 * CS) = (u32x4){d4, d5, d6, d7};
                            *(LAS u32x4*)(gd + 1 * CS) = (u32x4){AB(d4, d3), AB(d5, d4), AB(d6, d5), AB(d7, d6)};
                            *(LAS u32x4*)(gd + 2 * CS) = (u32x4){d3, d4, d5, d6};
                            *(LAS u32x4*)(gd + 3 * CS) = (u32x4){AB(d3, d2), AB(d4, d3), AB(d5, d4), AB(d6, d5)};
                            *(LAS u32x4*)(gd + 4 * CS) = (u32x4){d2, d3, d4, d5};
                            *(LAS u32x4*)(gd + 5 * CS) = (u32x4){AB(d2, d1), AB(d3, d2), AB(d4, d3), AB(d5, d4)};
                            *(LAS u32x4*)(gd + 6 * CS) = (u32x4){d1, d2, d3, d4};
                            *(LAS u32x4*)(gd + 7 * CS) = (u32x4){AB(d1, d0), AB(d2, d1), AB(d3, d2), AB(d4, d3)};
#undef AB
                        }
                        if (c + G < 1024) TP_LOAD(c + G);
                        __syncthreads();
                        const bool active = mode ? (wave == 0) : true;
                        if (active) {
                            const int r = lane & 31, hh = lane >> 5, q = r & 7, rho = r >> 3, bb = r >> 2, nn = r & 3;
                            att::f32x16 accA = {}, accB = {};
                            const int T0a = mode ? 0 : wave * 8, T0b = T0a + 4;
                            const int nS = Lf >> 5;
                            const LAS unsigned char* vbase = Vl + ((bb * TL + 128 + 32 * nn + 8 * hh) * 2);
                            const LAS unsigned char* gbase = Gl + q * CS + ((Lf - 8 * rho + 8 * hh) * 2);
#define TP_LD(F, S) do { const int da_ = T0a - (S); \
                                F[0] = *(const LAS bf16x8*)(vbase + (32 * (S)) * 2); F[1] = *(const LAS bf16x8*)(vbase + (32 * (S) + 16) * 2); \
                                F[2] = *(const LAS bf16x8*)(gbase + (-32 * da_) * 2); F[3] = *(const LAS bf16x8*)(gbase + (-32 * da_ + 16) * 2); \
                                F[4] = *(const LAS bf16x8*)(gbase + (-32 * (da_ + 4)) * 2); F[5] = *(const LAS bf16x8*)(gbase + (-32 * (da_ + 4) + 16) * 2); } while (0)
#define TP_MM(F) do { accA = __builtin_amdgcn_mfma_f32_32x32x16_bf16(F[2], F[0], accA, 0, 0, 0); accB = __builtin_amdgcn_mfma_f32_32x32x16_bf16(F[4], F[0], accB, 0, 0, 0); \
                                accA = __builtin_amdgcn_mfma_f32_32x32x16_bf16(F[3], F[1], accA, 0, 0, 0); accB = __builtin_amdgcn_mfma_f32_32x32x16_bf16(F[5], F[1], accB, 0, 0, 0); } while (0)
                            bf16x8 fa[6], fb[6];
                            TP_LD(fa, -3);
                            for (int S0 = -3; ; ) {
                                TP_LD(fb, S0 + 1);
                                __builtin_amdgcn_sched_barrier(0);
                                TP_MM(fa);
                                __builtin_amdgcn_sched_barrier(0);
                                if (++S0 >= nS) break;
                                TP_LD(fa, S0 + 1);
                                __builtin_amdgcn_sched_barrier(0);
                                TP_MM(fb);
                                __builtin_amdgcn_sched_barrier(0);
                                if (++S0 >= nS) break;
                            }
#undef TP_LD
#undef TP_MM
                            const float bias = bd[c];
                            bf16_t* ydst = YT + seg_off + ((size_t)c * 8 + bb) * Lf;
#pragma unroll
                            for (int g = 0; g < 4; ++g) {
                                { const int t = 32 * (T0a + nn) + 8 * g + 4 * hh;
                                  const u32x2 vw = *(const LAS u32x2*)(Vl + ((bb * TL + 128 + t) * 2));
                                  u32x2 o; o.x = pk2(accA[4 * g] + bflo(vw.x) * bias, accA[4 * g + 1] + bfhi(vw.x) * bias); o.y = pk2(accA[4 * g + 2] + bflo(vw.y) * bias, accA[4 * g + 3] + bfhi(vw.y) * bias);
                                  *(u32x2*)(ydst + t) = o; }
                                { const int t = 32 * (T0b + nn) + 8 * g + 4 * hh;
                                  const u32x2 vw = *(const LAS u32x2*)(Vl + ((bb * TL + 128 + t) * 2));
                                  u32x2 o; o.x = pk2(accB[4 * g] + bflo(vw.x) * bias, accB[4 * g + 1] + bfhi(vw.x) * bias); o.y = pk2(accB[4 * g + 2] + bflo(vw.y) * bias, accB[4 * g + 3] + bfhi(vw.y) * bias);
                                  *(u32x2*)(ydst + t) = o; }
                            }
                        }
                        __syncthreads();
                    }
                }
#undef TP_LOAD
            } else if (EN_O3 && !even && ew_hi > ew_lo && bid >= ew_blo) {
                const bf16_t* YT = (const bf16_t*)(BIG + OD_P + UU); const bf16_t* Z = (const bf16_t*)(BIG + OD_P + 3 * UU); bf16_t* U2 = (bf16_t*)(BIG + OD_P);
                LAS bf16_t* TT = (LAS bf16_t*)lds;
                for (int item = bid - ew_blo; item < ((ew_hi - ew_lo) / 64) * 16; item += G - ew_blo) {
                    const int rt = (ew_lo / 64) + (item >> 4), ct = item & 15;
                    const int m0 = rt * 64; const bool lat = m0 < NLAT;
                    const int bsel = lat ? (m0 >> 11) : ((m0 - NLAT) >> 8); const int t0 = lat ? (m0 & 2047) : ((m0 - NLAT) & 255); const int seglen = lat ? 2048 : 256;
                    {
                        const int cc = tid >> 3, tq = tid & 7;
                        const bf16_t* s = YT + (lat ? (size_t)0 : (size_t)1024 * 8 * 2048) + ((size_t)(ct * 64 + cc) * 8 + bsel) * seglen + t0 + 8 * tq;
                        *(LAS u32x4*)(TT + cc * 72 + 8 * tq) = __builtin_nontemporal_load((const u32x4*)s);
                    }
                    __syncthreads();
                    {
                        const int r = tid >> 3, cg = tid & 7; const int m = m0 + r, c0 = ct * 64 + cg * 8;
                        const u32x4 zw = __builtin_nontemporal_load((const u32x4*)(Z + (size_t)m * 1024 + c0));
                        float yv[8];
#pragma unroll
                        for (int j = 0; j < 8; ++j) yv[j] = bf2f(TT[(8 * cg + j) * 72 + r]);
                        u32x4 o; o.x = pk2(yv[0] * bflo(zw.x), yv[1] * bfhi(zw.x)); o.y = pk2(yv[2] * bflo(zw.y), yv[3] * bfhi(zw.y));
                        o.z = pk2(yv[4] * bflo(zw.z), yv[5] * bfhi(zw.z)); o.w = pk2(yv[6] * bflo(zw.w), yv[7] * bfhi(zw.w));
                        *(u32x4*)(U2 + (size_t)m * 1024 + c0) = o;
                    }
                    __syncthreads();
                }
            }

            if (EN_P0 && step == 1 && layer <= 2) {
                const int nwg = (Mrows / 256) * (even ? 13 : 16), nfull = nwg % G;
                const int nid = G - nfull;
                if (bid >= nfull) {
                    if (layer == 0) {
                        mods_items(INP(I_C), INP(I_CCTX), INP(I_MODW), INP(I_MODB), MODS, 48, 144, bid - nfull, nid, (LAS float*)lds, (LAS float*)(lds + 9 * 1024 * 4), tid);
                    } else if (layer == 2) {
                        even_wconv(nullptr, INP(I_EVWOUT) + (size_t)e * 1024 * 1024, INP(I_WUQ) + (size_t)e * 256 * 768, INP(I_WUKV) + (size_t)e * 128 * 1024,
                                   INP(I_QAN) + e * 256, INP(I_KVAN) + e * 128, WIN, WOUT, WUQ, WUKV, (bid - nfull) * NWAVES + wave, nid * NWAVES, (LAS float*)(lds + wave * 8448), lane);
                    } else {
                        LAS float* scr = (LAS float*)(lds + wave * 8448);
                        const float* wout = INP(I_ODWOUT);
                        for (int it = (bid - nfull) * NWAVES + wave; it < 32 * 16; it += nid * NWAVES) { const int nb = it / 16, kb = it % 16; transpose_item(wout, 1024, nb * 32, true, WOUT, 1024, nb * 32, kb * 64, scr, lane); }
                        __syncthreads();
                        filter_items(HDN + (size_t)2048 * 64, INP(I_FWOUT), (bf16_t*)(BIG + OD_GRC), 256, bid - nfull, nid, (LAS float*)(lds + 8 * 8448), (LAS float*)(lds + 8 * 8448 + 4096), tid);
                    }
                    __syncthreads();
                }
            }
            for (int jb = 0; EN_GR && jb < nroute; ++jb) {
                pg8::Gemm g; pg8::EpiRoute E; E.remap96 = 0;
                if (even && step == 1) {
                    g = pg8::Gemm{(const bf16_t*)(BIG + EV_E), WIN, MTOT, 3328, 1024, 1024};
                    E.base[0] = (bf16_t*)(BIG + EV_A); E.ld[0] = 1792; E.base[1] = (bf16_t*)(BIG + EV_B); E.ld[1] = 1024; E.base[2] = (bf16_t*)(BIG + EV_F); E.ld[2] = 512;
                    E.base[3] = E.base[2]; E.ld[3] = 512; E.t0 = 7; E.t1 = 11; E.t2 = 64;
                } else if (even && jb == 0) {
                    g = pg8::Gemm{(const bf16_t*)(BIG + EV_F), WUQ, MTOT, 768, 256, 512};
                    E.base[0] = (bf16_t*)(BIG + EV_C); E.ld[0] = 768; E.base[1] = E.base[0]; E.ld[1] = 768; E.base[2] = E.base[0]; E.ld[2] = 768; E.base[3] = E.base[0]; E.ld[3] = 768;
                    E.t0 = 64; E.t1 = 64; E.t2 = 64;
                } else if (even) {
                    g = pg8::Gemm{(const bf16_t*)(BIG + EV_F) + 256, WUKV, MTOT, 1024, 256, 512};
                    E.base[0] = (bf16_t*)(BIG + EV_G); E.ld[0] = 768; E.base[1] = (bf16_t*)(BIG + EV_D); E.ld[1] = 512; E.base[2] = E.base[1]; E.ld[2] = 512; E.base[3] = E.base[1]; E.ld[3] = 512;
                    E.t0 = 2; E.t1 = 64; E.t2 = 64; E.remap96 = 1;
                } else {
                    g = pg8::Gemm{(const bf16_t*)(BIG + OD_HV), WIN, Mrows, 4096, 1024, 1024};
                    E.base[0] = (bf16_t*)(BIG + OD_P); E.base[1] = (bf16_t*)(BIG + OD_P + UU); E.base[2] = (bf16_t*)(BIG + OD_P + 2 * UU); E.base[3] = (bf16_t*)(BIG + OD_P + 3 * UU);
                    E.ld[0] = E.ld[1] = E.ld[2] = E.ld[3] = 1024; E.t0 = 4; E.t1 = 8; E.t2 = 12;
                }
                pg8::StaticOrder S; S.init(g.M, g.N, Gl, bidl);
                pg8::gemm_phase<pg8::EpiRoute, pg8::StaticOrder, true, true>(lds, g, S, E, tid);
            }
            if (EN_GS && resid) {
                pg8::Gemm g{(const bf16_t*)(BIG + (even ? EV_D : OD_P)) + (size_t)rs_rowoff * 1024, WOUT, rs_M, 1024, 1024, 1024};
                pg8::EpiResid E{xsrc, xdst, xcsrc, XC, mods, rs_rowoff, xs_bf16, xd_bf16};
                pg8::StaticOrder S; S.init(g.M, g.N, rs_Gl, rs_bidl);
                pg8::gemm_phase<pg8::EpiResid, pg8::StaticOrder, true, true>(lds, g, S, E, tid);
            }
#ifdef PG_BLOCK
            if (layer == 0 && step == 4 && bid == PG_BLOCK) pg_acc = __builtin_amdgcn_s_memrealtime() - pg_t0;
#endif
            if (split && step < 4) { if (bid >= nscan) xcd_barrier(xb2, tid); }
            else xcd_barrier(xb, tid);
        }
    }
#ifdef PG_BLOCK
    if (bid == PG_BLOCK) { const unsigned long long t2 = __builtin_amdgcn_s_memrealtime(); while (__builtin_amdgcn_s_memrealtime() - t2 < pg_acc * PG_MULT) __builtin_amdgcn_s_sleep(8); }
#endif
#ifdef PROBE_LO
    if (PROBE_HI >= 28 && bid == 0) {
        volatile unsigned long long* ts = (volatile unsigned long long*)(a.ws + OFF_PSTAMP);
        const unsigned long long t2 = __builtin_amdgcn_s_memrealtime(); const unsigned long long t1 = ts[1];
        while (__builtin_amdgcn_s_memrealtime() - t2 < (t2 - t1) * PROBE_MULT) __builtin_amdgcn_s_sleep(8);
    }
#endif
}

extern "C" void kernel_launch(void* const* d_in, const int* in_sizes, int n_in, void* d_out, int out_size,
                              void* d_ws, size_t ws_size, hipStream_t stream) {
    static int grid_blocks = 0;
    if (!grid_blocks) {
        int dev = 0, cus = 0, per_cu = 0;
        (void)hipGetDevice(&dev);
        (void)hipDeviceGetAttribute(&cus, hipDeviceAttributeMultiprocessorCount, dev);
        (void)hipFuncSetAttribute((const void*)mega_fwd, hipFuncAttributeMaxDynamicSharedMemorySize, LDS_BYTES);
        (void)hipOccupancyMaxActiveBlocksPerMultiprocessor(&per_cu, (const void*)mega_fwd, NTHREADS, LDS_BYTES);
        if (per_cu < 1) per_cu = 1;
        if (per_cu > 1) per_cu = 1;
        grid_blocks = cus * per_cu;
        if (n_in != 37 || ws_size < 268435456) fprintf(stderr, "kernel_launch: unexpected n_in %d / ws %zu\n", n_in, ws_size);
    }
    Args a{};
    for (int i = 0; i < 37 && i < n_in; ++i) a.in[i] = (const float*)d_in[i];
    a.out = (float*)d_out; a.ws = (unsigned char*)d_ws;
    (void)hipMemsetAsync((unsigned char*)d_ws + OFF_BAR, 0, 32768, stream);
    void* args[] = {&a};
    hipError_t e = hipLaunchCooperativeKernel((const void*)mega_fwd, dim3(grid_blocks), dim3(NTHREADS), args, LDS_BYTES, stream);
    if (e != hipSuccess) fprintf(stderr, "cooperative launch failed: %s (grid %d)\n", hipGetErrorString(e), grid_blocks);
}
```
